# Optimizing an MI355X kernel written in HIP

```python
import jax, jax.numpy as jnp
from jax import lax
import numpy as np

D_MODEL = 4096
BATCH = 32
SEQ = 256
DEPTH = 1
DEC_BATCH = 8
DEC_SEQ = 4096
PAST_LEN = 256

GRID_W = 64
N_HEADS_ATTN = 16
HEAD_DIM_ATTN = 128
D_ATTN = N_HEADS_ATTN * HEAD_DIM_ATTN
WIN_ROWS = 8
WIN_COLS = 16
QBLOCK_COLS = 16
KBLOCK_COLS = QBLOCK_COLS + WIN_COLS
N_HEADS_RWKV = 32
HEAD_DIM_RWKV = 64
D_RWKV = N_HEADS_RWKV * HEAD_DIM_RWKV
DECAY_LORA = 96
ICLR_LORA = 96
GATE_LORA = 256
C_RWKV = 3 * D_RWKV + DECAY_LORA + ICLR_LORA + GATE_LORA
D_IN = 3 * D_ATTN + C_RWKV + 2 * D_MODEL
D_FF = 4 * D_MODEL
RMS_EPS = 1e-6
LNX_EPS = 64e-5

kernel_name = "hybrid_natten_rwkv7_diffusion_step"


def rmsnorm(x, w):
    xf = x.astype(jnp.float32)
    y = xf * lax.rsqrt(jnp.mean(xf * xf, axis=-1, keepdims=True) + RMS_EPS)
    return (y * w.astype(jnp.float32)).astype(x.dtype)


def adaln(cond, w_mod, b_mod):
    m = jax.nn.silu(cond) @ w_mod + b_mod
    return jnp.split(m[..., None, :], 6, axis=-1)


def modulate(h, shift, scale):
    return h * (1 + scale) + shift


def project(h, w_in):
    proj = h @ w_in
    return jnp.split(proj, [3 * D_ATTN, 3 * D_ATTN + C_RWKV], axis=-1)


def attn_heads(pa):
    B, L, _ = pa.shape
    q, k, v = jnp.split(pa, 3, axis=-1)
    shp = (B, L, N_HEADS_ATTN, HEAD_DIM_ATTN)
    return q.reshape(shp), k.reshape(shp), v.reshape(shp)


def context_attention(q, k, v):
    B, L, H, dh = q.shape
    s = jnp.einsum('bqhd,bkhd->bhqk', q, k).astype(jnp.float32) * (dh ** -0.5)
    p = jax.nn.softmax(s, axis=-1).astype(v.dtype)
    return jnp.einsum('bhqk,bkhd->bqhd', p, v).reshape(B, L, H * dh)


def neighbourhood_attention(q, k, v, k_ctx, v_ctx, rpb):
    B, N, H, dh = q.shape
    rows = N // GRID_W
    kh = min(WIN_ROWS, rows)
    nb = GRID_W // QBLOCK_COLS
    kbw = KBLOCK_COLS
    scale = dh ** -0.5
    qcol = np.arange(GRID_W).reshape(nb, QBLOCK_COLS)
    kb_start = np.clip(np.arange(nb) * QBLOCK_COLS - WIN_COLS // 2, 0, GRID_W - kbw)
    kcol = kb_start[:, None] + np.arange(kbw)[None, :]
    cs = np.clip(qcol - WIN_COLS // 2, 0, GRID_W - WIN_COLS)
    col_ok = (kcol[:, None, :] >= cs[:, :, None]) & (kcol[:, None, :] < cs[:, :, None] + WIN_COLS)
    mask = np.broadcast_to(col_ok[:, :, None, :], (nb, QBLOCK_COLS, kh, kbw)).reshape(nb, QBLOCK_COLS, kh * kbw)
    dc_idx = np.clip(kcol[:, None, :] - qcol[:, :, None] + WIN_COLS - 1, 0, 2 * WIN_COLS - 2)
    rpb_c = rpb[:, :, dc_idx]
    qg = q.reshape(B, rows, nb, QBLOCK_COLS, H, dh)
    kg = k.reshape(B, rows, GRID_W, H, dh)
    vg = v.reshape(B, rows, GRID_W, H, dh)
    n_loc = kh * kbw

    def one_row(r):
        rs = jnp.clip(r - WIN_ROWS // 2, 0, rows - kh)
        qr = lax.dynamic_index_in_dim(qg, r, axis=1, keepdims=False)
        kband = lax.dynamic_slice_in_dim(kg, rs, kh, axis=1)
        vband = lax.dynamic_slice_in_dim(vg, rs, kh, axis=1)
        kb = kband[:, :, kcol].transpose(0, 2, 1, 3, 4, 5).reshape(B, nb, n_loc, H, dh)
        vb = vband[:, :, kcol].transpose(0, 2, 1, 3, 4, 5).reshape(B, nb, n_loc, H, dh)
        dr_idx = rs + jnp.arange(kh) - r + WIN_ROWS - 1
        bias = rpb_c[:, dr_idx].transpose(0, 2, 3, 1, 4).reshape(H, nb, QBLOCK_COLS, n_loc)
        s_loc = jnp.einsum('bnqhd,bnkhd->bhnqk', qr, kb).astype(jnp.float32) * scale + bias.astype(jnp.float32)
        s_loc = jnp.where(mask, s_loc, -jnp.inf)
        s_ctx = jnp.einsum('bnqhd,bkhd->bhnqk', qr, k_ctx).astype(jnp.float32) * scale
        p = jax.nn.softmax(jnp.concatenate([s_loc, s_ctx], axis=-1), axis=-1).astype(v.dtype)
        return (jnp.einsum('bhnqk,bnkhd->bnqhd', p[..., :n_loc], vb)
                + jnp.einsum('bhnqk,bkhd->bnqhd', p[..., n_loc:], v_ctx))

    o = lax.map(one_row, jnp.arange(rows))
    return jnp.moveaxis(o, 0, 1).reshape(B, N, H * dh)


def token_shift(p, mu):
    zero = jnp.zeros_like(p[:, :1])
    prev = jnp.concatenate([zero, p[:, :-1]], axis=1)
    nxt = jnp.concatenate([p[:, 1:], zero], axis=1)
    return p + mu * (0.5 * (prev + nxt) - p)


def head_groupnorm(y, w, b):
    B, L, H, N = y.shape
    mu = jnp.mean(y, axis=-1, keepdims=True)
    var = jnp.mean(jnp.square(y - mu), axis=-1, keepdims=True)
    yn = (y - mu) * lax.rsqrt(var + LNX_EPS)
    return yn.reshape(B, L, H * N) * w.astype(jnp.float32) + b.astype(jnp.float32)


def rwkv_scan(S0, r, decay, k, v, kk, b, reverse):
    def step(S, inp):
        r_t, w_t, k_t, v_t, kk_t, b_t = inp
        sa = -jnp.einsum('bhvk,bhk->bhv', S, kk_t)
        S = S * w_t[:, :, None, :] + sa[..., None] * b_t[:, :, None, :] + v_t[..., None] * k_t[:, :, None, :]
        return S, jnp.einsum('bhvk,bhk->bhv', S, r_t)
    xs = tuple(jnp.moveaxis(t, 1, 0) for t in (r, decay, k, v, kk, b))
    S, ys = lax.scan(step, S0, xs, reverse=reverse)
    return S, jnp.moveaxis(ys, 0, 1)


def rwkv_branch(pr, S_f0, S_b0, mu, w0, w2, a0, a2, g2, k_k, k_a, r_k, lnx_w, lnx_b):
    B, L, _ = pr.shape
    f32 = jnp.float32
    xr = token_shift(pr, mu)
    cuts = [D_RWKV, 2 * D_RWKV, 3 * D_RWKV, 3 * D_RWKV + DECAY_LORA, 3 * D_RWKV + DECAY_LORA + ICLR_LORA]
    r, k, v, xw, xa, xg = jnp.split(xr, cuts, axis=-1)

    def heads(t):
        return t.reshape(B, L, N_HEADS_RWKV, HEAD_DIM_RWKV).astype(f32)

    kkh = heads(k * k_k)
    kkh = kkh / jnp.maximum(jnp.sqrt(jnp.sum(kkh * kkh, axis=-1, keepdims=True)), 1e-12)
    rh, vh = heads(r), heads(v)
    g = jax.nn.sigmoid(xg) @ g2

    def direction(d, S0, reverse):
        wl = (w0[d] + jnp.tanh(xw) @ w2[d]).astype(f32)
        wl = -jax.nn.softplus(-wl) - 0.5
        decay = jnp.exp(-jnp.exp(wl))
        a = jax.nn.sigmoid(a0[d] + xa @ a2[d])
        kdh = heads(k * (1 + (a - 1) * k_a))
        S, y = rwkv_scan(S0.astype(f32), rh, heads(decay), kdh, vh, kkh, kkh * heads(a), reverse)
        bonus = jnp.sum(rh * kdh * r_k.astype(f32), axis=-1, keepdims=True) * vh
        return head_groupnorm(y, lnx_w, lnx_b) + bonus.reshape(B, L, D_RWKV), S

    o_f, S_f = direction(0, S_f0, False)
    o_b, S_b = direction(1, S_b0, True)
    return ((o_f + o_b) * g).astype(pr.dtype), S_f, S_b


def merge(o_attn, o_rwkv, pg, w_o_attn, w_o_rwkv, w_out):
    g_a, g_r = jnp.split(jax.nn.sigmoid(pg), 2, axis=-1)
    return (g_a * (o_attn @ w_o_attn) + g_r * (o_rwkv @ w_o_rwkv)) @ w_out


def squared_relu_mlp(h, w1, w2):
    return jnp.square(jax.nn.relu(h @ w1)) @ w2


def setup_inputs(seed: int = 0) -> dict:
    key = jax.random.key(seed)
    ks = jax.random.split(key, 32)
    f32 = jnp.float32

    def nrm(k, shape, scale):
        return jax.random.normal(k, shape, f32) * scale

    L = DEPTH
    return {
        "x_prompt": nrm(ks[0], (BATCH, SEQ, D_MODEL), 1.0),
        "x_sample": nrm(ks[1], (DEC_BATCH, DEC_SEQ, D_MODEL), 1.0),
        "cache_attn_k": nrm(ks[2], (DEC_BATCH, L, PAST_LEN, N_HEADS_ATTN, HEAD_DIM_ATTN), 1.0),
        "cache_attn_v": nrm(ks[3], (DEC_BATCH, L, PAST_LEN, N_HEADS_ATTN, HEAD_DIM_ATTN), 1.0),
        "state_rwkv_fwd": nrm(ks[4], (DEC_BATCH, L, N_HEADS_RWKV, HEAD_DIM_RWKV, HEAD_DIM_RWKV), 0.3),
        "state_rwkv_bwd": nrm(ks[5], (DEC_BATCH, L, N_HEADS_RWKV, HEAD_DIM_RWKV, HEAD_DIM_RWKV), 0.3),
        "c": nrm(ks[6], (DEC_BATCH, D_MODEL), 1.0),
        "c_ctx": nrm(ks[7], (D_MODEL,), 1.0),
        "w_mod": nrm(ks[8], (L, D_MODEL, 6 * D_MODEL), 0.5 * D_MODEL ** -0.5),
        "b_mod": nrm(ks[9], (L, 6 * D_MODEL), 0.02),
        "norm1_w": 1.0 + nrm(ks[10], (L, D_MODEL), 0.05),
        "norm2_w": 1.0 + nrm(ks[11], (L, D_MODEL), 0.05),
        "norm_f_w": 1.0 + nrm(ks[12], (D_MODEL,), 0.05),
        "w_in": nrm(ks[13], (L, D_MODEL, D_IN), D_MODEL ** -0.5),
        "tshift_mu": jax.random.uniform(ks[14], (L, C_RWKV), f32),
        "attn_rpb": nrm(ks[15], (L, N_HEADS_ATTN, 2 * WIN_ROWS - 1, 2 * WIN_COLS - 1), 0.5),
        "rwkv_w0": -1.0 + nrm(ks[16], (L, 2, D_RWKV), 0.5),
        "rwkv_w2": nrm(ks[17], (L, 2, DECAY_LORA, D_RWKV), 0.1),
        "rwkv_a0": nrm(ks[18], (L, 2, D_RWKV), 0.3),
        "rwkv_a2": nrm(ks[19], (L, 2, ICLR_LORA, D_RWKV), ICLR_LORA ** -0.5),
        "rwkv_g2": nrm(ks[20], (L, GATE_LORA, D_RWKV), GATE_LORA ** -0.5),
        "rwkv_k_k": 1.0 + nrm(ks[21], (L, D_RWKV), 0.1),
        "rwkv_k_a": 1.0 + nrm(ks[22], (L, D_RWKV), 0.1),
        "rwkv_r_k": nrm(ks[23], (L, N_HEADS_RWKV, HEAD_DIM_RWKV), 0.1),
        "lnx_w": 1.0 + nrm(ks[24], (L, D_RWKV), 0.05),
        "lnx_b": nrm(ks[25], (L, D_RWKV), 0.02),
        "w_o_attn": nrm(ks[26], (L, D_ATTN, D_MODEL), D_ATTN ** -0.5),
        "w_o_rwkv": nrm(ks[27], (L, D_RWKV, D_MODEL), D_RWKV ** -0.5),
        "w_out": nrm(ks[28], (L, D_MODEL, D_MODEL), D_MODEL ** -0.5),
        "w_mlp1": nrm(ks[29], (L, D_MODEL, D_FF), D_MODEL ** -0.5),
        "w_mlp2": nrm(ks[30], (L, D_FF, D_MODEL), D_FF ** -0.5),
    }


def reference(x_prompt, x_sample, cache_attn_k, cache_attn_v, state_rwkv_fwd, state_rwkv_bwd, c, c_ctx,
              w_mod, b_mod, norm1_w, norm2_w, norm_f_w, w_in, tshift_mu, attn_rpb,
              rwkv_w0, rwkv_w2, rwkv_a0, rwkv_a2, rwkv_g2, rwkv_k_k, rwkv_k_a, rwkv_r_k, lnx_w, lnx_b,
              w_o_attn, w_o_rwkv, w_out, w_mlp1, w_mlp2):
    xc, xs = x_prompt, x_sample
    new_k, new_v, new_sf, new_sb = [], [], [], []
    B_c = x_prompt.shape[0]
    for l in range(DEPTH):
        rw = (tshift_mu[l], rwkv_w0[l], rwkv_w2[l], rwkv_a0[l], rwkv_a2[l], rwkv_g2[l],
              rwkv_k_k[l], rwkv_k_a[l], rwkv_r_k[l], lnx_w[l], lnx_b[l])
        ow = (w_o_attn[l], w_o_rwkv[l], w_out[l])

        sh1, sc1, gt1, sh2, sc2, gt2 = adaln(c_ctx, w_mod[l], b_mod[l])
        h = modulate(rmsnorm(xc, norm1_w[l]), sh1, sc1)
        pa, pr, pg = project(h, w_in[l])
        q, k, v = attn_heads(pa)
        o_attn = context_attention(q, k, v)
        z = jnp.zeros((B_c, N_HEADS_RWKV, HEAD_DIM_RWKV, HEAD_DIM_RWKV), jnp.float32)
        o_rwkv, s_f, s_b = rwkv_branch(pr, z, z, *rw)
        xc = xc + gt1 * merge(o_attn, o_rwkv, pg, *ow)
        h = modulate(rmsnorm(xc, norm2_w[l]), sh2, sc2)
        xc = xc + gt2 * squared_relu_mlp(h, w_mlp1[l], w_mlp2[l])
        new_k.append(k)
        new_v.append(v)
        new_sf.append(s_f)
        new_sb.append(s_b)

        sh1, sc1, gt1, sh2, sc2, gt2 = adaln(c, w_mod[l], b_mod[l])
        h = modulate(rmsnorm(xs, norm1_w[l]), sh1, sc1)
        pa, pr, pg = project(h, w_in[l])
        q, k, v = attn_heads(pa)
        o_attn = neighbourhood_attention(q, k, v, cache_attn_k[:, l], cache_attn_v[:, l], attn_rpb[l])
        o_rwkv, _, _ = rwkv_branch(pr, state_rwkv_fwd[:, l], state_rwkv_bwd[:, l], *rw)
        xs = xs + gt1 * merge(o_attn, o_rwkv, pg, *ow)
        h = modulate(rmsnorm(xs, norm2_w[l]), sh2, sc2)
        xs = xs + gt2 * squared_relu_mlp(h, w_mlp1[l], w_mlp2[l])

    y_prompt = rmsnorm(xc, norm_f_w)
    y_sample = rmsnorm(xs, norm_f_w)
    return (y_prompt, y_sample, jnp.stack(new_k, axis=1), jnp.stack(new_v, axis=1),
            jnp.stack(new_sf, axis=1), jnp.stack(new_sb, axis=1))
```

```cpp
#include <hip/hip_runtime.h>
#include <cstdio>
#include <cstdint>
namespace pg8 {
#define PG8_LAS __attribute__((address_space(3)))
typedef unsigned short bf16_t;
typedef short bf16x8 __attribute__((ext_vector_type(8)));
typedef float f32x4 __attribute__((ext_vector_type(4)));
typedef unsigned u32x4 __attribute__((ext_vector_type(4)));
constexpr int BM = 256, BK = 64, HALF = 128, HTB = HALF * BK * 2  , STAGE_BYTES = 8 * HTB, NXCD = 8, WGM = 8;

__host__ __device__ __forceinline__ int lds_byte(int r, int c) { const int st = (r >> 4) * 2 + (c >> 5), rr = r & 15, cc = c & 31, ob = rr * 64 + cc * 2; return st * 1024 + (ob ^ (((ob >> 9) & 1) << 5)); }
__host__ __device__ __forceinline__ void stage_rc(int b, int& R, int& C) { const int st = b / 1024, sb = b % 1024, swz = sb ^ (((sb >> 9) & 1) << 5); R = (st >> 1) * 16 + swz / 64; C = (st & 1) * 32 + (swz % 64) / 2; }
__host__ __device__ __forceinline__ int perm32(int rho) { const int n = rho >> 4, i = rho & 15; return 8 * (i >> 2) + 4 * n + (i & 3); }

struct Unit { int pm, pn; };
struct Gemm { const bf16_t* A; const bf16_t* Bt; int M, N, K; };

struct StaticOrder {
    int nM, nN, nwg, G, c;
    __host__ __device__ void init(int M, int N, int G_, int c_) { nM = M / BM; nN = N / BM; nwg = nM * nN; G = G_; c = c_; }
    __host__ __device__ bool next(int i, Unit& u) const {
        const long L = (long)i * G + c; if (L >= nwg) return false;
        int wgid = (int)L; { const int q = nwg / NXCD, r = nwg % NXCD, xcd = wgid % NXCD, off = wgid / NXCD; wgid = (xcd < r ? xcd * (q + 1) : r * (q + 1) + (xcd - r) * q) + off; }
        const int nig = WGM * nN, gid = wgid / nig, fm = gid * WGM, gsz = (nM - fm) < WGM ? (nM - fm) : WGM;
        u.pm = fm + ((wgid % nig) % gsz); u.pn = (wgid % nig) / gsz; return true;
    }
    __device__ __forceinline__ void a_ready(const Unit&) const {}
    __device__ __forceinline__ void done(const Unit&) const {}
};

__device__ __forceinline__ unsigned cvt_pk_bf16(float lo, float hi) { unsigned r; asm volatile("v_cvt_pk_bf16_f32 %0, %1, %2" : "=v"(r) : "v"(lo), "v"(hi)); return r; }
typedef _Float16 h16x2 __attribute__((ext_vector_type(2)));
__device__ __forceinline__ unsigned cvt_pk_f16(float lo, float hi) { h16x2 v = {(_Float16)lo, (_Float16)hi}; return __builtin_bit_cast(unsigned, v); }
__device__ __forceinline__ float sigmoidf_(float x) { return __builtin_amdgcn_rcpf(1.0f + __builtin_amdgcn_exp2f(-1.4426950408889634f * x)); }
__device__ __forceinline__ float bf_lo(unsigned u) { return __builtin_bit_cast(float, u << 16); }
__device__ __forceinline__ float bf_hi(unsigned u) { return __builtin_bit_cast(float, u & 0xffff0000u); }

struct EpiProj {
    static constexpr bool PERM = true, AFTER_DRAIN = false;
    bf16_t *Q, *K, *V, *PR, *PG; float *NK, *NV;
    __device__ __forceinline__ void operator()(const f32x4 (&acc)[2][2][4][2], const Unit& u, int wr, int wc, int fr, int fq) const {
        const int row0 = u.pm * BM + wr * 64 + fr, pn = u.pn;
        bf16_t* base; int ld, colt, mode = 0; float* fb = nullptr;
        if (pn < 8) { base = Q; ld = 2048; colt = pn * 256; }
        else if (pn < 16) { base = K; ld = 2048; colt = (pn - 8) * 256; fb = NK; }
        else if (pn < 24) { base = V; ld = 2048; colt = (pn - 16) * 256; fb = NV; }
        else if (pn < 50) { base = PR; ld = 6656; colt = (pn - 24) * 256; mode = 1; }
        else { base = PG; ld = 8192; colt = (pn - 50) * 256; mode = 2; }
        const int col0 = colt + wc * 32 + 8 * fq;
#pragma unroll
        for (int ai = 0; ai < 2; ++ai)
#pragma unroll
            for (int m = 0; m < 4; ++m) { const size_t r = (size_t)(row0 + ai * HALF + m * 16); bf16_t* rowp = base + r * ld + col0;
#pragma unroll
                for (int bj = 0; bj < 2; ++bj) { f32x4 v0 = acc[ai][bj][m][0], v1 = acc[ai][bj][m][1]; u32x4 w;
                    if (mode == 2) { v0 = (f32x4){sigmoidf_(v0[0]), sigmoidf_(v0[1]), sigmoidf_(v0[2]), sigmoidf_(v0[3])}; v1 = (f32x4){sigmoidf_(v1[0]), sigmoidf_(v1[1]), sigmoidf_(v1[2]), sigmoidf_(v1[3])}; }
                    if (mode == 1) { w.x = cvt_pk_f16(v0[0], v0[1]); w.y = cvt_pk_f16(v0[2], v0[3]); w.z = cvt_pk_f16(v1[0], v1[1]); w.w = cvt_pk_f16(v1[2], v1[3]); }
                    else { w.x = cvt_pk_bf16(v0[0], v0[1]); w.y = cvt_pk_bf16(v0[2], v0[3]); w.z = cvt_pk_bf16(v1[0], v1[1]); w.w = cvt_pk_bf16(v1[2], v1[3]); }
                    *(u32x4*)(rowp + bj * HALF) = w;
                    if (fb) { float* fp = fb + r * 2048 + col0 + bj * HALF; *(f32x4*)fp = v0; *(f32x4*)(fp + 4) = v1; } } }
    }
};
struct EpiLora {
    static constexpr bool PERM = true, AFTER_DRAIN = false;
    bf16_t* OUT[5]; const float *w0, *a0;
    __device__ __forceinline__ void operator()(const f32x4 (&acc)[2][2][4][2], const Unit& u, int wr, int wc, int fr, int fq) const {
        const int row0 = u.pm * BM + wr * 64 + fr, sel = u.pn >> 3, colt = (u.pn & 7) * 256, col0 = colt + wc * 32 + 8 * fq;
        bf16_t* base = sel == 0 ? OUT[0] : sel == 1 ? OUT[1] : sel == 2 ? OUT[2] : sel == 3 ? OUT[3] : OUT[4];
        const float* bias = sel < 2 ? w0 + sel * 2048 : a0 + (sel - 2) * 2048;
        f32x4 bv[2][2];
#pragma unroll
        for (int bj = 0; bj < 2; ++bj)
#pragma unroll
            for (int n = 0; n < 2; ++n) bv[bj][n] = sel < 4 ? *(const f32x4*)(bias + col0 + bj * HALF + 4 * n) : (f32x4){0.f, 0.f, 0.f, 0.f};
#pragma unroll
        for (int ai = 0; ai < 2; ++ai)
#pragma unroll
            for (int m = 0; m < 4; ++m) { bf16_t* rowp = base + (size_t)(row0 + ai * HALF + m * 16) * 2048 + col0;
#pragma unroll
                for (int bj = 0; bj < 2; ++bj) { f32x4 v0 = acc[ai][bj][m][0] + bv[bj][0], v1 = acc[ai][bj][m][1] + bv[bj][1];
                    if (sel < 4) {
#pragma unroll
                        for (int e = 0; e < 4; ++e) { v0[e] = sigmoidf_(v0[e]); v1[e] = sigmoidf_(v1[e]); }
                        if (sel < 2) {
#pragma unroll
                            for (int e = 0; e < 4; ++e) { v0[e] = __builtin_amdgcn_exp2f(-0.87503716f * v0[e]); v1[e] = __builtin_amdgcn_exp2f(-0.87503716f * v1[e]); } } }
                    u32x4 w; w.x = cvt_pk_f16(v0[0], v0[1]); w.y = cvt_pk_f16(v0[2], v0[3]); w.z = cvt_pk_f16(v1[0], v1[1]); w.w = cvt_pk_f16(v1[2], v1[3]);
                    *(u32x4*)(rowp + bj * HALF) = w; } }
    }
};
template <bool ADD> struct EpiGate {
    static constexpr bool PERM = true, AFTER_DRAIN = false;
    bf16_t* O; const bf16_t* G; int goff;
    __device__ __forceinline__ void operator()(const f32x4 (&acc)[2][2][4][2], const Unit& u, int wr, int wc, int fr, int fq) const {
        const int row0 = u.pm * BM + wr * 64 + fr, col0 = u.pn * BM + wc * 32 + 8 * fq;
#pragma unroll
        for (int ai = 0; ai < 2; ++ai)
#pragma unroll
            for (int m = 0; m < 4; ++m) { const size_t r = (size_t)(row0 + ai * HALF + m * 16); bf16_t* rowp = O + r * 4096 + col0; const bf16_t* gp = G + r * 8192 + goff + col0;
#pragma unroll
                for (int bj = 0; bj < 2; ++bj) { const u32x4 g = *(const u32x4*)(gp + bj * HALF); const f32x4 a0 = acc[ai][bj][m][0], a1 = acc[ai][bj][m][1];
                    float o[8] = {a0[0] * bf_lo(g.x), a0[1] * bf_hi(g.x), a0[2] * bf_lo(g.y), a0[3] * bf_hi(g.y), a1[0] * bf_lo(g.z), a1[1] * bf_hi(g.z), a1[2] * bf_lo(g.w), a1[3] * bf_hi(g.w)};
                    if (ADD) { const u32x4 p = *(const u32x4*)(rowp + bj * HALF); o[0] += bf_lo(p.x); o[1] += bf_hi(p.x); o[2] += bf_lo(p.y); o[3] += bf_hi(p.y); o[4] += bf_lo(p.z); o[5] += bf_hi(p.z); o[6] += bf_lo(p.w); o[7] += bf_hi(p.w); }
                    u32x4 w; w.x = cvt_pk_bf16(o[0], o[1]); w.y = cvt_pk_bf16(o[2], o[3]); w.z = cvt_pk_bf16(o[4], o[5]); w.w = cvt_pk_bf16(o[6], o[7]);
                    *(u32x4*)(rowp + bj * HALF) = w; } }
    }
};
struct EpiResid {
    static constexpr bool PERM = false, AFTER_DRAIN = false;
    const float* R; float* Y; const float* gt; int jbase, ppb, jmul;
    __device__ __forceinline__ void operator()(const f32x4 (&acc)[2][2][4][2], const Unit& u, int wr, int wc, int fr, int fq) const {
        const int row0 = u.pm * BM + wr * 64 + fr, col0 = u.pn * BM + wc * 32 + 4 * fq;
        const float* g = gt + (size_t)(jbase + (u.pm / ppb) * jmul) * 24576 + col0;
        f32x4 gv[2][2];
#pragma unroll
        for (int bj = 0; bj < 2; ++bj)
#pragma unroll
            for (int n = 0; n < 2; ++n) gv[bj][n] = *(const f32x4*)(g + bj * HALF + n * 16);
#pragma unroll
        for (int ai = 0; ai < 2; ++ai)
#pragma unroll
            for (int m = 0; m < 4; ++m) { const size_t off = (size_t)(row0 + ai * HALF + m * 16) * 4096 + col0;
#pragma unroll
                for (int bj = 0; bj < 2; ++bj)
#pragma unroll
                    for (int n = 0; n < 2; ++n) { const f32x4 r = *(const f32x4*)(R + off + bj * HALF + n * 16); *(f32x4*)(Y + off + bj * HALF + n * 16) = r + gv[bj][n] * acc[ai][bj][m][n]; } }
    }
};
struct EpiRelu2 {
    static constexpr bool PERM = true, AFTER_DRAIN = false;
    bf16_t* U;
    __device__ __forceinline__ void operator()(const f32x4 (&acc)[2][2][4][2], const Unit& u, int wr, int wc, int fr, int fq) const {
        const int row0 = u.pm * BM + wr * 64 + fr, col0 = u.pn * BM + wc * 32 + 8 * fq;
#pragma unroll
        for (int ai = 0; ai < 2; ++ai)
#pragma unroll
            for (int m = 0; m < 4; ++m) { bf16_t* rowp = U + (size_t)(row0 + ai * HALF + m * 16) * 16384 + col0;
#pragma unroll
                for (int bj = 0; bj < 2; ++bj) { f32x4 v0 = acc[ai][bj][m][0], v1 = acc[ai][bj][m][1];
#pragma unroll
                    for (int e = 0; e < 4; ++e) { const float a = fmaxf(v0[e], 0.f), b = fmaxf(v1[e], 0.f); v0[e] = a * a; v1[e] = b * b; }
                    u32x4 w; w.x = cvt_pk_bf16(v0[0], v0[1]); w.y = cvt_pk_bf16(v0[2], v0[3]); w.z = cvt_pk_bf16(v1[0], v1[1]); w.w = cvt_pk_bf16(v1[2], v1[3]);
                    *(u32x4*)(rowp + bj * HALF) = w; } }
    }
};

template <class Epi, class Sched, bool ALIGN_EPI = false, bool SP2 = false>
__device__ __forceinline__ void gemm_phase(PG8_LAS unsigned char* lds, const Gemm g, const Sched& S, const Epi& E) {
    int tid_ = threadIdx.x; asm volatile("" : "+v"(tid_));
    const int tid = tid_, wid = __builtin_amdgcn_readfirstlane(tid >> 6), lane = tid & 63, wr = wid >> 2, wc = wid & 3, fr = lane & 15, fq = lane >> 4;
    const int K = g.K, nt = K / BK;
    unsigned voffA[2], voffB[2];
#pragma unroll
    for (int i = 0; i < 2; ++i) { int R, C; stage_rc(tid * 16 + i * 8192, R, C); const int Rb = Epi::PERM ? ((R & ~31) + perm32(R & 31)) : R;
        voffA[i] = (unsigned)(R * K + C) * 2u; voffB[i] = (unsigned)(Rb * K + C) * 2u; }
    const size_t kstep = (size_t)(BK * 2);
    const size_t hstep = (size_t)HALF * K * 2;
    const size_t tstep = 2 * hstep;
    const unsigned ldsw = (unsigned)wid * 1024u;
    const int aoff = lds_byte(wr * 64 + fr, fq * 8), boff = lds_byte(wc * 32 + fr, fq * 8);
#define PG8_SA(b, h) (((b) * 2 + (h)) * HTB)
#define PG8_SB(b, h) ((4 + (b) * 2 + (h)) * HTB)
#define PG8_STAGE(bufoff, gbase, voff) do { _Pragma("unroll") for (int _i = 0; _i < 2; ++_i) \
        __builtin_amdgcn_global_load_lds((const unsigned*)((const char*)(gbase) + (voff)[_i]), (PG8_LAS unsigned*)(lds + (bufoff) + ldsw + _i * 8192), 16, 0, 0); } while (0)
#define PG8_LDA(dst, b, h) do { _Pragma("unroll") for (int m = 0; m < 4; ++m) _Pragma("unroll") for (int k = 0; k < 2; ++k) dst[m][k] = *(const PG8_LAS bf16x8*)(lds + PG8_SA(b, h) + aoff + m * 2048 + k * 1024); } while (0)
#define PG8_LDB(dst, b, h) do { _Pragma("unroll") for (int n = 0; n < 2; ++n) _Pragma("unroll") for (int k = 0; k < 2; ++k) dst[n][k] = *(const PG8_LAS bf16x8*)(lds + PG8_SB(b, h) + boff + n * 2048 + k * 1024); } while (0)
#define PG8_MMA(ai, bj, At, Bt) do { __builtin_amdgcn_s_setprio(1); _Pragma("unroll") for (int m = 0; m < 4; ++m) _Pragma("unroll") for (int n = 0; n < 2; ++n) _Pragma("unroll") for (int k = 0; k < 2; ++k) \
        acc[ai][bj][m][n] = __builtin_amdgcn_mfma_f32_16x16x32_bf16(Bt[n][k], At[m][k], acc[ai][bj][m][n], 0, 0, 0); __builtin_amdgcn_s_setprio(0); } while (0)
#define PG8_WAIT_V(n) asm volatile("s_waitcnt vmcnt(" #n ")" ::: "memory")
#define PG8_WAIT_L(n) asm volatile("s_waitcnt lgkmcnt(" #n ")" ::: "memory")
#define PG8_BAR __builtin_amdgcn_s_barrier()
#define PG8_SCHED __builtin_amdgcn_sched_barrier(0)
    Unit cur, nxt; int ui = 0;
    if (!S.next(0, cur)) return;
    f32x4 acc[2][2][4][2];
#pragma unroll
    for (int a = 0; a < 2; ++a)
#pragma unroll
        for (int b = 0; b < 2; ++b)
#pragma unroll
            for (int m = 0; m < 4; ++m)
#pragma unroll
                for (int n = 0; n < 2; ++n) acc[a][b][m][n] = (f32x4){0.f, 0.f, 0.f, 0.f};
    bf16x8 At[4][2], B0[2][2], B1[2][2];
    const char* cA = (const char*)g.A + (size_t)cur.pm * tstep; const char* cB = (const char*)g.Bt + (size_t)cur.pn * tstep;
    S.a_ready(cur);
    if constexpr (SP2) {
        PG8_STAGE(PG8_SB(0, 0), cB, voffB); PG8_STAGE(PG8_SB(0, 1), cB + hstep, voffB); PG8_STAGE(PG8_SA(0, 0), cA, voffA); PG8_STAGE(PG8_SA(0, 1), cA + hstep, voffA);
        if (wr == 1) PG8_BAR;
        PG8_WAIT_V(2); PG8_BAR;
        PG8_STAGE(PG8_SB(1, 0), cB + kstep, voffB); PG8_STAGE(PG8_SA(1, 0), cA + kstep, voffA); PG8_STAGE(PG8_SB(1, 1), cB + hstep + kstep, voffB);
        PG8_WAIT_V(6); PG8_BAR;
    } else {
        PG8_STAGE(PG8_SB(0, 0), cB, voffB); PG8_STAGE(PG8_SA(0, 0), cA, voffA); PG8_STAGE(PG8_SB(0, 1), cB + hstep, voffB); PG8_STAGE(PG8_SA(0, 1), cA + hstep, voffA);
        if (wr == 1) PG8_BAR;
        PG8_WAIT_V(4); PG8_BAR;
        PG8_STAGE(PG8_SB(1, 0), cB + kstep, voffB); PG8_STAGE(PG8_SA(1, 0), cA + kstep, voffA); PG8_STAGE(PG8_SB(1, 1), cB + hstep + kstep, voffB);
        PG8_WAIT_V(6); PG8_BAR;
    }
    for (;;) {
        const bool has_next = S.next(ui + 1, nxt);
        const char* nA = has_next ? (const char*)g.A + (size_t)nxt.pm * tstep : cA; const char* nB = has_next ? (const char*)g.Bt + (size_t)nxt.pn * tstep : cB;
        for (int t = 0; t < nt; t += 2) {
            const bool last = (t == nt - 2);
            const char* a1 = cA + (size_t)(t + 1) * kstep;
            const char* a2 = last ? nA : cA + (size_t)(t + 2) * kstep; const char* b2 = last ? nB : cB + (size_t)(t + 2) * kstep;
            const char* a3 = a2 + kstep; const char* b3 = b2 + kstep;
            if (last && has_next) S.a_ready(nxt);
            if constexpr (SP2) {
            PG8_LDB(B0, 0, 0); PG8_LDB(B1, 0, 1); PG8_SCHED; PG8_LDA(At, 0, 0); PG8_STAGE(PG8_SA(1, 1), a1 + hstep, voffA);
            PG8_WAIT_V(8); PG8_WAIT_L(0); PG8_BAR; PG8_MMA(0, 0, At, B0); PG8_MMA(0, 1, At, B1); PG8_BAR; PG8_SCHED;
            PG8_LDA(At, 0, 1); PG8_STAGE(PG8_SB(0, 0), b2, voffB); PG8_STAGE(PG8_SB(0, 1), b2 + hstep, voffB); PG8_STAGE(PG8_SA(0, 0), a2, voffA);
            PG8_WAIT_V(8); PG8_WAIT_L(0); PG8_BAR; PG8_MMA(1, 0, At, B0); PG8_MMA(1, 1, At, B1); PG8_BAR; PG8_SCHED;
            PG8_LDB(B0, 1, 0); PG8_LDB(B1, 1, 1); PG8_SCHED; PG8_LDA(At, 1, 0); PG8_STAGE(PG8_SA(0, 1), a2 + hstep, voffA);
            PG8_WAIT_V(8); PG8_WAIT_L(0); PG8_BAR; PG8_MMA(0, 0, At, B0); PG8_MMA(0, 1, At, B1); PG8_BAR; PG8_SCHED;
            PG8_LDA(At, 1, 1); PG8_STAGE(PG8_SB(1, 0), b3, voffB); PG8_STAGE(PG8_SB(1, 1), b3 + hstep, voffB); PG8_STAGE(PG8_SA(1, 0), a3, voffA);
            PG8_WAIT_V(8); PG8_WAIT_L(0); PG8_BAR; PG8_MMA(1, 0, At, B0); PG8_MMA(1, 1, At, B1); PG8_BAR; PG8_SCHED;
            } else {
            PG8_LDB(B0, 0, 0); PG8_SCHED; PG8_LDA(At, 0, 0); PG8_STAGE(PG8_SA(1, 1), a1 + hstep, voffA);
            PG8_WAIT_L(8); PG8_BAR; PG8_WAIT_L(0); PG8_MMA(0, 0, At, B0); PG8_BAR; PG8_SCHED;
            PG8_LDB(B1, 0, 1); PG8_STAGE(PG8_SB(0, 0), b2, voffB);
            PG8_BAR; PG8_WAIT_L(0); PG8_MMA(0, 1, At, B1); PG8_BAR;
            PG8_LDA(At, 0, 1); PG8_STAGE(PG8_SA(0, 0), a2, voffA);
            PG8_BAR; PG8_WAIT_L(0); PG8_MMA(1, 0, At, B0); PG8_BAR; PG8_SCHED;
            PG8_STAGE(PG8_SB(0, 1), b2 + hstep, voffB);
            PG8_WAIT_V(6); PG8_BAR; PG8_MMA(1, 1, At, B1); PG8_BAR;
            PG8_LDB(B0, 1, 0); PG8_SCHED; PG8_LDA(At, 1, 0); PG8_STAGE(PG8_SA(0, 1), a2 + hstep, voffA);
            PG8_WAIT_L(8); PG8_BAR; PG8_WAIT_L(0); PG8_MMA(0, 0, At, B0); PG8_BAR; PG8_SCHED;
            PG8_LDB(B1, 1, 1); PG8_STAGE(PG8_SB(1, 0), b3, voffB);
            PG8_BAR; PG8_WAIT_L(0); PG8_MMA(0, 1, At, B1); PG8_BAR;
            PG8_LDA(At, 1, 1); PG8_STAGE(PG8_SA(1, 0), a3, voffA);
            PG8_BAR; PG8_WAIT_L(0); PG8_MMA(1, 0, At, B0); PG8_BAR; PG8_SCHED;
            PG8_STAGE(PG8_SB(1, 1), b3 + hstep, voffB);
            PG8_WAIT_V(6); PG8_BAR; PG8_MMA(1, 1, At, B1); PG8_BAR;
            }
        }
        if constexpr (ALIGN_EPI) { if (wr == 0) PG8_BAR; }
        if constexpr (!Epi::AFTER_DRAIN) { E(acc, cur, wr, wc, fr, fq); S.done(cur); }
        if (!has_next) break;
#pragma unroll
        for (int a = 0; a < 2; ++a)
#pragma unroll
            for (int b = 0; b < 2; ++b)
#pragma unroll
                for (int m = 0; m < 4; ++m)
#pragma unroll
                    for (int n = 0; n < 2; ++n) acc[a][b][m][n] = (f32x4){0.f, 0.f, 0.f, 0.f};
        cur = nxt; cA = nA; cB = nB; ++ui;
        if constexpr (ALIGN_EPI) { if (wr == 1) PG8_BAR; }
    }
    PG8_WAIT_V(0);
    if constexpr (!ALIGN_EPI) { if (wr == 0) PG8_BAR; }
    PG8_BAR;
    if constexpr (Epi::AFTER_DRAIN) { E.fused(acc, cur, wr, wc, fr, fq, lds, wid, lane); S.done(cur); }
#undef PG8_SA
#undef PG8_SB
#undef PG8_STAGE
#undef PG8_LDA
#undef PG8_LDB
#undef PG8_MMA
#undef PG8_WAIT_V
#undef PG8_WAIT_L
#undef PG8_BAR
#undef PG8_SCHED
}
}

constexpr int NWAVES = 8;
constexpr int DM = 4096, T_CTX = 8192, T_LAT = 32768, L_CTX = 256, L_LAT = 4096, B_CTX = 32, B_LAT = 8;
constexpr int NH_A = 16, DH_A = 128, D_ATT = 2048, NH_R = 32, DH_R = 64, D_RW = 2048;
constexpr int C_RWKV = 6592, C_RWKV_P = 6656, D_IN = 20928, N_IN_P = 20992, D_FF = 16384, N_LORA = 10240, K_LORA = 512, NMOD = 24576;
constexpr float RMS_EPS = 1e-6f, LNX_EPS = 64e-5f;
constexpr size_t MiB = 1u << 20;
constexpr size_t WS_CTL = 0, CTL_ZERO_BYTES = 1 * MiB;
constexpr size_t WS_MODP = 1 * MiB;
constexpr size_t WS_MOD = 8 * MiB;
constexpr size_t WS_WIN = 9 * MiB;
constexpr size_t WS_WOA = 173 * MiB, WS_WOR = 189 * MiB, WS_WOUT = 205 * MiB;
constexpr size_t WS_WM1 = 237 * MiB, WS_WM2 = 365 * MiB;
constexpr size_t WS_WLORA = 493 * MiB;
constexpr size_t WS_CK = 503 * MiB, WS_CV = 511 * MiB;
constexpr size_t WS_H = 520 * MiB;
constexpr size_t WS_Q = 776 * MiB, WS_K = 904 * MiB, WS_V = 1032 * MiB;
constexpr size_t WS_PR = 1160 * MiB;
constexpr size_t WS_ORW = 1576 * MiB;
constexpr size_t WS_LG = 1704 * MiB, WS_LA = 1768 * MiB;
constexpr size_t WS_YF = 1784 * MiB, WS_YB = 1848 * MiB;
constexpr size_t WS_U = 776 * MiB;
constexpr size_t WS_END = 1912 * MiB;
constexpr size_t WS_RS = WS_H, WS_KS = WS_H + 64 * MiB, WS_VS = WS_H + 128 * MiB, WS_KK = WS_H + 192 * MiB;
constexpr size_t WS_DF = WS_K, WS_DB = WS_K + 64 * MiB, WS_AF = WS_V, WS_AB = WS_V + 64 * MiB;
static_assert(WS_U + (size_t)T_LAT * D_FF * 2 <= WS_END + 0 * MiB || true, "");
constexpr int CW_BAR = 4096;
constexpr int RING_OFF = 0, RING_BYTES = 131072;
constexpr int LDSCTL_OFF = RING_BYTES, MISC_OFF = LDSCTL_OFF + 320;
constexpr int LDS_BYTES = 147456;

#define GAS __attribute__((address_space(1)))
#define LAS __attribute__((address_space(3)))
typedef unsigned short bf16;
typedef unsigned v4u __attribute__((ext_vector_type(4)));
typedef float f32x4 __attribute__((ext_vector_type(4)));
typedef short bf16x8 __attribute__((ext_vector_type(8)));
typedef GAS unsigned gu32;
typedef GAS unsigned long long gu64;
#define RLX_AGENT __ATOMIC_RELAXED, __HIP_MEMORY_SCOPE_AGENT
#define LDS_WAIT() asm volatile("s_waitcnt lgkmcnt(0)" ::: "memory")
#define VM_WAIT() asm volatile("s_waitcnt vmcnt(0)" ::: "memory")
__device__ __forceinline__ unsigned long long rt() { return __builtin_amdgcn_s_memrealtime(); }
__device__ __forceinline__ unsigned f2bf(float f) { unsigned u = __builtin_bit_cast(unsigned, f); return (u + 0x7fffu + ((u >> 16) & 1u)) >> 16; }
__device__ __forceinline__ unsigned pk2(float lo, float hi) { return f2bf(lo) | (f2bf(hi) << 16); }

#define XB_TMO      128
#define XB_XCNT(j)  (256  + 64 * (j))
#define XB_XSUB(j)  (1280 + 64 * (j))
#define XB_XGEN(j)  (2304 + 64 * (j))
#define XB_TOP      3328
#define XB_TOPGEN   3392
#define XCD_BAR_WORDS 3456
#define XB_SPIN_CAP (1u << 18)

__device__ __forceinline__ unsigned xb_ld(unsigned* p)              { return __hip_atomic_load(p, __ATOMIC_RELAXED, __HIP_MEMORY_SCOPE_AGENT); }
__device__ __forceinline__ unsigned xb_add(unsigned* p, unsigned v) { return __hip_atomic_fetch_add(p, v, __ATOMIC_RELAXED, __HIP_MEMORY_SCOPE_AGENT); }
__device__ __forceinline__ unsigned xb_xcc_id() { return (unsigned)__builtin_amdgcn_s_getreg((3 << 11) | 20) & 0xFu; }
#define XB_SPIN(cond, bar) do { unsigned _sp = 0; while (cond) { __builtin_amdgcn_s_sleep(1); \
    if ((++_sp & 255u) == 0u) { if (xb_ld(&(bar)[XB_TMO])) break; if (_sp > XB_SPIN_CAP) { atomicAdd(&(bar)[XB_TMO], 1u); break; } } } } while (0)

struct XcdBarrier {
    unsigned* bar; unsigned x;
    volatile LAS unsigned* st;
};

__device__ __forceinline__ XcdBarrier xcd_barrier_post(unsigned* bar, volatile LAS unsigned* st) {
    XcdBarrier b; b.bar = bar; b.x = xb_xcc_id(); b.st = st;
    if (threadIdx.x == 0) (void)xb_add(&bar[XB_XCNT(b.x)], 1u);
    return b;
}
__device__ __forceinline__ void xcd_barrier_complete(unsigned* bar, unsigned x, unsigned& nloc, unsigned& nx) {
    const unsigned G = gridDim.x * gridDim.y * gridDim.z;
    unsigned sum, cnt, mine, sp = 0u;
    for (;;) {
        sum = 0u; cnt = 0u; mine = 0u;
#pragma unroll
        for (unsigned j = 0; j < 16; ++j) { const unsigned c = xb_ld(&bar[XB_XCNT(j)]); sum += c; cnt += (c > 0u) ? 1u : 0u; mine = (j == x) ? c : mine; }
        if (sum == G) break;
        __builtin_amdgcn_s_sleep(1);
        if ((++sp & 255u) == 0u) { if (xb_ld(&bar[XB_TMO])) break; if (sp > XB_SPIN_CAP) { atomicAdd(&bar[XB_TMO], 1u); break; } }
    }
    nloc = mine > 0u ? mine : 1u; nx = cnt > 0u ? cnt : 1u;
}

__device__ __forceinline__ void xcd_barrier(const XcdBarrier& b) {
    asm volatile("s_waitcnt vmcnt(0)" ::: "memory");
    __syncthreads();
    if (threadIdx.x == 0) {
        unsigned* bar = b.bar;
        __builtin_amdgcn_s_waitcnt(0);
        unsigned nloc = b.st[0], nx = b.st[1];
        if (nloc == 0u) { xcd_barrier_complete(bar, b.x, nloc, nx); b.st[0] = nloc; b.st[1] = nx; }
        const unsigned old = xb_add(&bar[XB_XSUB(b.x)], 1u);
        const unsigned gen = old / nloc;
        if (old + 1u == (gen + 1u) * nloc) {
            __builtin_amdgcn_fence(__ATOMIC_RELEASE, "agent");
            asm volatile("s_waitcnt vmcnt(0)" ::: "memory");
            const unsigned og = xb_add(&bar[XB_TOP], 1u);
            const unsigned tg = og / nx;
            if (og + 1u == (tg + 1u) * nx) xb_add(&bar[XB_TOPGEN], 1u);
            else XB_SPIN(xb_ld(&bar[XB_TOPGEN]) == tg, bar);
            __builtin_amdgcn_fence(__ATOMIC_ACQUIRE, "agent");
            xb_add(&bar[XB_XGEN(b.x)], 1u);
            asm volatile("s_waitcnt vmcnt(0)" ::: "memory");
        } else {
            XB_SPIN(xb_ld(&bar[XB_XGEN(b.x)]) == gen, bar);
            __builtin_amdgcn_fence(__ATOMIC_ACQUIRE, "agent");
            asm volatile("s_waitcnt vmcnt(0)" ::: "memory");
        }
    }
    __syncthreads();
}

typedef unsigned short h16s;
typedef _Float16 h16x8 __attribute__((ext_vector_type(8)));
typedef float f32x16 __attribute__((ext_vector_type(16)));
typedef short s16x4 __attribute__((ext_vector_type(4)));
struct Frame {
    LAS unsigned char* lds;
    volatile LAS unsigned* MISC;
    gu32* ctl;
    int tid, lane, wave;
    int vcu, G;
    unsigned char* ws;
    float* out;
};
struct Args { const float* in[31]; float* out; unsigned char* ws; };
enum { I_XP = 0, I_XS, I_CK, I_CV, I_SF, I_SB, I_C, I_CCTX, I_WMOD, I_BMOD, I_N1, I_N2, I_NF, I_WIN, I_MU, I_RPB, I_W0, I_W2, I_A0, I_A2, I_G2, I_KK, I_KA, I_RK, I_LNW, I_LNB, I_WOA, I_WOR, I_WOUT, I_WM1, I_WM2 };
constexpr size_t O_Y = 0, O_NK = (size_t)(T_CTX + T_LAT) * DM, O_NV = O_NK + (size_t)T_CTX * D_ATT, O_SF = O_NV + (size_t)T_CTX * D_ATT, O_SB = O_SF + (size_t)B_CTX * NH_R * 64 * 64;

__device__ __forceinline__ float wave_sum(float v) {
#pragma unroll
    for (int o = 1; o < 64; o <<= 1) v += __shfl_xor(v, o);
    return v;
}
__device__ __forceinline__ unsigned pkbf(float lo, float hi) { return pg8::cvt_pk_bf16(lo, hi); }
__device__ __forceinline__ unsigned pkh(float lo, float hi) { return pg8::cvt_pk_f16(lo, hi); }
__device__ __forceinline__ float sigm(float x) { return pg8::sigmoidf_(x); }
__device__ __forceinline__ void unpack_h8(const v4u w, float (&f)[8]) { const h16x8 h = __builtin_bit_cast(h16x8, w);
#pragma unroll
    for (int e = 0; e < 8; ++e) f[e] = (float)h[e]; }

__device__ __forceinline__ void p0_transpose_item(const float* W, int ldw, int col_off, int nblk, bf16* WT, int ldt, int row_off, LAS float* scr, int item, int lane) {
    const int kb = item / nblk, nb = item % nblk, k0 = 64 * kb, n0 = 32 * nb;
#pragma unroll 8
    for (int i = 0; i < 32; ++i) { const int kk = 2 * i + (lane >> 5); scr[kk * 33 + (lane & 31)] = W[(size_t)(k0 + kk) * ldw + col_off + n0 + (lane & 31)]; }
    LDS_WAIT(); asm volatile("" ::: "memory");
    const int c = lane & 7;
#pragma unroll
    for (int j = 0; j < 4; ++j) { const int n = (lane >> 3) + 8 * j; const LAS float* s = scr + (8 * c) * 33 + n;
        v4u o; o.x = pkbf(s[0 * 33], s[1 * 33]); o.y = pkbf(s[2 * 33], s[3 * 33]); o.z = pkbf(s[4 * 33], s[5 * 33]); o.w = pkbf(s[6 * 33], s[7 * 33]);
        *(GAS v4u*)(WT + (size_t)(row_off + n0 + n) * ldt + k0 + 8 * c) = o; }
    LDS_WAIT(); asm volatile("" ::: "memory");
}
__device__ __forceinline__ void p0_prologue(Frame& F, const Args& A) {
    const int gw = F.vcu * NWAVES + F.wave, NGW = F.G * NWAVES, gt = gw * 64 + F.lane, NGT = NGW * 64;
    unsigned char* ws = F.ws;
    { LAS float* scr = (LAS float*)(F.lds + RING_OFF + F.wave * 16384);
      constexpr int I_A = 64 * 398, I_B = 64 * 256, I_OA = 32 * 128, I_OR = 32 * 128, I_OUT = 64 * 128, I_M1 = 64 * 512, I_M2 = 256 * 128;
      constexpr int NITEMS = I_A + I_B + I_OA + I_OR + I_OUT + I_M1 + I_M2;
      for (int it = gw; it < NITEMS; it += NGW) { int r = it;
          if (r < I_A) { p0_transpose_item(A.in[I_WIN], D_IN, 0, 398, (bf16*)(ws + WS_WIN), DM, 0, scr, r, F.lane); continue; } r -= I_A;
          if (r < I_B) { p0_transpose_item(A.in[I_WIN], D_IN, 12736, 256, (bf16*)(ws + WS_WIN), DM, 12800, scr, r, F.lane); continue; } r -= I_B;
          if (r < I_OA) { p0_transpose_item(A.in[I_WOA], DM, 0, 128, (bf16*)(ws + WS_WOA), D_ATT, 0, scr, r, F.lane); continue; } r -= I_OA;
          if (r < I_OR) { p0_transpose_item(A.in[I_WOR], DM, 0, 128, (bf16*)(ws + WS_WOR), D_RW, 0, scr, r, F.lane); continue; } r -= I_OR;
          if (r < I_OUT) { p0_transpose_item(A.in[I_WOUT], DM, 0, 128, (bf16*)(ws + WS_WOUT), DM, 0, scr, r, F.lane); continue; } r -= I_OUT;
          if (r < I_M1) { p0_transpose_item(A.in[I_WM1], D_FF, 0, 512, (bf16*)(ws + WS_WM1), DM, 0, scr, r, F.lane); continue; } r -= I_M1;
          p0_transpose_item(A.in[I_WM2], DM, 0, 128, (bf16*)(ws + WS_WM2), D_FF, 0, scr, r, F.lane);
      } }
    { GAS v4u* p = (GAS v4u*)((bf16*)(ws + WS_WIN) + (size_t)12736 * DM); const int n = 64 * DM / 8; for (int i = gt; i < n; i += NGT) p[i] = (v4u){0u, 0u, 0u, 0u}; }
    { bf16* WL = (bf16*)(ws + WS_WLORA); const float *w2 = A.in[I_W2], *a2 = A.in[I_A2], *g2 = A.in[I_G2];
      for (int i = gt; i < N_LORA * K_LORA / 2; i += NGT) { const int n = i / (K_LORA / 2), k = (i % (K_LORA / 2)) * 2; const int sel = n >> 11, col = n & 2047; float v[2];
#pragma unroll
          for (int e = 0; e < 2; ++e) { const int kk = k + e; float x = 0.f;
              if (sel < 2) { if (kk < 96) x = w2[((size_t)sel * 96 + kk) * 2048 + col]; }
              else if (sel < 4) { if (kk >= 96 && kk < 192) x = a2[((size_t)(sel - 2) * 96 + (kk - 96)) * 2048 + col]; }
              else { if (kk >= 192 && kk < 448) x = g2[(size_t)(kk - 192) * 2048 + col]; }
              v[e] = x; }
          ((GAS unsigned*)WL)[i] = pkbf(v[0], v[1]); } }
    { const int n8 = B_LAT * 256 * 2048 / 8;
      for (int i = gt; i < 2 * n8; i += NGT) { const bool isk = i < n8; const int j = isk ? i : i - n8; const float* src = (isk ? A.in[I_CK] : A.in[I_CV]) + (size_t)j * 8;
          const f32x4 a = *(const GAS f32x4*)src, b = *(const GAS f32x4*)(src + 4); v4u o; o.x = pkbf(a.x, a.y); o.y = pkbf(a.z, a.w); o.z = pkbf(b.x, b.y); o.w = pkbf(b.z, b.w);
          *((GAS v4u*)(ws + (isk ? WS_CK : WS_CV)) + j) = o; } }
    { LAS float* sc = (LAS float*)(F.lds + RING_OFF); LAS float* red = sc + 9 * 512; const float* wm = A.in[I_WMOD]; float* MODP = (float*)(ws + WS_MODP);
      for (int it = F.vcu; it < 96 * 8; it += F.G) { const int cb = it % 96, ks = it / 96;
          for (int idx = F.tid; idx < 9 * 512; idx += NWAVES * 64) { const int j = idx >> 9, kk = idx & 511, k = ks * 512 + kk; const float c = j == 0 ? A.in[I_CCTX][k] : A.in[I_C][(size_t)(j - 1) * DM + k]; sc[idx] = c * sigm(c); }
          __syncthreads();
          f32x4 acc[9];
#pragma unroll
          for (int j = 0; j < 9; ++j) acc[j] = (f32x4){0.f, 0.f, 0.f, 0.f};
          const float* wp = wm + (size_t)(ks * 512 + F.wave * 64) * NMOD + cb * 256 + F.lane * 4;
#pragma unroll 8
          for (int r = 0; r < 64; ++r) { const f32x4 w4 = *(const GAS f32x4*)(wp + (size_t)r * NMOD); const int kk = F.wave * 64 + r;
#pragma unroll
              for (int j = 0; j < 9; ++j) acc[j] += w4 * sc[j * 512 + kk]; }
#pragma unroll
          for (int j = 0; j < 9; ++j) *(LAS f32x4*)(red + (F.wave * 9 + j) * 256 + F.lane * 4) = acc[j];
          __syncthreads();
          for (int idx = F.tid; idx < 9 * 256; idx += NWAVES * 64) { const int j = idx >> 8, c = idx & 255; float s = 0.f;
#pragma unroll
              for (int w = 0; w < 8; ++w) s += red[(w * 9 + j) * 256 + c];
              MODP[((size_t)ks * 9 + j) * NMOD + cb * 256 + c] = s; }
          __syncthreads(); } }
}
__device__ __forceinline__ void p0b_mod_finalize(Frame& F, const Args& A) {
    const int gt = (F.vcu * NWAVES + F.wave) * 64 + F.lane, NGT = F.G * NWAVES * 64; const float* MODP = (const float*)(F.ws + WS_MODP); float* MOD = (float*)(F.ws + WS_MOD);
    for (int i = gt; i < 9 * NMOD; i += NGT) { const int n = i % NMOD; float s = A.in[I_BMOD][n];
#pragma unroll
        for (int ks = 0; ks < 8; ++ks) s += MODP[(size_t)ks * 9 * NMOD + i];
        MOD[i] = s; }
}
__device__ __forceinline__ void modnorm_rows(Frame& F, const float* X, int M, const float* nw, int sh_off, int sc_off, int jbase, int rps, int jmul, bf16* H) {
    const int gw = F.vcu * NWAVES + F.wave, NGW = F.G * NWAVES; const float* MOD = (const float*)(F.ws + WS_MOD);
    for (int row = gw; row < M; row += NGW) {
        const float* xr = X + (size_t)row * DM + F.lane * 8; f32x4 v[8][2]; float ss = 0.f;
#pragma unroll
        for (int c = 0; c < 8; ++c) { v[c][0] = *(const GAS f32x4*)(xr + c * 512); v[c][1] = *(const GAS f32x4*)(xr + c * 512 + 4);
            ss += (v[c][0].x * v[c][0].x + v[c][0].y * v[c][0].y) + (v[c][0].z * v[c][0].z + v[c][0].w * v[c][0].w) + (v[c][1].x * v[c][1].x + v[c][1].y * v[c][1].y) + (v[c][1].z * v[c][1].z + v[c][1].w * v[c][1].w); }
        const float rstd = 1.0f / sqrtf(wave_sum(ss) * (1.0f / DM) + RMS_EPS);
        const float* mj = MOD + (size_t)(jbase + (row / rps) * jmul) * NMOD + F.lane * 8; bf16* hr = H + (size_t)row * DM + F.lane * 8;
#pragma unroll
        for (int c = 0; c < 8; ++c) { v4u o; unsigned ow[4];
#pragma unroll
            for (int h = 0; h < 2; ++h) { const f32x4 w4 = *(const GAS f32x4*)(nw + F.lane * 8 + c * 512 + 4 * h), s4 = *(const GAS f32x4*)(mj + sc_off + c * 512 + 4 * h), b4 = *(const GAS f32x4*)(mj + sh_off + c * 512 + 4 * h);
                const f32x4 y = v[c][h] * rstd * w4 * (s4 + 1.0f) + b4; ow[2 * h] = pkbf(y.x, y.y); ow[2 * h + 1] = pkbf(y.z, y.w); }
            o.x = ow[0]; o.y = ow[1]; o.z = ow[2]; o.w = ow[3]; *(GAS v4u*)(hr + c * 512) = o; }
    }
}
__device__ __forceinline__ void final_norm_rows(Frame& F, float* Y, int M, const float* nw) {
    const int gw = F.vcu * NWAVES + F.wave, NGW = F.G * NWAVES;
    for (int row = gw; row < M; row += NGW) {
        float* xr = Y + (size_t)row * DM + F.lane * 8; f32x4 v[8][2]; float ss = 0.f;
#pragma unroll
        for (int c = 0; c < 8; ++c) { v[c][0] = *(const GAS f32x4*)(xr + c * 512); v[c][1] = *(const GAS f32x4*)(xr + c * 512 + 4);
            ss += (v[c][0].x * v[c][0].x + v[c][0].y * v[c][0].y) + (v[c][0].z * v[c][0].z + v[c][0].w * v[c][0].w) + (v[c][1].x * v[c][1].x + v[c][1].y * v[c][1].y) + (v[c][1].z * v[c][1].z + v[c][1].w * v[c][1].w); }
        const float rstd = 1.0f / sqrtf(wave_sum(ss) * (1.0f / DM) + RMS_EPS);
#pragma unroll
        for (int c = 0; c < 8; ++c)
#pragma unroll
            for (int h = 0; h < 2; ++h) { const f32x4 w4 = *(const GAS f32x4*)(nw + F.lane * 8 + c * 512 + 4 * h); *(GAS f32x4*)(xr + c * 512 + 4 * h) = v[c][h] * rstd * w4; }
    }
}
namespace att {
constexpr float SCALE = 0.088388347648318440f, C = SCALE * 1.4426950408889634f;
constexpr int SHM_T = 16384;
constexpr int OFF_V = 0, OFF_K = 2 * SHM_T, OFF_WS = 4 * SHM_T, OFF_TAB = OFF_WS + 4096;
#define KSWZ(row, colB) ((row) * 256 + ((colB) ^ (((row) & 7) << 4)))
#define SBAR() __builtin_amdgcn_sched_barrier(0)
__device__ __forceinline__ int crow(int r, int hi) { return (r & 3) + 8 * (r >> 2) + 4 * hi; }
__device__ __forceinline__ void partialSM(f32x16& p0, f32x16& p1, float& m_reg, float& mn, float& alpha) {
  float pmax = p0[0];
#pragma unroll
  for (int r = 1; r < 16; ++r) pmax = fmaxf(pmax, p0[r]);
#pragma unroll
  for (int r = 0; r < 16; ++r) pmax = fmaxf(pmax, p1[r]);
  { auto rr = __builtin_amdgcn_permlane32_swap(__float_as_uint(pmax), __float_as_uint(pmax), false, false);
    pmax = fmaxf(__uint_as_float(rr[0]), __uint_as_float(rr[1])); }
  if (__all(pmax <= m_reg)) { mn = m_reg; alpha = 1.f; }
  else { mn = fmaxf(m_reg, pmax); alpha = __builtin_amdgcn_exp2f((m_reg - mn) * C); m_reg = mn; }
  const float mnC = -mn * C;
#pragma unroll
  for (int r = 0; r < 16; ++r) p0[r] = __builtin_amdgcn_exp2f(fmaf(p0[r], C, mnC));
#pragma unroll
  for (int r = 0; r < 16; ++r) p1[r] = __builtin_amdgcn_exp2f(fmaf(p1[r], C, mnC));
}
__device__ __forceinline__ void finishSM(f32x16& p0, f32x16& p1, float alpha, float& l_reg, bf16x8& pa0, bf16x8& pa1, bf16x8& pa2, bf16x8& pa3) {
  float ps = 0;
#pragma unroll
  for (int r = 0; r < 16; ++r) ps += p0[r];
#pragma unroll
  for (int r = 0; r < 16; ++r) ps += p1[r];
  { auto rr = __builtin_amdgcn_permlane32_swap(__float_as_uint(ps), __float_as_uint(ps), false, false);
    ps = __uint_as_float(rr[0]) + __uint_as_float(rr[1]); }
  l_reg = l_reg * alpha + ps;
#define PK4(P, BASE, OUT) do { unsigned a0 = pkbf(P[BASE + 0], P[BASE + 1]), a1 = pkbf(P[BASE + 2], P[BASE + 3]);   \
    unsigned b0 = pkbf(P[BASE + 4], P[BASE + 5]), b1 = pkbf(P[BASE + 6], P[BASE + 7]);                              \
    auto r0 = __builtin_amdgcn_permlane32_swap(a0, b0, false, false); auto r1 = __builtin_amdgcn_permlane32_swap(a1, b1, false, false); \
    v4u w = {r0[0], r1[0], r0[1], r1[1]}; OUT = __builtin_bit_cast(bf16x8, w); } while (0)
  PK4(p0, 0, pa0); PK4(p0, 8, pa1); PK4(p1, 0, pa2); PK4(p1, 8, pa3);
#undef PK4
}
__device__ __forceinline__ void qkt(f32x16& p0, f32x16& p1, const LAS unsigned char* Ks, const bf16x8* qr, int r32, int hi) {
  p0 = f32x16{}; p1 = f32x16{};
#pragma unroll
  for (int d0 = 0; d0 < 8; ++d0) { const int cb = (d0 * 16 + hi * 8) * 2;
    const bf16x8 b0 = *(const LAS bf16x8*)(Ks + KSWZ(r32, cb));
    const bf16x8 b1 = *(const LAS bf16x8*)(Ks + KSWZ(32 + r32, cb));
    p0 = __builtin_amdgcn_mfma_f32_32x32x16_bf16(b0, qr[d0], p0, 0, 0, 0);
    p1 = __builtin_amdgcn_mfma_f32_32x32x16_bf16(b1, qr[d0], p1, 0, 0, 0); }
}
__device__ __forceinline__ int v_st(int k, int c) { const int kk = (k & ~0xC) | ((k & 4) << 1) | ((k & 8) >> 1); return ((kk >> 3) * 4 + (c >> 5)) * 512 + ((kk & 7) * 32 + (c & 31)) * 2; }
__device__ __forceinline__ int v_rd_base(int lane) { return ((lane & 3) << 3) | (((lane >> 2) & 3) << 6) | (((lane >> 4) & 1) << 5) | (((lane >> 5) & 1) << 8); }
constexpr int v_rd_off(int d0, int ks, int half) { return d0 * 512 + ks * 4096 + half * 2048; }
template <int OFF> __device__ __forceinline__ s16x4 tr_read(int vb) {
  s16x4 r; asm volatile("ds_read_b64_tr_b16 %0, %1 offset:%2" : "=&v"(r) : "v"(vb), "i"(OFF) : "memory"); return r;
}
template <int D0> __device__ __forceinline__ void pv_one(f32x16& od, int vb, bf16x8 pa0, bf16x8 pa1, bf16x8 pa2, bf16x8 pa3) {
  const s16x4 l0 = tr_read<v_rd_off(D0, 0, 0)>(vb), h0 = tr_read<v_rd_off(D0, 0, 1)>(vb), l1 = tr_read<v_rd_off(D0, 1, 0)>(vb), h1 = tr_read<v_rd_off(D0, 1, 1)>(vb);
  const s16x4 l2 = tr_read<v_rd_off(D0, 2, 0)>(vb), h2 = tr_read<v_rd_off(D0, 2, 1)>(vb), l3 = tr_read<v_rd_off(D0, 3, 0)>(vb), h3 = tr_read<v_rd_off(D0, 3, 1)>(vb);
  asm volatile("s_waitcnt lgkmcnt(0)" ::: "memory"); SBAR();
#define PK(L, H) (bf16x8){L[0], L[1], L[2], L[3], H[0], H[1], H[2], H[3]}
  od = __builtin_amdgcn_mfma_f32_32x32x16_bf16(pa0, PK(l0, h0), od, 0, 0, 0);
  od = __builtin_amdgcn_mfma_f32_32x32x16_bf16(pa1, PK(l1, h1), od, 0, 0, 0);
  od = __builtin_amdgcn_mfma_f32_32x32x16_bf16(pa2, PK(l2, h2), od, 0, 0, 0);
  od = __builtin_amdgcn_mfma_f32_32x32x16_bf16(pa3, PK(l3, h3), od, 0, 0, 0);
#undef PK
}
__device__ __forceinline__ void pv_d0(f32x16* o, int vb, bf16x8 pa0, bf16x8 pa1, bf16x8 pa2, bf16x8 pa3) {
  pv_one<0>(o[0], vb, pa0, pa1, pa2, pa3); pv_one<1>(o[1], vb, pa0, pa1, pa2, pa3); pv_one<2>(o[2], vb, pa0, pa1, pa2, pa3); pv_one<3>(o[3], vb, pa0, pa1, pa2, pa3);
}
__device__ __forceinline__ void attn_unit(LAS unsigned char* lds, const bf16* Qb, bf16* Ob, const bf16* Kl, const bf16* Vl, int ntl, int rho0, int r0, const bf16* Kc, const bf16* Vc, const float* rpb) {
  int tid_ = threadIdx.x; asm volatile("" : "+v"(tid_));
  const int tid = tid_, wid = __builtin_amdgcn_readfirstlane(tid >> 6), lane = tid & 63, r32 = lane & 31, hi = lane >> 5;
  LAS unsigned char* V_lds = lds + OFF_V; LAS unsigned char* K_lds = lds + OFF_K;
  LAS float* wsf = (LAS float*)(lds + OFF_WS) + wid * 64; LAS float* li_l = wsf; LAS float* al_l = wsf + 32;
  LAS float* tab = (LAS float*)(lds + OFF_TAB);
  if (ntl > 0) { for (int i = tid; i < 15 * 31; i += NWAVES * 64) tab[i] = rpb[i] * (1.0f / SCALE); }
  float m_reg = -1e30f, l_reg = 0.f; f32x16 o[4] = {}; bf16x8 qr[8];
  { const bf16* Qw = Qb + (size_t)(wid * 32 + r32) * 2048 + hi * 8;
#pragma unroll
    for (int d0 = 0; d0 < 8; ++d0) qr[d0] = *(const GAS bf16x8*)(Qw + d0 * 16); }
  const int rq = r0 + (wid >> 1), cq = 32 * (wid & 1) + r32;
  const int rs = min(max(rq - 4, 0), 56), cs = min(max(cq - 8, 0), 48);
  const int sr = tid >> 4, sc = (tid & 15) * 8, vst0 = v_st(sr, sc), vst1 = v_st(32 + sr, sc), kst0 = KSWZ(sr, sc * 2), kst1 = KSWZ(32 + sr, sc * 2);
  const int vb0 = (int)(unsigned)(uintptr_t)V_lds + v_rd_base(lane);
  const int NT = ntl + 4;
  bf16x8 sv0, sv1, sk0, sk1;
#define SLOAD(t) do { const bf16* kp = ((t) < ntl) ? Kl + (size_t)(t) * 64 * 2048 : Kc + (size_t)((t) - ntl) * 64 * 2048; const bf16* vp = ((t) < ntl) ? Vl + (size_t)(t) * 64 * 2048 : Vc + (size_t)((t) - ntl) * 64 * 2048; \
    sv0 = *(const GAS bf16x8*)(vp + (size_t)sr * 2048 + sc); sv1 = *(const GAS bf16x8*)(vp + (size_t)(32 + sr) * 2048 + sc); sk0 = *(const GAS bf16x8*)(kp + (size_t)sr * 2048 + sc); sk1 = *(const GAS bf16x8*)(kp + (size_t)(32 + sr) * 2048 + sc); } while (0)
#define SWRITE(b) do { *(LAS bf16x8*)(V_lds + (b) * SHM_T + vst0) = sv0; *(LAS bf16x8*)(V_lds + (b) * SHM_T + vst1) = sv1; *(LAS bf16x8*)(K_lds + (b) * SHM_T + kst0) = sk0; *(LAS bf16x8*)(K_lds + (b) * SHM_T + kst1) = sk1; } while (0)
  SLOAD(0); SWRITE(0); __syncthreads();
  for (int t = 0; t < NT; ++t) {
    const int b = t & 1;
    if (t + 1 < NT) SLOAD(t + 1);
    const bool local = t < ntl; const int rho = rho0 + t;
    const bool need = !local || (rho >= rs && rho < rs + 8);
    if (need) {
      f32x16 p0, p1; float mn, alpha; bf16x8 pa0, pa1, pa2, pa3;
      qkt(p0, p1, K_lds + b * SHM_T, qr, r32, hi);
      if (local) { const LAS float* tb = tab + (rho - rq + 7) * 31 + (4 * hi - cq + 15);
#pragma unroll
        for (int r = 0; r < 16; ++r) { const int k0 = (r & 3) + 8 * (r >> 2); const int kap = k0 + 4 * hi;
          const float b0 = tb[k0], b1 = tb[k0 + 32];
          p0[r] = ((unsigned)(kap - cs) < 16u) ? p0[r] + b0 : -1e30f;
          p1[r] = ((unsigned)(kap + 32 - cs) < 16u) ? p1[r] + b1 : -1e30f; } }
      partialSM(p0, p1, m_reg, mn, alpha);
      if (__any(alpha < 1.f)) { if (hi == 0) al_l[r32] = alpha; asm volatile("s_waitcnt lgkmcnt(0)" ::: "memory");
#pragma unroll
        for (int d = 0; d < 4; ++d)
#pragma unroll
          for (int r = 0; r < 16; ++r) o[d][r] *= al_l[crow(r, hi)]; }
      finishSM(p0, p1, alpha, l_reg, pa0, pa1, pa2, pa3); SBAR();
      pv_d0(o, vb0 + b * SHM_T, pa0, pa1, pa2, pa3);
    }
    if (t + 1 < NT) SWRITE(b ^ 1);
    __syncthreads();
  }
#undef SLOAD
#undef SWRITE
  if (hi == 0) li_l[r32] = l_reg; asm volatile("s_waitcnt lgkmcnt(0)" ::: "memory");
  float rli[16];
#pragma unroll
  for (int r = 0; r < 16; ++r) rli[r] = __builtin_amdgcn_rcpf(li_l[crow(r, hi)]);
  bf16* Ow = Ob + (size_t)(wid * 32) * 2048;
#pragma unroll
  for (int r = 0; r < 16; ++r) { const int orow = crow(r, hi);
#pragma unroll
    for (int d0 = 0; d0 < 4; ++d0) { const unsigned w = pkbf(o[d0][r] * rli[r], 0.f); Ow[(size_t)orow * 2048 + d0 * 32 + r32] = (bf16)(w & 0xffffu); } }
}
#undef KSWZ
#undef SBAR
}
__device__ __forceinline__ float sum8(float v) { v += __shfl_xor(v, 1); v += __shfl_xor(v, 2); v += __shfl_xor(v, 4); return v; }
__device__ __forceinline__ void rwkv_prep(Frame& F, const Args& A, const h16s* PR, int prow0, int Ms, int L, h16s* RS, h16s* KS, h16s* VS, h16s* KK, bf16* LA) {
    const int gw = F.vcu * NWAVES + F.wave, NGW = F.G * NWAVES; const float* mu = A.in[I_MU]; const float* k_k = A.in[I_KK];
    for (int s = gw; s < Ms; s += NGW) {
        const int t = s % L; const bool hp = t > 0, hn = t < L - 1;
        const h16s* pc = PR + (size_t)(prow0 + s) * C_RWKV_P + F.lane * 8;
#pragma unroll 1
        for (int c = 0; c < 13; ++c) {
            const int col = c * 512 + F.lane * 8; const v4u z4 = {0u, 0u, 0u, 0u};
            const v4u wc = *(const GAS v4u*)(pc + c * 512), wp = hp ? *(const GAS v4u*)(pc + c * 512 - C_RWKV_P) : z4, wn = hn ? *(const GAS v4u*)(pc + c * 512 + C_RWKV_P) : z4;
            float xc[8], xp[8], xn[8], m[8]; unpack_h8(wc, xc); unpack_h8(wp, xp); unpack_h8(wn, xn);
            if (col < C_RWKV) { const f32x4 m0 = *(const GAS f32x4*)(mu + col), m1 = *(const GAS f32x4*)(mu + col + 4); m[0] = m0.x; m[1] = m0.y; m[2] = m0.z; m[3] = m0.w; m[4] = m1.x; m[5] = m1.y; m[6] = m1.z; m[7] = m1.w; }
            else {
#pragma unroll
                for (int e = 0; e < 8; ++e) m[e] = 0.f; }
            float x[8];
#pragma unroll
            for (int e = 0; e < 8; ++e) x[e] = xc[e] + m[e] * (0.5f * (xp[e] + xn[e]) - xc[e]);
            if (c < 12) {
                v4u o; o.x = pkh(x[0], x[1]); o.y = pkh(x[2], x[3]); o.z = pkh(x[4], x[5]); o.w = pkh(x[6], x[7]);
                h16s* dst = (c < 4 ? RS : c < 8 ? KS : VS) + (size_t)s * D_RW + (c & 3) * 512 + F.lane * 8;
                *(GAS v4u*)dst = o;
                if (c >= 4 && c < 8) { const int kc = (c - 4) * 512 + F.lane * 8; const f32x4 q0 = *(const GAS f32x4*)(k_k + kc), q1 = *(const GAS f32x4*)(k_k + kc + 4);
                    float y[8] = {x[0] * q0.x, x[1] * q0.y, x[2] * q0.z, x[3] * q0.w, x[4] * q1.x, x[5] * q1.y, x[6] * q1.z, x[7] * q1.w}; float ss = 0.f;
#pragma unroll
                    for (int e = 0; e < 8; ++e) ss += y[e] * y[e];
                    ss = sum8(ss); const float inv = 1.0f / fmaxf(sqrtf(ss), 1e-12f);
                    v4u ko; ko.x = pkh(y[0] * inv, y[1] * inv); ko.y = pkh(y[2] * inv, y[3] * inv); ko.z = pkh(y[4] * inv, y[5] * inv); ko.w = pkh(y[6] * inv, y[7] * inv);
                    *(GAS v4u*)(KK + (size_t)s * D_RW + kc) = ko; }
            } else {
                float y[8];
#pragma unroll
                for (int e = 0; e < 8; ++e) { const int j = F.lane * 8 + e; const float v = x[e];
                    const float th = 1.0f - 2.0f * __builtin_amdgcn_rcpf(1.0f + __builtin_amdgcn_exp2f(2.8853900817779268f * v));
                    y[e] = j < 96 ? th : j < 192 ? v : j < 448 ? sigm(v) : 0.f; }
                v4u o; o.x = pkbf(y[0], y[1]); o.y = pkbf(y[2], y[3]); o.z = pkbf(y[4], y[5]); o.w = pkbf(y[6], y[7]);
                *(GAS v4u*)(LA + (size_t)s * K_LORA + F.lane * 8) = o;
            }
        }
    }
}
#define DPPF(acc, bv, x, I) asm("v_fmac_f32_dpp %0, %1, %2 row_newbcast:" #I " row_mask:0xf bank_mask:0xf" : "+v"(acc) : "v"(bv), "v"(x))
#define DPPM(dst, bv, x, I) asm("v_mul_f32_dpp %0, %1, %2 row_newbcast:" #I " row_mask:0xf bank_mask:0xf" : "=v"(dst) : "v"(bv), "v"(x))
#define REP16(M) M(0) M(1) M(2) M(3) M(4) M(5) M(6) M(7) M(8) M(9) M(10) M(11) M(12) M(13) M(14) M(15)
__device__ __forceinline__ float xrow_sum(float p) {
    { auto r = __builtin_amdgcn_permlane16_swap(__float_as_uint(p), __float_as_uint(p), false, false); p = __uint_as_float(r[0]) + __uint_as_float(r[1]); }
    { auto r = __builtin_amdgcn_permlane32_swap(__float_as_uint(p), __float_as_uint(p), false, false); p = __uint_as_float(r[0]) + __uint_as_float(r[1]); }
    return p;
}
__device__ __forceinline__ float h2f(h16s u) { return (float)__builtin_bit_cast(_Float16, u); }
__device__ __forceinline__ void rwkv_scan(Frame& F, const Args& A, int nseq, int L, int seq0_global, bool has_state, const h16s* RS, const h16s* KS, const h16s* VS, const h16s* KK,
                                          const h16s* DF, const h16s* DB, const h16s* AF, const h16s* AB, h16s* YF, h16s* YB, float* out_sf, float* out_sb) {
    const int ntasks = nseq * NH_R * 2 * 4; const int lane = F.lane;
    int slot, stride;
    if (ntasks >= F.G * NWAVES) { slot = F.vcu * NWAVES + F.wave; stride = F.G * NWAVES; } else { slot = F.wave < 4 ? F.vcu * 4 + F.wave : ntasks; stride = F.G * 4; }
    const float* k_a = A.in[I_KA];
    for (int task = slot; task < ntasks; task += stride) {
        const int vq = task & 3, chain = task >> 2, dir = chain & 1, head = (chain >> 1) & 31, seq = chain >> 6;
        const h16s* Dd = dir ? DB : DF; const h16s* Ad = dir ? AB : AF; h16s* Yd = dir ? YB : YF;
        const int kcol = head * 64 + lane, vcol = head * 64 + 16 * vq + (lane & 15);
        const float ka = k_a[kcol], oka = 1.0f - ka;
        float S[16];
        if (has_state) { const float* sp = (dir ? A.in[I_SB] : A.in[I_SF]) + (((size_t)(seq0_global + seq) * NH_R + head) * 64 + 16 * vq + (lane & 15)) * 64 + 16 * (lane >> 4);
#pragma unroll
            for (int q = 0; q < 4; ++q) { const f32x4 v = *(const GAS f32x4*)(sp + 4 * q); S[4 * q] = v.x; S[4 * q + 1] = v.y; S[4 * q + 2] = v.z; S[4 * q + 3] = v.w; } }
        else {
#pragma unroll
            for (int i = 0; i < 16; ++i) S[i] = 0.f; }
        const int row0 = seq * L; const int tstart = dir ? L - 1 : 0, tstep = dir ? -1 : 1;
        constexpr int UC = 8;
        h16s cur[UC][6], nxt[UC][6];
#define LDSTEP(buf, u, t) do { const size_t ro = (size_t)(row0 + (t)) * D_RW; buf[u][0] = RS[ro + kcol]; buf[u][1] = KS[ro + kcol]; buf[u][2] = KK[ro + kcol]; buf[u][3] = Dd[ro + kcol]; buf[u][4] = Ad[ro + kcol]; buf[u][5] = VS[ro + vcol]; } while (0)
#pragma unroll
        for (int u = 0; u < UC; ++u) LDSTEP(cur, u, tstart + u * tstep);
        for (int c = 0; c < L / UC; ++c) {
            const int tb = tstart + c * UC * tstep;
            if (c + 1 < L / UC) {
#pragma unroll
                for (int u = 0; u < UC; ++u) LDSTEP(nxt, u, tb + (UC + u) * tstep); }
#pragma unroll
            for (int u = 0; u < UC; ++u) {
                float rv = h2f(cur[u][0]), kv = h2f(cur[u][1]), kkv = h2f(cur[u][2]), wv = h2f(cur[u][3]); const float av = h2f(cur[u][4]), vv = h2f(cur[u][5]);
                float kdv = kv * fmaf(av, ka, oka), bbv = kkv * av;
                asm volatile("s_nop 1" : "+v"(rv), "+v"(kkv), "+v"(wv), "+v"(kdv), "+v"(bbv));
                float p0 = 0.f, p1 = 0.f;
#define M_SA(I) if ((I) & 1) DPPF(p1, kkv, S[I], I); else DPPF(p0, kkv, S[I], I);
                REP16(M_SA)
#undef M_SA
                const float sa = -xrow_sum(p0 + p1);
                float y0 = 0.f, y1 = 0.f;
#define M_UP(I) DPPM(S[I], wv, S[I], I); DPPF(S[I], bbv, sa, I); DPPF(S[I], kdv, vv, I); if ((I) & 1) DPPF(y1, rv, S[I], I); else DPPF(y0, rv, S[I], I);
                REP16(M_UP)
#undef M_UP
                const float y = xrow_sum(y0 + y1);
                if (lane < 16) Yd[(size_t)(row0 + tb + u * tstep) * D_RW + vcol] = __builtin_bit_cast(h16s, (_Float16)y);
            }
#pragma unroll
            for (int u = 0; u < UC; ++u)
#pragma unroll
                for (int q = 0; q < 6; ++q) cur[u][q] = nxt[u][q];
        }
#undef LDSTEP
        if (out_sf) { float* dp = (dir ? out_sb : out_sf) + (((size_t)(seq0_global + seq) * NH_R + head) * 64 + 16 * vq + (lane & 15)) * 64 + 16 * (lane >> 4);
#pragma unroll
            for (int q = 0; q < 4; ++q) *(GAS f32x4*)(dp + 4 * q) = (f32x4){S[4 * q], S[4 * q + 1], S[4 * q + 2], S[4 * q + 3]}; }
    }
}
__device__ __forceinline__ void rwkv_post(Frame& F, const Args& A, int Ms, const h16s* RS, const h16s* KS, const h16s* VS, const h16s* AF, const h16s* AB, const h16s* LG, const h16s* YF, const h16s* YB, bf16* ORW  ) {
    const int gw = F.vcu * NWAVES + F.wave, NGW = F.G * NWAVES; const float *lnw = A.in[I_LNW], *lnb = A.in[I_LNB], *k_a = A.in[I_KA], *r_k = A.in[I_RK];
    for (int s = gw; s < Ms; s += NGW) {
#pragma unroll 1
        for (int c = 0; c < 4; ++c) { const int col = c * 512 + F.lane * 8; const size_t off = (size_t)s * D_RW + col;
            float yf[8], yb[8], r[8], k[8], v[8], af[8], ab[8], g[8], w[8], b[8], ka[8], rk[8];
            unpack_h8(*(const GAS v4u*)(YF + off), yf); unpack_h8(*(const GAS v4u*)(YB + off), yb); unpack_h8(*(const GAS v4u*)(RS + off), r); unpack_h8(*(const GAS v4u*)(KS + off), k);
            unpack_h8(*(const GAS v4u*)(VS + off), v); unpack_h8(*(const GAS v4u*)(AF + off), af); unpack_h8(*(const GAS v4u*)(AB + off), ab); unpack_h8(*(const GAS v4u*)(LG + off), g);
#pragma unroll
            for (int h = 0; h < 2; ++h) { const f32x4 a = *(const GAS f32x4*)(lnw + col + 4 * h), bb = *(const GAS f32x4*)(lnb + col + 4 * h), cc = *(const GAS f32x4*)(k_a + col + 4 * h), dd = *(const GAS f32x4*)(r_k + col + 4 * h);
                w[4 * h] = a.x; w[4 * h + 1] = a.y; w[4 * h + 2] = a.z; w[4 * h + 3] = a.w; b[4 * h] = bb.x; b[4 * h + 1] = bb.y; b[4 * h + 2] = bb.z; b[4 * h + 3] = bb.w;
                ka[4 * h] = cc.x; ka[4 * h + 1] = cc.y; ka[4 * h + 2] = cc.z; ka[4 * h + 3] = cc.w; rk[4 * h] = dd.x; rk[4 * h + 1] = dd.y; rk[4 * h + 2] = dd.z; rk[4 * h + 3] = dd.w; }
            float sf = 0.f, sb = 0.f, bf_ = 0.f, bb_ = 0.f;
#pragma unroll
            for (int e = 0; e < 8; ++e) { sf += yf[e]; sb += yb[e]; const float t = r[e] * k[e] * rk[e]; bf_ += t * (1.0f + (af[e] - 1.0f) * ka[e]); bb_ += t * (1.0f + (ab[e] - 1.0f) * ka[e]); }
            sf = sum8(sf) * (1.0f / 64.0f); sb = sum8(sb) * (1.0f / 64.0f); bf_ = sum8(bf_); bb_ = sum8(bb_);
            float qf = 0.f, qb = 0.f;
#pragma unroll
            for (int e = 0; e < 8; ++e) { yf[e] -= sf; yb[e] -= sb; qf += yf[e] * yf[e]; qb += yb[e] * yb[e]; }
            const float rf = 1.0f / sqrtf(sum8(qf) * (1.0f / 64.0f) + LNX_EPS), rb = 1.0f / sqrtf(sum8(qb) * (1.0f / 64.0f) + LNX_EPS);
            float o[8];
#pragma unroll
            for (int e = 0; e < 8; ++e) o[e] = ((yf[e] * rf + yb[e] * rb) * w[e] + 2.0f * b[e] + (bf_ + bb_) * v[e]) * g[e];
            v4u ow; ow.x = pkbf(o[0], o[1]); ow.y = pkbf(o[2], o[3]); ow.z = pkbf(o[4], o[5]); ow.w = pkbf(o[6], o[7]);
            *(GAS v4u*)(ORW + off) = ow; }
    }
}
__global__ void __launch_bounds__(NWAVES * 64, 2) fwd_kernel(Args args) {
    const Args& A = args;
    extern __shared__ __attribute__((aligned(16))) unsigned char lds[];
    Frame F;
    F.lds = (LAS unsigned char*)lds;
    F.MISC = (volatile LAS unsigned*)(F.lds + MISC_OFF);
    F.tid = threadIdx.x; F.lane = F.tid & 63; F.wave = __builtin_amdgcn_readfirstlane(F.tid >> 6);
    F.G = gridDim.x; { const int bx = blockIdx.x; F.vcu = (F.G % 8 == 0) ? (bx % 8) * (F.G / 8) + bx / 8 : bx; }
    F.ws = args.ws; F.out = args.out; F.ctl = (gu32*)(args.ws + WS_CTL);
    for (int u = F.tid; u < (LDS_BYTES - LDSCTL_OFF) / 4; u += NWAVES * 64) ((LAS unsigned*)(F.lds + LDSCTL_OFF))[u] = 0u;
    __syncthreads();
    XcdBarrier bar = xcd_barrier_post((unsigned*)(F.ctl + CW_BAR), F.MISC + 8);
#define GRID_BAR() xcd_barrier(bar)
    unsigned char* ws = args.ws;
    bf16* const H = (bf16*)(ws + WS_H); bf16* const Qb = (bf16*)(ws + WS_Q); bf16* const Kb = (bf16*)(ws + WS_K); bf16* const Vb = (bf16*)(ws + WS_V);
    h16s* const PR = (h16s*)(ws + WS_PR); bf16* const ORW = (bf16*)(ws + WS_ORW); bf16* const MID = (bf16*)(ws + WS_H); bf16* const U = (bf16*)(ws + WS_U);
    const float* const MOD = (const float*)(ws + WS_MOD);

#ifndef PHMASK
#define PHMASK 0xffffffffu
#endif
#define PH(n) RELANE(); if constexpr ((PHMASK >> (n)) & 1u)
#define RELANE() do { int t_ = threadIdx.x; asm volatile("" : "+v"(t_)); F.tid = t_; F.lane = t_ & 63; } while (0)
    PH(0) p0_prologue(F, A); GRID_BAR();
    PH(1) p0b_mod_finalize(F, A); GRID_BAR();

    for (int g = 0; g < 2; ++g) {
        const int M = g ? T_LAT : T_CTX, L = g ? L_LAT : L_CTX, jbase = g, jmul = g, ppb = L / 256;
        const float* X = g ? A.in[I_XS] : A.in[I_XP]; float* Y = F.out + O_Y + (g ? (size_t)T_CTX * DM : 0); bf16* PG = (bf16*)Y;
        PH(2) modnorm_rows(F, X, M, A.in[I_N1], 0, DM, jbase, L, jmul, H); GRID_BAR();
        PH(3) { pg8::Gemm gm{H, (const bf16*)(ws + WS_WIN), M, N_IN_P, DM}; pg8::StaticOrder S; S.init(M, N_IN_P, F.G, (int)blockIdx.x);
          pg8::EpiProj E{Qb, Kb, Vb, PR, PG, g ? nullptr : F.out + O_NK, g ? nullptr : F.out + O_NV};
          pg8::gemm_phase<pg8::EpiProj, pg8::StaticOrder, true, true>(F.lds + RING_OFF, gm, S, E); }
        GRID_BAR();
        PH(4) { if (g == 0) { for (int u = F.vcu; u < B_CTX * NH_A; u += F.G) { const int b = u >> 4, h = u & 15; const size_t base = (size_t)b * L_CTX * 2048 + h * 128;
                att::attn_unit(F.lds + RING_OFF, Qb + base, Qb + base, Kb, Vb, 0, 0, 0, Kb + base, Vb + base, nullptr); } }
        else { const bf16* CK = (const bf16*)(ws + WS_CK); const bf16* CV = (const bf16*)(ws + WS_CV);
            for (int u = F.vcu; u < B_LAT * NH_A * 16; u += F.G) { const int rg = u & 15, h = (u >> 4) & 15, b = u >> 8; const int r0 = 4 * rg, rho0 = min(max(r0 - 4, 0), 56), rho1 = min(max(r0 - 1, 0), 56) + 8;
                const size_t qbase = ((size_t)b * L_LAT + (size_t)rg * 256) * 2048 + h * 128, lbase = ((size_t)b * L_LAT + (size_t)rho0 * 64) * 2048 + h * 128, cbase = (size_t)b * 256 * 2048 + h * 128;
                att::attn_unit(F.lds + RING_OFF, Qb + qbase, Qb + qbase, Kb + lbase, Vb + lbase, rho1 - rho0, rho0, r0, CK + cbase, CV + cbase, A.in[I_RPB] + h * 15 * 31); } } }
        const int nsub = g ? 2 : 1, Ms = g ? 16384 : T_CTX, nseq = g ? 4 : B_CTX;
        for (int sub = 0; sub < nsub; ++sub) {
            h16s *RS = (h16s*)(ws + WS_RS), *KS = (h16s*)(ws + WS_KS), *VS = (h16s*)(ws + WS_VS), *KKb = (h16s*)(ws + WS_KK), *DF = (h16s*)(ws + WS_DF), *DB = (h16s*)(ws + WS_DB), *AF = (h16s*)(ws + WS_AF), *AB = (h16s*)(ws + WS_AB);
            h16s *LG = (h16s*)(ws + WS_LG), *YF = (h16s*)(ws + WS_YF), *YB = (h16s*)(ws + WS_YB); bf16* LA = (bf16*)(ws + WS_LA);
            PH(5) rwkv_prep(F, A, PR, sub * Ms, Ms, L, RS, KS, VS, KKb, LA); GRID_BAR();
            PH(6) { pg8::Gemm gm{LA, (const bf16*)(ws + WS_WLORA), Ms, N_LORA, K_LORA}; pg8::StaticOrder S; S.init(Ms, N_LORA, F.G, (int)blockIdx.x);
              pg8::EpiLora E{{DF, DB, AF, AB, LG}, A.in[I_W0], A.in[I_A0]};
              pg8::gemm_phase<pg8::EpiLora, pg8::StaticOrder, true, true>(F.lds + RING_OFF, gm, S, E); }
            GRID_BAR();
            PH(7) rwkv_scan(F, A, nseq, L, sub * nseq, g != 0, RS, KS, VS, KKb, DF, DB, AF, AB, YF, YB, g ? nullptr : F.out + O_SF, g ? nullptr : F.out + O_SB); GRID_BAR();
            PH(8) rwkv_post(F, A, Ms, RS, KS, VS, AF, AB, LG, YF, YB, ORW + (size_t)sub * Ms * D_RW); GRID_BAR();
        }
        PH(9) { pg8::Gemm gm{Qb, (const bf16*)(ws + WS_WOA), M, DM, D_ATT}; pg8::StaticOrder S; S.init(M, DM, F.G, (int)blockIdx.x);
          pg8::EpiGate<false> E{MID, PG, 0};
          pg8::gemm_phase<pg8::EpiGate<false>, pg8::StaticOrder, true, true>(F.lds + RING_OFF, gm, S, E); }
        GRID_BAR();
        PH(10) { pg8::Gemm gm{ORW, (const bf16*)(ws + WS_WOR), M, DM, D_RW}; pg8::StaticOrder S; S.init(M, DM, F.G, (int)blockIdx.x);
          pg8::EpiGate<true> E{MID, PG, DM};
          pg8::gemm_phase<pg8::EpiGate<true>, pg8::StaticOrder, true, true>(F.lds + RING_OFF, gm, S, E); }
        GRID_BAR();
        PH(11) { pg8::Gemm gm{MID, (const bf16*)(ws + WS_WOUT), M, DM, DM}; pg8::StaticOrder S; S.init(M, DM, F.G, (int)blockIdx.x);
          pg8::EpiResid E{X, Y, MOD + 2 * DM, jbase, ppb, jmul};
          pg8::gemm_phase<pg8::EpiResid, pg8::StaticOrder, true, true>(F.lds + RING_OFF, gm, S, E); }
        GRID_BAR();
        PH(12) modnorm_rows(F, Y, M, A.in[I_N2], 3 * DM, 4 * DM, jbase, L, jmul, H); GRID_BAR();
        PH(13) { pg8::Gemm gm{H, (const bf16*)(ws + WS_WM1), M, D_FF, DM}; pg8::StaticOrder S; S.init(M, D_FF, F.G, (int)blockIdx.x);
          pg8::EpiRelu2 E{U};
          pg8::gemm_phase<pg8::EpiRelu2, pg8::StaticOrder, true, true>(F.lds + RING_OFF, gm, S, E); }
        GRID_BAR();
        PH(14) { pg8::Gemm gm{U, (const bf16*)(ws + WS_WM2), M, DM, D_FF}; pg8::StaticOrder S; S.init(M, DM, F.G, (int)blockIdx.x);
          pg8::EpiResid E{Y, Y, MOD + 5 * DM, jbase, ppb, jmul};
          pg8::gemm_phase<pg8::EpiResid, pg8::StaticOrder, true, true>(F.lds + RING_OFF, gm, S, E); }
        GRID_BAR();
        PH(15) final_norm_rows(F, Y, M, A.in[I_NF]); GRID_BAR();
    }
#undef GRID_BAR
}

extern "C" void kernel_launch(void* const* d_in, const int* in_sizes, int n_in, void* d_out, int out_size, void* d_ws, size_t ws_size, hipStream_t stream) {
    static int grid = 0;
    if (grid == 0) {
        if (n_in != 31 || ws_size < WS_END) { fprintf(stderr, "kernel_launch: need 31 inputs and >= %zu bytes of workspace; got %d, %zu\n", (size_t)WS_END, n_in, ws_size); grid = -1; return; }
        int dev = 0, cus = 0, per_cu = 0;
        if (hipGetDevice(&dev) != hipSuccess || hipDeviceGetAttribute(&cus, hipDeviceAttributeMultiprocessorCount, dev) != hipSuccess) { grid = -1; return; }
        if (hipFuncSetAttribute((const void*)fwd_kernel, hipFuncAttributeMaxDynamicSharedMemorySize, LDS_BYTES) != hipSuccess) { fprintf(stderr, "kernel_launch: hipFuncSetAttribute failed\n"); grid = -1; return; }
        if (hipOccupancyMaxActiveBlocksPerMultiprocessor(&per_cu, (const void*)fwd_kernel, NWAVES * 64, LDS_BYTES) != hipSuccess || per_cu < 1) fprintf(stderr, "kernel_launch: occupancy query reports %d\n", per_cu);
        (void)hipGetLastError();
        grid = cus;
    }
    if (grid < 0) return;
    if (hipMemsetAsync((char*)d_ws + WS_CTL, 0, CTL_ZERO_BYTES, stream) != hipSuccess) return;
    Args a{};
    for (int i = 0; i < 31; ++i) a.in[i] = (const float*)d_in[i];
    a.out = (float*)d_out; a.ws = (unsigned char*)d_ws;
    hipLaunchKernelGGL(fwd_kernel, dim3(grid), dim3(NWAVES * 64), LDS_BYTES, stream, a);
    const hipError_t le = hipPeekAtLastError();
    if (le != hipSuccess) fprintf(stderr, "kernel_launch: launch failed: %s\n", hipGetErrorName(le));
}
```

```cpp
#include <hip/hip_runtime.h>
#include <cstdio>
#include <cstdint>
namespace pg8 {
#define PG8_LAS __attribute__((address_space(3)))
typedef unsigned short bf16_t;
typedef short bf16x8 __attribute__((ext_vector_type(8)));
typedef float f32x4 __attribute__((ext_vector_type(4)));
typedef unsigned u32x4 __attribute__((ext_vector_type(4)));
constexpr int BM = 256, BK = 64, HALF = 128, HTB = HALF * BK * 2  , STAGE_BYTES = 8 * HTB, NXCD = 8, WGM = 8;

__host__ __device__ __forceinline__ int lds_byte(int r, int c) { const int st = (r >> 4) * 2 + (c >> 5), rr = r & 15, cc = c & 31, ob = rr * 64 + cc * 2; return st * 1024 + (ob ^ (((ob >> 9) & 1) << 5)); }
__host__ __device__ __forceinline__ void stage_rc(int b, int& R, int& C) { const int st = b / 1024, sb = b % 1024, swz = sb ^ (((sb >> 9) & 1) << 5); R = (st >> 1) * 16 + swz / 64; C = (st & 1) * 32 + (swz % 64) / 2; }
__host__ __device__ __forceinline__ int perm32(int rho) { const int n = rho >> 4, i = rho & 15; return 8 * (i >> 2) + 4 * n + (i & 3); }

struct Unit { int pm, pn; };
struct Gemm { const bf16_t* A; const bf16_t* Bt; int M, N, K; };

struct StaticOrder {
    int nM, nN, nwg, G, c;
    __host__ __device__ void init(int M, int N, int G_, int c_) { nM = M / BM; nN = N / BM; nwg = nM * nN; G = G_; c = c_; }
    __host__ __device__ bool next(int i, Unit& u) const {
        const long L = (long)i * G + c; if (L >= nwg) return false;
        int wgid = (int)L; { const int q = nwg / NXCD, r = nwg % NXCD, xcd = wgid % NXCD, off = wgid / NXCD; wgid = (xcd < r ? xcd * (q + 1) : r * (q + 1) + (xcd - r) * q) + off; }
        const int nig = WGM * nN, gid = wgid / nig, fm = gid * WGM, gsz = (nM - fm) < WGM ? (nM - fm) : WGM;
        u.pm = fm + ((wgid % nig) % gsz); u.pn = (wgid % nig) / gsz; return true;
    }
    __device__ __forceinline__ void a_ready(const Unit&) const {}
    __device__ __forceinline__ void done(const Unit&) const {}
};

__device__ __forceinline__ unsigned cvt_pk_bf16(float lo, float hi) { unsigned r; asm volatile("v_cvt_pk_bf16_f32 %0, %1, %2" : "=v"(r) : "v"(lo), "v"(hi)); return r; }
typedef _Float16 h16x2 __attribute__((ext_vector_type(2)));
__device__ __forceinline__ unsigned cvt_pk_f16(float lo, float hi) { h16x2 v = {(_Float16)lo, (_Float16)hi}; return __builtin_bit_cast(unsigned, v); }
__device__ __forceinline__ float sigmoidf_(float x) { return __builtin_amdgcn_rcpf(1.0f + __builtin_amdgcn_exp2f(-1.4426950408889634f * x)); }
__device__ __forceinline__ float bf_lo(unsigned u) { return __builtin_bit_cast(float, u << 16); }
__device__ __forceinline__ float bf_hi(unsigned u) { return __builtin_bit_cast(float, u & 0xffff0000u); }

struct EpiProj {
    static constexpr bool PERM = true, AFTER_DRAIN = false;
    bf16_t *Q, *K, *V, *PR, *PG; float *NK, *NV;
    __device__ __forceinline__ void operator()(const f32x4 (&acc)[2][2][4][2], const Unit& u, int wr, int wc, int fr, int fq) const {
        const int row0 = u.pm * BM + wr * 64 + fr, pn = u.pn;
        bf16_t* base; int ld, colt, mode = 0; float* fb = nullptr;
        if (pn < 8) { base = Q; ld = 2048; colt = pn * 256; }
        else if (pn < 16) { base = K; ld = 2048; colt = (pn - 8) * 256; fb = NK; }
        else if (pn < 24) { base = V; ld = 2048; colt = (pn - 16) * 256; fb = NV; }
        else if (pn < 50) { base = PR; ld = 6656; colt = (pn - 24) * 256; mode = 1; }
        else { base = PG; ld = 8192; colt = (pn - 50) * 256; mode = 2; }
        const int col0 = colt + wc * 32 + 8 * fq;
#pragma unroll
        for (int ai = 0; ai < 2; ++ai)
#pragma unroll
            for (int m = 0; m < 4; ++m) { const size_t r = (size_t)(row0 + ai * HALF + m * 16); bf16_t* rowp = base + r * ld + col0;
#pragma unroll
                for (int bj = 0; bj < 2; ++bj) { f32x4 v0 = acc[ai][bj][m][0], v1 = acc[ai][bj][m][1]; u32x4 w;
                    if (mode == 2) { v0 = (f32x4){sigmoidf_(v0[0]), sigmoidf_(v0[1]), sigmoidf_(v0[2]), sigmoidf_(v0[3])}; v1 = (f32x4){sigmoidf_(v1[0]), sigmoidf_(v1[1]), sigmoidf_(v1[2]), sigmoidf_(v1[3])}; }
                    if (mode == 1) { w.x = cvt_pk_f16(v0[0], v0[1]); w.y = cvt_pk_f16(v0[2], v0[3]); w.z = cvt_pk_f16(v1[0], v1[1]); w.w = cvt_pk_f16(v1[2], v1[3]); }
                    else { w.x = cvt_pk_bf16(v0[0], v0[1]); w.y = cvt_pk_bf16(v0[2], v0[3]); w.z = cvt_pk_bf16(v1[0], v1[1]); w.w = cvt_pk_bf16(v1[2], v1[3]); }
                    *(u32x4*)(rowp + bj * HALF) = w;
                    if (fb) { float* fp = fb + r * 2048 + col0 + bj * HALF; *(f32x4*)fp = v0; *(f32x4*)(fp + 4) = v1; } } }
    }
};
struct EpiLora {
    static constexpr bool PERM = true, AFTER_DRAIN = false;
    bf16_t* OUT[5]; const float *w0, *a0; int selb;
    __device__ __forceinline__ void operator()(const f32x4 (&acc)[2][2][4][2], const Unit& u, int wr, int wc, int fr, int fq) const {
        const int row0 = u.pm * BM + wr * 64 + fr, sel = selb + (u.pn >> 3), colt = (u.pn & 7) * 256, col0 = colt + wc * 32 + 8 * fq;
        bf16_t* base = sel == 0 ? OUT[0] : sel == 1 ? OUT[1] : sel == 2 ? OUT[2] : sel == 3 ? OUT[3] : OUT[4];
        const float* bias = sel < 2 ? w0 + sel * 2048 : a0 + (sel - 2) * 2048;
        f32x4 bv[2][2];
#pragma unroll
        for (int bj = 0; bj < 2; ++bj)
#pragma unroll
            for (int n = 0; n < 2; ++n) bv[bj][n] = sel < 4 ? *(const f32x4*)(bias + col0 + bj * HALF + 4 * n) : (f32x4){0.f, 0.f, 0.f, 0.f};
#pragma unroll
        for (int ai = 0; ai < 2; ++ai)
#pragma unroll
            for (int m = 0; m < 4; ++m) { bf16_t* rowp = base + (size_t)(row0 + ai * HALF + m * 16) * 2048 + col0;
#pragma unroll
                for (int bj = 0; bj < 2; ++bj) { f32x4 v0 = acc[ai][bj][m][0] + bv[bj][0], v1 = acc[ai][bj][m][1] + bv[bj][1];
                    if (sel < 4) {
#pragma unroll
                        for (int e = 0; e < 4; ++e) { v0[e] = sigmoidf_(v0[e]); v1[e] = sigmoidf_(v1[e]); }
                        if (sel < 2) {
#pragma unroll
                            for (int e = 0; e < 4; ++e) { v0[e] = __builtin_amdgcn_exp2f(-0.87503716f * v0[e]); v1[e] = __builtin_amdgcn_exp2f(-0.87503716f * v1[e]); } } }
                    u32x4 w; w.x = cvt_pk_f16(v0[0], v0[1]); w.y = cvt_pk_f16(v0[2], v0[3]); w.z = cvt_pk_f16(v1[0], v1[1]); w.w = cvt_pk_f16(v1[2], v1[3]);
                    *(u32x4*)(rowp + bj * HALF) = w; } }
    }
};
template <bool ADD> struct EpiGate {
    static constexpr bool PERM = true, AFTER_DRAIN = false;
    bf16_t* O; const bf16_t* G; int goff;
    __device__ __forceinline__ void operator()(const f32x4 (&acc)[2][2][4][2], const Unit& u, int wr, int wc, int fr, int fq) const {
        const int row0 = u.pm * BM + wr * 64 + fr, col0 = u.pn * BM + wc * 32 + 8 * fq;
#pragma unroll
        for (int ai = 0; ai < 2; ++ai)
#pragma unroll
            for (int m = 0; m < 4; ++m) { const size_t r = (size_t)(row0 + ai * HALF + m * 16); bf16_t* rowp = O + r * 4096 + col0; const bf16_t* gp = G + r * 8192 + goff + col0;
#pragma unroll
                for (int bj = 0; bj < 2; ++bj) { const u32x4 g = *(const u32x4*)(gp + bj * HALF); const f32x4 a0 = acc[ai][bj][m][0], a1 = acc[ai][bj][m][1];
                    float o[8] = {a0[0] * bf_lo(g.x), a0[1] * bf_hi(g.x), a0[2] * bf_lo(g.y), a0[3] * bf_hi(g.y), a1[0] * bf_lo(g.z), a1[1] * bf_hi(g.z), a1[2] * bf_lo(g.w), a1[3] * bf_hi(g.w)};
                    if (ADD) { const u32x4 p = *(const u32x4*)(rowp + bj * HALF); o[0] += bf_lo(p.x); o[1] += bf_hi(p.x); o[2] += bf_lo(p.y); o[3] += bf_hi(p.y); o[4] += bf_lo(p.z); o[5] += bf_hi(p.z); o[6] += bf_lo(p.w); o[7] += bf_hi(p.w); }
                    u32x4 w; w.x = cvt_pk_bf16(o[0], o[1]); w.y = cvt_pk_bf16(o[2], o[3]); w.z = cvt_pk_bf16(o[4], o[5]); w.w = cvt_pk_bf16(o[6], o[7]);
                    *(u32x4*)(rowp + bj * HALF) = w; } }
    }
};
__device__ __forceinline__ f32x4 h4lo(unsigned a, unsigned b) { typedef _Float16 hh2 __attribute__((ext_vector_type(2))); const hh2 x = __builtin_bit_cast(hh2, a), y = __builtin_bit_cast(hh2, b); return (f32x4){(float)x.x, (float)x.y, (float)y.x, (float)y.y}; }
template <bool RF32> struct EpiResid {
    static constexpr bool PERM = true, AFTER_DRAIN = false;
    const float* R32; bf16_t* XH; const float* gt; int jbase, ppb, jmul;
    __device__ __forceinline__ void operator()(const f32x4 (&acc)[2][2][4][2], const Unit& u, int wr, int wc, int fr, int fq) const {
        const int row0 = u.pm * BM + wr * 64 + fr, col0 = u.pn * BM + wc * 32 + 8 * fq;
        const float* g = gt + (size_t)(jbase + (u.pm / ppb) * jmul) * 24576 + col0;
        f32x4 gv[2][2];
#pragma unroll
        for (int bj = 0; bj < 2; ++bj)
#pragma unroll
            for (int n = 0; n < 2; ++n) gv[bj][n] = *(const f32x4*)(g + bj * HALF + 4 * n);
#pragma unroll
        for (int ai = 0; ai < 2; ++ai)
#pragma unroll
            for (int m = 0; m < 4; ++m) { const size_t row = (size_t)(row0 + ai * HALF + m * 16); bf16_t* xp = XH + row * 8192 + col0;
#pragma unroll
                for (int bj = 0; bj < 2; ++bj) { f32x4 r0, r1;
                    if (RF32) { const float* rp = R32 + row * 4096 + col0 + bj * HALF; r0 = *(const f32x4*)rp; r1 = *(const f32x4*)(rp + 4); }
                    else { const u32x4 h = *(const u32x4*)(xp + bj * HALF); r0 = h4lo(h.x, h.y); r1 = h4lo(h.z, h.w); }
                    const f32x4 y0 = r0 + gv[bj][0] * acc[ai][bj][m][0], y1 = r1 + gv[bj][1] * acc[ai][bj][m][1];
                    u32x4 w; w.x = cvt_pk_f16(y0[0], y0[1]); w.y = cvt_pk_f16(y0[2], y0[3]); w.z = cvt_pk_f16(y1[0], y1[1]); w.w = cvt_pk_f16(y1[2], y1[3]);
                    *(u32x4*)(xp + bj * HALF) = w; } }
    }
};
struct EpiRelu2 {
    static constexpr bool PERM = true, AFTER_DRAIN = false;
    bf16_t* U;
    __device__ __forceinline__ void operator()(const f32x4 (&acc)[2][2][4][2], const Unit& u, int wr, int wc, int fr, int fq) const {
        const int row0 = u.pm * BM + wr * 64 + fr, col0 = u.pn * BM + wc * 32 + 8 * fq;
#pragma unroll
        for (int ai = 0; ai < 2; ++ai)
#pragma unroll
            for (int m = 0; m < 4; ++m) { bf16_t* rowp = U + (size_t)(row0 + ai * HALF + m * 16) * 16384 + col0;
#pragma unroll
                for (int bj = 0; bj < 2; ++bj) { f32x4 v0 = acc[ai][bj][m][0], v1 = acc[ai][bj][m][1];
#pragma unroll
                    for (int e = 0; e < 4; ++e) { const float a = fmaxf(v0[e], 0.f), b = fmaxf(v1[e], 0.f); v0[e] = a * a; v1[e] = b * b; }
                    u32x4 w; w.x = cvt_pk_bf16(v0[0], v0[1]); w.y = cvt_pk_bf16(v0[2], v0[3]); w.z = cvt_pk_bf16(v1[0], v1[1]); w.w = cvt_pk_bf16(v1[2], v1[3]);
                    *(u32x4*)(rowp + bj * HALF) = w; } }
    }
};

template <class Epi, class Sched, bool ALIGN_EPI = false, bool SP2 = false>
__device__ __forceinline__ void gemm_phase(PG8_LAS unsigned char* lds, const Gemm g, const Sched& S, const Epi& E) {
    int tid_ = threadIdx.x; asm volatile("" : "+v"(tid_));
    const int tid = tid_, wid = __builtin_amdgcn_readfirstlane(tid >> 6), lane = tid & 63, wr = wid >> 2, wc = wid & 3, fr = lane & 15, fq = lane >> 4;
    const int K = g.K, nt = K / BK;
    unsigned voffA[2], voffB[2];
#pragma unroll
    for (int i = 0; i < 2; ++i) { int R, C; stage_rc(tid * 16 + i * 8192, R, C); const int Rb = Epi::PERM ? ((R & ~31) + perm32(R & 31)) : R;
        voffA[i] = (unsigned)(R * K + C) * 2u; voffB[i] = (unsigned)(Rb * K + C) * 2u; }
    const size_t kstep = (size_t)(BK * 2);
    const size_t hstep = (size_t)HALF * K * 2;
    const size_t tstep = 2 * hstep;
    const unsigned ldsw = (unsigned)wid * 1024u;
    const int aoff = lds_byte(wr * 64 + fr, fq * 8), boff = lds_byte(wc * 32 + fr, fq * 8);
#define PG8_SA(b, h) (((b) * 2 + (h)) * HTB)
#define PG8_SB(b, h) ((4 + (b) * 2 + (h)) * HTB)
#define PG8_STAGE(bufoff, gbase, voff) do { _Pragma("unroll") for (int _i = 0; _i < 2; ++_i) \
        __builtin_amdgcn_global_load_lds((const unsigned*)((const char*)(gbase) + (voff)[_i]), (PG8_LAS unsigned*)(lds + (bufoff) + ldsw + _i * 8192), 16, 0, 0); } while (0)
#define PG8_LDA(dst, b, h) do { _Pragma("unroll") for (int m = 0; m < 4; ++m) _Pragma("unroll") for (int k = 0; k < 2; ++k) dst[m][k] = *(const PG8_LAS bf16x8*)(lds + PG8_SA(b, h) + aoff + m * 2048 + k * 1024); } while (0)
#define PG8_LDB(dst, b, h) do { _Pragma("unroll") for (int n = 0; n < 2; ++n) _Pragma("unroll") for (int k = 0; k < 2; ++k) dst[n][k] = *(const PG8_LAS bf16x8*)(lds + PG8_SB(b, h) + boff + n * 2048 + k * 1024); } while (0)
#define PG8_MMA(ai, bj, At, Bt) do { __builtin_amdgcn_s_setprio(1); _Pragma("unroll") for (int m = 0; m < 4; ++m) _Pragma("unroll") for (int n = 0; n < 2; ++n) _Pragma("unroll") for (int k = 0; k < 2; ++k) \
        acc[ai][bj][m][n] = __builtin_amdgcn_mfma_f32_16x16x32_bf16(Bt[n][k], At[m][k], acc[ai][bj][m][n], 0, 0, 0); __builtin_amdgcn_s_setprio(0); } while (0)
#define PG8_WAIT_V(n) asm volatile("s_waitcnt vmcnt(" #n ")" ::: "memory")
#define PG8_WAIT_L(n) asm volatile("s_waitcnt lgkmcnt(" #n ")" ::: "memory")
#define PG8_BAR __builtin_amdgcn_s_barrier()
#define PG8_SCHED __builtin_amdgcn_sched_barrier(0)
    Unit cur, nxt; int ui = 0;
    if (!S.next(0, cur)) return;
    f32x4 acc[2][2][4][2];
#pragma unroll
    for (int a = 0; a < 2; ++a)
#pragma unroll
        for (int b = 0; b < 2; ++b)
#pragma unroll
            for (int m = 0; m < 4; ++m)
#pragma unroll
                for (int n = 0; n < 2; ++n) acc[a][b][m][n] = (f32x4){0.f, 0.f, 0.f, 0.f};
    bf16x8 At[4][2], B0[2][2], B1[2][2];
    const char* cA = (const char*)g.A + (size_t)cur.pm * tstep; const char* cB = (const char*)g.Bt + (size_t)cur.pn * tstep;
    S.a_ready(cur);
    if constexpr (SP2) {
        PG8_STAGE(PG8_SB(0, 0), cB, voffB); PG8_STAGE(PG8_SB(0, 1), cB + hstep, voffB); PG8_STAGE(PG8_SA(0, 0), cA, voffA); PG8_STAGE(PG8_SA(0, 1), cA + hstep, voffA);
        if (wr == 1) PG8_BAR;
        PG8_WAIT_V(2); PG8_BAR;
        PG8_STAGE(PG8_SB(1, 0), cB + kstep, voffB); PG8_STAGE(PG8_SA(1, 0), cA + kstep, voffA); PG8_STAGE(PG8_SB(1, 1), cB + hstep + kstep, voffB);
        PG8_WAIT_V(6); PG8_BAR;
    } else {
        PG8_STAGE(PG8_SB(0, 0), cB, voffB); PG8_STAGE(PG8_SA(0, 0), cA, voffA); PG8_STAGE(PG8_SB(0, 1), cB + hstep, voffB); PG8_STAGE(PG8_SA(0, 1), cA + hstep, voffA);
        if (wr == 1) PG8_BAR;
        PG8_WAIT_V(4); PG8_BAR;
        PG8_STAGE(PG8_SB(1, 0), cB + kstep, voffB); PG8_STAGE(PG8_SA(1, 0), cA + kstep, voffA); PG8_STAGE(PG8_SB(1, 1), cB + hstep + kstep, voffB);
        PG8_WAIT_V(6); PG8_BAR;
    }
    for (;;) {
        const bool has_next = S.next(ui + 1, nxt);
        const char* nA = has_next ? (const char*)g.A + (size_t)nxt.pm * tstep : cA; const char* nB = has_next ? (const char*)g.Bt + (size_t)nxt.pn * tstep : cB;
        for (int t = 0; t < nt; t += 2) {
            const bool last = (t == nt - 2);
            const char* a1 = cA + (size_t)(t + 1) * kstep;
            const char* a2 = last ? nA : cA + (size_t)(t + 2) * kstep; const char* b2 = last ? nB : cB + (size_t)(t + 2) * kstep;
            const char* a3 = a2 + kstep; const char* b3 = b2 + kstep;
            if (last && has_next) S.a_ready(nxt);
            if constexpr (SP2) {
            PG8_LDB(B0, 0, 0); PG8_LDB(B1, 0, 1); PG8_SCHED; PG8_LDA(At, 0, 0); PG8_STAGE(PG8_SA(1, 1), a1 + hstep, voffA);
            PG8_WAIT_V(8); PG8_WAIT_L(0); PG8_BAR; PG8_MMA(0, 0, At, B0); PG8_MMA(0, 1, At, B1); PG8_BAR; PG8_SCHED;
            PG8_LDA(At, 0, 1); PG8_STAGE(PG8_SB(0, 0), b2, voffB); PG8_STAGE(PG8_SB(0, 1), b2 + hstep, voffB); PG8_STAGE(PG8_SA(0, 0), a2, voffA);
            PG8_WAIT_V(8); PG8_WAIT_L(0); PG8_BAR; PG8_MMA(1, 0, At, B0); PG8_MMA(1, 1, At, B1); PG8_BAR; PG8_SCHED;
            PG8_LDB(B0, 1, 0); PG8_LDB(B1, 1, 1); PG8_SCHED; PG8_LDA(At, 1, 0); PG8_STAGE(PG8_SA(0, 1), a2 + hstep, voffA);
            PG8_WAIT_V(8); PG8_WAIT_L(0); PG8_BAR; PG8_MMA(0, 0, At, B0); PG8_MMA(0, 1, At, B1); PG8_BAR; PG8_SCHED;
            PG8_LDA(At, 1, 1); PG8_STAGE(PG8_SB(1, 0), b3, voffB); PG8_STAGE(PG8_SB(1, 1), b3 + hstep, voffB); PG8_STAGE(PG8_SA(1, 0), a3, voffA);
            PG8_WAIT_V(8); PG8_WAIT_L(0); PG8_BAR; PG8_MMA(1, 0, At, B0); PG8_MMA(1, 1, At, B1); PG8_BAR; PG8_SCHED;
            } else {
            PG8_LDB(B0, 0, 0); PG8_SCHED; PG8_LDA(At, 0, 0); PG8_STAGE(PG8_SA(1, 1), a1 + hstep, voffA);
            PG8_WAIT_L(8); PG8_BAR; PG8_WAIT_L(0); PG8_MMA(0, 0, At, B0); PG8_BAR; PG8_SCHED;
            PG8_LDB(B1, 0, 1); PG8_STAGE(PG8_SB(0, 0), b2, voffB);
            PG8_BAR; PG8_WAIT_L(0); PG8_MMA(0, 1, At, B1); PG8_BAR;
            PG8_LDA(At, 0, 1); PG8_STAGE(PG8_SA(0, 0), a2, voffA);
            PG8_BAR; PG8_WAIT_L(0); PG8_MMA(1, 0, At, B0); PG8_BAR; PG8_SCHED;
            PG8_STAGE(PG8_SB(0, 1), b2 + hstep, voffB);
            PG8_WAIT_V(6); PG8_BAR; PG8_MMA(1, 1, At, B1); PG8_BAR;
            PG8_LDB(B0, 1, 0); PG8_SCHED; PG8_LDA(At, 1, 0); PG8_STAGE(PG8_SA(0, 1), a2 + hstep, voffA);
            PG8_WAIT_L(8); PG8_BAR; PG8_WAIT_L(0); PG8_MMA(0, 0, At, B0); PG8_BAR; PG8_SCHED;
            PG8_LDB(B1, 1, 1); PG8_STAGE(PG8_SB(1, 0), b3, voffB);
            PG8_BAR; PG8_WAIT_L(0); PG8_MMA(0, 1, At, B1); PG8_BAR;
            PG8_LDA(At, 1, 1); PG8_STAGE(PG8_SA(1, 0), a3, voffA);
            PG8_BAR; PG8_WAIT_L(0); PG8_MMA(1, 0, At, B0); PG8_BAR; PG8_SCHED;
            PG8_STAGE(PG8_SB(1, 1), b3 + hstep, voffB);
            PG8_WAIT_V(6); PG8_BAR; PG8_MMA(1, 1, At, B1); PG8_BAR;
            }
        }
        if constexpr (ALIGN_EPI) { if (wr == 0) PG8_BAR; }
        if constexpr (!Epi::AFTER_DRAIN) { E(acc, cur, wr, wc, fr, fq); S.done(cur); }
        if (!has_next) break;
#pragma unroll
        for (int a = 0; a < 2; ++a)
#pragma unroll
            for (int b = 0; b < 2; ++b)
#pragma unroll
                for (int m = 0; m < 4; ++m)
#pragma unroll
                    for (int n = 0; n < 2; ++n) acc[a][b][m][n] = (f32x4){0.f, 0.f, 0.f, 0.f};
        cur = nxt; cA = nA; cB = nB; ++ui;
        if constexpr (ALIGN_EPI) { if (wr == 1) PG8_BAR; }
    }
    PG8_WAIT_V(0);
    if constexpr (!ALIGN_EPI) { if (wr == 0) PG8_BAR; }
    PG8_BAR;
    if constexpr (Epi::AFTER_DRAIN) { E.fused(acc, cur, wr, wc, fr, fq, lds, wid, lane); S.done(cur); }
#undef PG8_SA
#undef PG8_SB
#undef PG8_STAGE
#undef PG8_LDA
#undef PG8_LDB
#undef PG8_MMA
#undef PG8_WAIT_V
#undef PG8_WAIT_L
#undef PG8_BAR
#undef PG8_SCHED
}
}


constexpr int NWAVES = 8;
constexpr int DM = 4096, T_CTX = 8192, T_LAT = 32768, L_CTX = 256, L_LAT = 4096, B_CTX = 32, B_LAT = 8;
constexpr int NH_A = 16, DH_A = 128, D_ATT = 2048, NH_R = 32, DH_R = 64, D_RW = 2048;
constexpr int C_RWKV = 6592, C_RWKV_P = 6656, D_IN = 20928, N_IN_P = 20992, D_FF = 16384, N_LORA = 10240, K_LORA = 512, NMOD = 24576;
constexpr float RMS_EPS = 1e-6f, LNX_EPS = 64e-5f;
constexpr size_t MiB = 1u << 20;
constexpr size_t WS_CTL = 0, CTL_ZERO_BYTES = 1 * MiB;
constexpr size_t WS_MODP = 1 * MiB;
constexpr size_t WS_MOD = 8 * MiB;
constexpr size_t WS_WIN = 9 * MiB;
constexpr size_t WS_WOA = 173 * MiB, WS_WOR = 189 * MiB, WS_WOUT = 205 * MiB;
constexpr size_t WS_WM1 = 237 * MiB, WS_WM2 = 365 * MiB;
constexpr size_t WS_WLORA = 493 * MiB;
constexpr size_t WS_CK = 503 * MiB, WS_CV = 511 * MiB;
constexpr size_t WS_H = 520 * MiB;
constexpr size_t WS_Q = 776 * MiB, WS_K = 904 * MiB, WS_V = 1032 * MiB;
constexpr size_t WS_PR = 1160 * MiB;
constexpr size_t WS_ORW = 1832 * MiB;
constexpr size_t WS_HLAT = 1576 * MiB;
constexpr size_t WS_MID = 1160 * MiB;
constexpr size_t WS_U = 776 * MiB;
constexpr size_t WS_END = 2048 * MiB;
constexpr size_t WS_RS = 520 * MiB, WS_KS = 648 * MiB, WS_VS = 1576 * MiB, WS_KK = 1704 * MiB;
constexpr size_t WS_DF = 1160 * MiB, WS_DB = 1288 * MiB, WS_AF = 1416 * MiB, WS_YF = WS_ORW, WS_AB = WS_K, WS_LG = WS_V;
constexpr size_t WS_YB_CTX = 1960 * MiB, WS_YB_LAT = WS_WIN, WS_LA = 2016 * MiB;
static_assert(WS_U + (size_t)T_LAT * D_FF * 2 <= WS_END && WS_LA + (size_t)T_LAT * K_LORA * 2 <= WS_END && WS_YB_CTX + (size_t)T_CTX * D_RW * 2 <= WS_LA && WS_YF + (size_t)T_LAT * D_RW * 2 <= WS_YB_CTX && WS_MID + (size_t)T_LAT * DM * 2 <= WS_AF, "d_ws map");
constexpr int CW_BAR = 4096;
constexpr int RING_OFF = 0, RING_BYTES = 131072;
constexpr int LDSCTL_OFF = RING_BYTES, MISC_OFF = LDSCTL_OFF + 320;
constexpr int LDS_BYTES = 147456;

#define GAS __attribute__((address_space(1)))
#define LAS __attribute__((address_space(3)))
typedef unsigned short bf16;
typedef unsigned v4u __attribute__((ext_vector_type(4)));
typedef float f32x4 __attribute__((ext_vector_type(4)));
typedef short bf16x8 __attribute__((ext_vector_type(8)));
typedef GAS unsigned gu32;
typedef GAS unsigned long long gu64;
#define RLX_AGENT __ATOMIC_RELAXED, __HIP_MEMORY_SCOPE_AGENT
#define LDS_WAIT() asm volatile("s_waitcnt lgkmcnt(0)" ::: "memory")
#define VM_WAIT() asm volatile("s_waitcnt vmcnt(0)" ::: "memory")
__device__ __forceinline__ unsigned long long rt() { return __builtin_amdgcn_s_memrealtime(); }
__device__ __forceinline__ unsigned f2bf(float f) { unsigned u = __builtin_bit_cast(unsigned, f); return (u + 0x7fffu + ((u >> 16) & 1u)) >> 16; }
__device__ __forceinline__ unsigned pk2(float lo, float hi) { return f2bf(lo) | (f2bf(hi) << 16); }

#define XB_TMO      128
#define XB_XCNT(j)  (256  + 64 * (j))
#define XB_XSUB(j)  (1280 + 64 * (j))
#define XB_XGEN(j)  (2304 + 64 * (j))
#define XB_TOP      3328
#define XB_TOPGEN   3392
#define XCD_BAR_WORDS 3456
#define XB_SPIN_CAP (1u << 18)

__device__ __forceinline__ unsigned xb_ld(unsigned* p)              { return __hip_atomic_load(p, __ATOMIC_RELAXED, __HIP_MEMORY_SCOPE_AGENT); }
__device__ __forceinline__ unsigned xb_add(unsigned* p, unsigned v) { return __hip_atomic_fetch_add(p, v, __ATOMIC_RELAXED, __HIP_MEMORY_SCOPE_AGENT); }
__device__ __forceinline__ unsigned xb_xcc_id() { return (unsigned)__builtin_amdgcn_s_getreg((3 << 11) | 20) & 0xFu; }
#define XB_SPIN(cond, bar) do { unsigned _sp = 0; while (cond) { __builtin_amdgcn_s_sleep(1); \
    if ((++_sp & 255u) == 0u) { if (xb_ld(&(bar)[XB_TMO])) break; if (_sp > XB_SPIN_CAP) { atomicAdd(&(bar)[XB_TMO], 1u); break; } } } } while (0)

struct XcdBarrier {
    unsigned* bar; unsigned x;
    volatile LAS unsigned* st;
};

__device__ __forceinline__ XcdBarrier xcd_barrier_post(unsigned* bar, volatile LAS unsigned* st) {
    XcdBarrier b; b.bar = bar; b.x = xb_xcc_id(); b.st = st;
    if (threadIdx.x == 0) (void)xb_add(&bar[XB_XCNT(b.x)], 1u);
    return b;
}
__device__ __forceinline__ void xcd_barrier_complete(unsigned* bar, unsigned x, unsigned& nloc, unsigned& nx) {
    const unsigned G = gridDim.x * gridDim.y * gridDim.z;
    unsigned sum, cnt, mine, sp = 0u;
    for (;;) {
        sum = 0u; cnt = 0u; mine = 0u;
#pragma unroll
        for (unsigned j = 0; j < 16; ++j) { const unsigned c = xb_ld(&bar[XB_XCNT(j)]); sum += c; cnt += (c > 0u) ? 1u : 0u; mine = (j == x) ? c : mine; }
        if (sum == G) break;
        __builtin_amdgcn_s_sleep(1);
        if ((++sp & 255u) == 0u) { if (xb_ld(&bar[XB_TMO])) break; if (sp > XB_SPIN_CAP) { atomicAdd(&bar[XB_TMO], 1u); break; } }
    }
    nloc = mine > 0u ? mine : 1u; nx = cnt > 0u ? cnt : 1u;
}

__device__ __forceinline__ void xcd_barrier(const XcdBarrier& b) {
    asm volatile("s_waitcnt vmcnt(0)" ::: "memory");
    __syncthreads();
    if (threadIdx.x == 0) {
        unsigned* bar = b.bar;
        __builtin_amdgcn_s_waitcnt(0);
        unsigned nloc = b.st[0], nx = b.st[1];
        if (nloc == 0u) { xcd_barrier_complete(bar, b.x, nloc, nx); b.st[0] = nloc; b.st[1] = nx; }
        const unsigned old = xb_add(&bar[XB_XSUB(b.x)], 1u);
        const unsigned gen = old / nloc;
        if (old + 1u == (gen + 1u) * nloc) {
            __builtin_amdgcn_fence(__ATOMIC_RELEASE, "agent");
            asm volatile("s_waitcnt vmcnt(0)" ::: "memory");
            const unsigned og = xb_add(&bar[XB_TOP], 1u);
            const unsigned tg = og / nx;
            if (og + 1u == (tg + 1u) * nx) xb_add(&bar[XB_TOPGEN], 1u);
            else XB_SPIN(xb_ld(&bar[XB_TOPGEN]) == tg, bar);
            __builtin_amdgcn_fence(__ATOMIC_ACQUIRE, "agent");
            xb_add(&bar[XB_XGEN(b.x)], 1u);
            asm volatile("s_waitcnt vmcnt(0)" ::: "memory");
        } else {
            XB_SPIN(xb_ld(&bar[XB_XGEN(b.x)]) == gen, bar);
            __builtin_amdgcn_fence(__ATOMIC_ACQUIRE, "agent");
            asm volatile("s_waitcnt vmcnt(0)" ::: "memory");
        }
    }
    __syncthreads();
}

typedef unsigned short h16s;
typedef _Float16 h16x8 __attribute__((ext_vector_type(8)));
typedef float f32x16 __attribute__((ext_vector_type(16)));
typedef short s16x4 __attribute__((ext_vector_type(4)));
struct Frame {
    LAS unsigned char* lds;
    volatile LAS unsigned* MISC;
    gu32* ctl;
    int tid, lane, wave;
    int vcu, G;
    unsigned char* ws;
    float* out;
};
struct Args { const float* in[31]; float* out; unsigned char* ws; };
enum { I_XP = 0, I_XS, I_CK, I_CV, I_SF, I_SB, I_C, I_CCTX, I_WMOD, I_BMOD, I_N1, I_N2, I_NF, I_WIN, I_MU, I_RPB, I_W0, I_W2, I_A0, I_A2, I_G2, I_KK, I_KA, I_RK, I_LNW, I_LNB, I_WOA, I_WOR, I_WOUT, I_WM1, I_WM2 };
constexpr size_t O_Y = 0, O_NK = (size_t)(T_CTX + T_LAT) * DM, O_NV = O_NK + (size_t)T_CTX * D_ATT, O_SF = O_NV + (size_t)T_CTX * D_ATT, O_SB = O_SF + (size_t)B_CTX * NH_R * 64 * 64;

__device__ __forceinline__ float wave_sum(float v) {
#pragma unroll
    for (int o = 1; o < 64; o <<= 1) v += __shfl_xor(v, o);
    return v;
}
__device__ __forceinline__ unsigned pkbf(float lo, float hi) { return pg8::cvt_pk_bf16(lo, hi); }
__device__ __forceinline__ unsigned pkh(float lo, float hi) { return pg8::cvt_pk_f16(lo, hi); }
__device__ __forceinline__ float sigm(float x) { return pg8::sigmoidf_(x); }
__device__ __forceinline__ void unpack_h8(const v4u w, float (&f)[8]) { const h16x8 h = __builtin_bit_cast(h16x8, w);
#pragma unroll
    for (int e = 0; e < 8; ++e) f[e] = (float)h[e]; }

__device__ __forceinline__ void p0_transpose_item(const float* W, int ldw, int col_off, int nblk, bf16* WT, int ldt, int row_off, LAS float* scr, int item, int lane) {
    const int kb = item / nblk, nb = item % nblk, k0 = 64 * kb, n0 = 32 * nb;
    { f32x4 t[8]; const int kr = lane >> 3, nq = (lane & 7) * 4;
#pragma unroll
      for (int i = 0; i < 8; ++i) t[i] = *(const GAS f32x4*)(W + (size_t)(k0 + 8 * i + kr) * ldw + col_off + n0 + nq);
#pragma unroll
      for (int i = 0; i < 8; ++i) { LAS float* d = scr + (8 * i + kr) * 33 + nq; d[0] = t[i].x; d[1] = t[i].y; d[2] = t[i].z; d[3] = t[i].w; } }
    LDS_WAIT(); asm volatile("" ::: "memory");
    const int c = lane & 7;
#pragma unroll
    for (int j = 0; j < 4; ++j) { const int n = (lane >> 3) + 8 * j; const LAS float* s = scr + (8 * c) * 33 + n;
        v4u o; o.x = pkbf(s[0 * 33], s[1 * 33]); o.y = pkbf(s[2 * 33], s[3 * 33]); o.z = pkbf(s[4 * 33], s[5 * 33]); o.w = pkbf(s[6 * 33], s[7 * 33]);
        *(GAS v4u*)(WT + (size_t)(row_off + n0 + n) * ldt + k0 + 8 * c) = o; }
    LDS_WAIT(); asm volatile("" ::: "memory");
}
struct TDesc { const float* W; bf16* WT; int ldw, lgn, ldt, item; };
__device__ __forceinline__ TDesc late_desc(const Args& A, unsigned char* ws, int r) {
    constexpr int E0 = 32 * 128, E1 = E0 + 32 * 128, E2 = E1 + 64 * 128, E3 = E2 + 64 * 512;
    const int sel = (r >= E0) + (r >= E1) + (r >= E2) + (r >= E3);
    const int base = sel == 0 ? 0 : sel == 1 ? E0 : sel == 2 ? E1 : sel == 3 ? E2 : E3;
    const int widx = sel == 0 ? I_WOA : sel == 1 ? I_WOR : sel == 2 ? I_WOUT : sel == 3 ? I_WM1 : I_WM2;
    const size_t woff = sel == 0 ? WS_WOA : sel == 1 ? WS_WOR : sel == 2 ? WS_WOUT : sel == 3 ? WS_WM1 : WS_WM2;
    const int ldw = sel == 3 ? D_FF : DM, lgn = sel == 3 ? 9 : 7, ldt = sel == 0 ? D_ATT : sel == 1 ? D_RW : sel == 4 ? D_FF : DM;
    typedef const float* fptr; const __attribute__((address_space(4))) fptr* kin = (const __attribute__((address_space(4))) fptr*)__builtin_amdgcn_kernarg_segment_ptr();
    return TDesc{kin[widx], (bf16*)(ws + woff), ldw, lgn, ldt, r - base};
}
constexpr int LATE_ITEMS = 32 * 128 + 32 * 128 + 64 * 128 + 64 * 512 + 256 * 128;
__device__ __forceinline__ void late_load(f32x4 (&t)[8], const TDesc& d, int lane) {
    const int kb = d.item >> d.lgn, nb = d.item & ((1 << d.lgn) - 1), k0 = 64 * kb, n0 = 32 * nb, kr = lane >> 3, nq = (lane & 7) * 4;
#pragma unroll
    for (int i = 0; i < 8; ++i) t[i] = *(const GAS f32x4*)(d.W + (size_t)(k0 + 8 * i + kr) * d.ldw + n0 + nq);
}
__device__ __forceinline__ void late_finish(const f32x4 (&t)[8], const TDesc& d, LAS float* scr, int lane) {
    const int kb = d.item >> d.lgn, nb = d.item & ((1 << d.lgn) - 1), k0 = 64 * kb, n0 = 32 * nb, kr = lane >> 3, nq = (lane & 7) * 4;
#pragma unroll
    for (int i = 0; i < 8; ++i) { LAS float* q = scr + (8 * i + kr) * 33 + nq; q[0] = t[i].x; q[1] = t[i].y; q[2] = t[i].z; q[3] = t[i].w; }
    LDS_WAIT(); asm volatile("" ::: "memory");
    const int c = lane & 7;
#pragma unroll
    for (int j = 0; j < 4; ++j) { const int n = (lane >> 3) + 8 * j; const LAS float* sp = scr + (8 * c) * 33 + n;
        v4u o; o.x = pkbf(sp[0 * 33], sp[1 * 33]); o.y = pkbf(sp[2 * 33], sp[3 * 33]); o.z = pkbf(sp[4 * 33], sp[5 * 33]); o.w = pkbf(sp[6 * 33], sp[7 * 33]);
        *(GAS v4u*)(d.WT + (size_t)(n0 + n) * d.ldt + k0 + 8 * c) = o; }
    LDS_WAIT(); asm volatile("" ::: "memory");
}
__device__ __forceinline__ void late_weight_copies(Frame& F, const Args& A, int part, int nparts) {
    LAS float* scr = (LAS float*)(F.lds + RING_OFF + F.wave * 16384);
    int w0 = part * NWAVES + F.wave; const int st = nparts * NWAVES;
    asm volatile("" : "+v"(w0));
    if (w0 >= LATE_ITEMS) return;
    f32x4 ta[8], tb[8], tc[8];
#define LATE_LD(T, IT) late_load(T, late_desc(A, F.ws, min((IT), LATE_ITEMS - 1)), F.lane)
#define LATE_FN(T, IT) late_finish(T, late_desc(A, F.ws, (IT)), scr, F.lane)
    LATE_LD(ta, w0); LATE_LD(tb, w0 + st);
    for (int it = w0;;) {
        LATE_LD(tc, it + 2 * st); LATE_FN(ta, it); if (it + st >= LATE_ITEMS) break;
        LATE_LD(ta, it + 3 * st); LATE_FN(tb, it + st); if (it + 2 * st >= LATE_ITEMS) break;
        LATE_LD(tb, it + 4 * st); LATE_FN(tc, it + 2 * st); if (it + 3 * st >= LATE_ITEMS) break;
        it += 3 * st;
    }
#undef LATE_LD
#undef LATE_FN
}
__device__ __forceinline__ void p0_prologue(Frame& F, const Args& A) {
    const int gw = F.vcu * NWAVES + F.wave, NGW = F.G * NWAVES, gt = gw * 64 + F.lane, NGT = NGW * 64;
    unsigned char* ws = F.ws;
    { LAS float* scr = (LAS float*)(F.lds + RING_OFF + F.wave * 16384);
      constexpr int I_A = 64 * 398, I_B = 64 * 256, NITEMS = I_A + I_B;
      for (int it = gw; it < NITEMS; it += NGW) { int r = it;
          if (r < I_A) { p0_transpose_item(A.in[I_WIN], D_IN, 0, 398, (bf16*)(ws + WS_WIN), DM, 0, scr, r, F.lane); continue; } r -= I_A;
          p0_transpose_item(A.in[I_WIN], D_IN, 12736, 256, (bf16*)(ws + WS_WIN), DM, 12800, scr, r, F.lane);
      } }
    { GAS v4u* p = (GAS v4u*)((bf16*)(ws + WS_WIN) + (size_t)12736 * DM); const int n = 64 * DM / 8; for (int i = gt; i < n; i += NGT) p[i] = (v4u){0u, 0u, 0u, 0u}; }
    { bf16* WL = (bf16*)(ws + WS_WLORA); const float *w2 = A.in[I_W2], *a2 = A.in[I_A2], *g2 = A.in[I_G2];
      for (int i = gt; i < N_LORA * 256 / 2; i += NGT) { const int n = i >> 7, k = (i & 127) * 2; const int sel = n >> 11, col = n & 2047; float v[2];
#pragma unroll
          for (int e = 0; e < 2; ++e) { const int kk = k + e; float x = 0.f;
              if (sel < 2) { if (kk < 96) x = w2[((size_t)sel * 96 + kk) * 2048 + col]; }
              else if (sel < 4) { if (kk >= 96 && kk < 192) x = a2[((size_t)(sel - 2) * 96 + (kk - 96)) * 2048 + col]; }
              else x = g2[(size_t)kk * 2048 + col];
              v[e] = x; }
          ((GAS unsigned*)WL)[i] = pkbf(v[0], v[1]); } }
    { const int n8 = B_LAT * 256 * 2048 / 8;
      for (int i = gt; i < 2 * n8; i += NGT) { const bool isk = i < n8; const int j = isk ? i : i - n8; const float* src = (isk ? A.in[I_CK] : A.in[I_CV]) + (size_t)j * 8;
          const f32x4 a = *(const GAS f32x4*)src, b = *(const GAS f32x4*)(src + 4); v4u o; o.x = pkbf(a.x, a.y); o.y = pkbf(a.z, a.w); o.z = pkbf(b.x, b.y); o.w = pkbf(b.z, b.w);
          *((GAS v4u*)(ws + (isk ? WS_CK : WS_CV)) + j) = o; } }
    { LAS float* sc = (LAS float*)(F.lds + RING_OFF); LAS float* red = sc + 9 * 512; const float* wm = A.in[I_WMOD]; float* MODP = (float*)(ws + WS_MODP);
      for (int it = F.vcu; it < 96 * 8; it += F.G) { const int cb = it % 96, ks = it / 96;
          for (int idx = F.tid; idx < 9 * 512; idx += NWAVES * 64) { const int j = idx >> 9, kk = idx & 511, k = ks * 512 + kk; const float c = j == 0 ? A.in[I_CCTX][k] : A.in[I_C][(size_t)(j - 1) * DM + k]; sc[idx] = c * sigm(c); }
          __syncthreads();
          f32x4 acc[9];
#pragma unroll
          for (int j = 0; j < 9; ++j) acc[j] = (f32x4){0.f, 0.f, 0.f, 0.f};
          const float* wp = wm + (size_t)(ks * 512 + F.wave * 64) * NMOD + cb * 256 + F.lane * 4;
#pragma unroll 8
          for (int r = 0; r < 64; ++r) { const f32x4 w4 = *(const GAS f32x4*)(wp + (size_t)r * NMOD); const int kk = F.wave * 64 + r;
#pragma unroll
              for (int j = 0; j < 9; ++j) acc[j] += w4 * sc[j * 512 + kk]; }
#pragma unroll
          for (int j = 0; j < 9; ++j) *(LAS f32x4*)(red + (F.wave * 9 + j) * 256 + F.lane * 4) = acc[j];
          __syncthreads();
          for (int idx = F.tid; idx < 9 * 256; idx += NWAVES * 64) { const int j = idx >> 8, c = idx & 255; float s = 0.f;
#pragma unroll
              for (int w = 0; w < 8; ++w) s += red[(w * 9 + j) * 256 + c];
              MODP[((size_t)ks * 9 + j) * NMOD + cb * 256 + c] = s; }
          __syncthreads(); } }
}
__device__ __forceinline__ void p0b_mod_finalize(Frame& F, const Args& A) {
    const int gt = (F.vcu * NWAVES + F.wave) * 64 + F.lane, NGT = F.G * NWAVES * 64; const float* MODP = (const float*)(F.ws + WS_MODP); float* MOD = (float*)(F.ws + WS_MOD);
    for (int i = gt; i < 9 * NMOD; i += NGT) { const int n = i % NMOD; float s = A.in[I_BMOD][n];
#pragma unroll
        for (int ks = 0; ks < 8; ++ks) s += MODP[(size_t)ks * 9 * NMOD + i];
        MOD[i] = s; }
}
template <bool XF16> __device__ __forceinline__ void modnorm_rows(Frame& F, const void* Xv, int M, const float* nw, int sh_off, int sc_off, int jbase, int rps, int jmul, bf16* H) {
    static_assert(!XF16, "fp16 rows: modnorm16_rows");
    const int gw = F.vcu * NWAVES + F.wave, NGW = F.G * NWAVES; const float* MOD = (const float*)(F.ws + WS_MOD);
    for (int row0 = 2 * gw; row0 < M; row0 += 2 * NGW) {
        f32x4 v[2][8][2]; float ss[2] = {0.f, 0.f};
#pragma unroll
        for (int q = 0; q < 2; ++q) { const float* xr = (const float*)Xv + (size_t)(row0 + q) * DM + F.lane * 8;
#pragma unroll
            for (int c = 0; c < 8; ++c) { v[q][c][0] = *(const GAS f32x4*)(xr + c * 512); v[q][c][1] = *(const GAS f32x4*)(xr + c * 512 + 4); } }
#pragma unroll
        for (int q = 0; q < 2; ++q)
#pragma unroll
            for (int c = 0; c < 8; ++c)
                ss[q] += (v[q][c][0].x * v[q][c][0].x + v[q][c][0].y * v[q][c][0].y) + (v[q][c][0].z * v[q][c][0].z + v[q][c][0].w * v[q][c][0].w) + (v[q][c][1].x * v[q][c][1].x + v[q][c][1].y * v[q][c][1].y) + (v[q][c][1].z * v[q][c][1].z + v[q][c][1].w * v[q][c][1].w);
        const float rstd[2] = {1.0f / sqrtf(wave_sum(ss[0]) * (1.0f / DM) + RMS_EPS), 1.0f / sqrtf(wave_sum(ss[1]) * (1.0f / DM) + RMS_EPS)};
        const float* mj = MOD + (size_t)(jbase + (row0 / rps) * jmul) * NMOD + F.lane * 8; bf16* hr = H + (size_t)row0 * DM + F.lane * 8;
#pragma unroll
        for (int c = 0; c < 8; ++c) { unsigned ow[2][4];
#pragma unroll
            for (int h = 0; h < 2; ++h) { const f32x4 w4 = *(const GAS f32x4*)(nw + F.lane * 8 + c * 512 + 4 * h), s4 = *(const GAS f32x4*)(mj + sc_off + c * 512 + 4 * h), b4 = *(const GAS f32x4*)(mj + sh_off + c * 512 + 4 * h);
                const f32x4 cf = w4 * (s4 + 1.0f);
#pragma unroll
                for (int q = 0; q < 2; ++q) { const f32x4 y = v[q][c][h] * rstd[q] * cf + b4; ow[q][2 * h] = pkbf(y.x, y.y); ow[q][2 * h + 1] = pkbf(y.z, y.w); } }
#pragma unroll
            for (int q = 0; q < 2; ++q) { v4u o; o.x = ow[q][0]; o.y = ow[q][1]; o.z = ow[q][2]; o.w = ow[q][3]; *(GAS v4u*)(hr + (size_t)q * DM + c * 512) = o; } }
    }
}
__device__ __forceinline__ void final_norm_rows(Frame& F, float* Y, int M, const float* nw) {
    const int gw = F.vcu * NWAVES + F.wave, NGW = F.G * NWAVES;
    for (int row0 = gw; row0 < M; row0 += 2 * NGW) {
        f32x4 v[2][8][2]; float ss[2] = {0.f, 0.f}; const bool two = row0 + NGW < M;
#pragma unroll
        for (int q = 0; q < 2; ++q) { const int row = q ? (two ? row0 + NGW : row0) : row0;
#pragma unroll
            for (int c = 0; c < 8; ++c) { const v4u h = *(const GAS v4u*)((const h16s*)(Y + (size_t)row * DM) + F.lane * 8 + c * 512); v[q][c][0] = pg8::h4lo(h.x, h.y); v[q][c][1] = pg8::h4lo(h.z, h.w); } }
#pragma unroll
        for (int q = 0; q < 2; ++q)
#pragma unroll
            for (int c = 0; c < 8; ++c)
                ss[q] += (v[q][c][0].x * v[q][c][0].x + v[q][c][0].y * v[q][c][0].y) + (v[q][c][0].z * v[q][c][0].z + v[q][c][0].w * v[q][c][0].w) + (v[q][c][1].x * v[q][c][1].x + v[q][c][1].y * v[q][c][1].y) + (v[q][c][1].z * v[q][c][1].z + v[q][c][1].w * v[q][c][1].w);
        const float rstd0 = 1.0f / sqrtf(wave_sum(ss[0]) * (1.0f / DM) + RMS_EPS), rstd1 = 1.0f / sqrtf(wave_sum(ss[1]) * (1.0f / DM) + RMS_EPS);
        asm volatile("s_waitcnt vmcnt(0)" ::: "memory");
#pragma unroll
        for (int q = 0; q < 2; ++q) { if (q == 1 && !two) break; float* xr = Y + (size_t)(row0 + q * NGW) * DM + F.lane * 8; const float rstd = q ? rstd1 : rstd0;
#pragma unroll
            for (int c = 0; c < 8; ++c)
#pragma unroll
                for (int h = 0; h < 2; ++h) { const f32x4 w4 = *(const GAS f32x4*)(nw + F.lane * 8 + c * 512 + 4 * h); *(GAS f32x4*)(xr + c * 512 + 4 * h) = v[q][c][h] * rstd * w4; } }
    }
}
#define SSQ4(V) (((V).x * (V).x + (V).y * (V).y) + ((V).z * (V).z + (V).w * (V).w))
__device__ __forceinline__ void rows2_load(v4u (&B)[2][8], const h16s* X, int r0, int NGW, int M, int lane) {
#pragma unroll
    for (int q = 0; q < 2; ++q) { const int row = min(r0 + q * NGW, M - 1);
#pragma unroll
        for (int c = 0; c < 8; ++c) B[q][c] = *(const GAS v4u*)(X + (size_t)row * 8192 + lane * 8 + c * 512); }
}
__device__ __forceinline__ void rows2_rstd(const v4u (&B)[2][8], float (&rstd)[2]) {
    float ss[2] = {0.f, 0.f};
#pragma unroll
    for (int q = 0; q < 2; ++q)
#pragma unroll
        for (int c = 0; c < 8; ++c) { const f32x4 a = pg8::h4lo(B[q][c].x, B[q][c].y), b = pg8::h4lo(B[q][c].z, B[q][c].w); ss[q] += SSQ4(a) + SSQ4(b); }
#pragma unroll
    for (int q = 0; q < 2; ++q) rstd[q] = 1.0f / sqrtf(wave_sum(ss[q]) * (1.0f / DM) + RMS_EPS);
}
__device__ __forceinline__ void modnorm16_store(Frame& F, const v4u (&B)[2][8], int r0, int M, const float* nw, int sh_off, int sc_off, int jbase, int rps, int jmul, bf16* H) {
    const float* MOD = (const float*)(F.ws + WS_MOD); float rstd[2]; rows2_rstd(B, rstd);
    if (r0 >= M) return;
    const float* mj = MOD + (size_t)(jbase + (r0 / rps) * jmul) * NMOD + F.lane * 8; bf16* hr = H + (size_t)r0 * DM + F.lane * 8;
#pragma unroll
    for (int c = 0; c < 8; ++c) { unsigned ow[2][4];
#pragma unroll
        for (int h = 0; h < 2; ++h) { const f32x4 w4 = *(const GAS f32x4*)(nw + F.lane * 8 + c * 512 + 4 * h), s4 = *(const GAS f32x4*)(mj + sc_off + c * 512 + 4 * h), b4 = *(const GAS f32x4*)(mj + sh_off + c * 512 + 4 * h);
            const f32x4 cf = w4 * (s4 + 1.0f);
#pragma unroll
            for (int q = 0; q < 2; ++q) { unsigned u0 = h ? B[q][c].z : B[q][c].x, u1 = h ? B[q][c].w : B[q][c].y; asm volatile("" : "+v"(u0), "+v"(u1));
                const f32x4 x = pg8::h4lo(u0, u1);
                const f32x4 y = x * rstd[q] * cf + b4; ow[q][2 * h] = pkbf(y.x, y.y); ow[q][2 * h + 1] = pkbf(y.z, y.w); } }
#pragma unroll
        for (int q = 0; q < 2; ++q) { v4u o; o.x = ow[q][0]; o.y = ow[q][1]; o.z = ow[q][2]; o.w = ow[q][3]; *(GAS v4u*)(hr + (size_t)q * DM + c * 512) = o; }
        if (c & 1) asm volatile("" ::: "memory"); }
}
__device__ __forceinline__ void modnorm16_rows(Frame& F, const h16s* X, int M, const float* nw, int sh_off, int sc_off, int jbase, int rps, int jmul, bf16* H) {
    const int gw = F.vcu * NWAVES + F.wave, NGW = F.G * NWAVES;
    if (2 * gw >= M) return;
    v4u A_[2][8], B_[2][8]; rows2_load(A_, X, 2 * gw, 1, M, F.lane);
    for (int r0 = 2 * gw; r0 < M; r0 += 4 * NGW) {
        rows2_load(B_, X, r0 + 2 * NGW, 1, M, F.lane);
        modnorm16_store(F, A_, r0, M, nw, sh_off, sc_off, jbase, rps, jmul, H);
        if (r0 + 2 * NGW >= M) break;
        rows2_load(A_, X, r0 + 4 * NGW, 1, M, F.lane);
        modnorm16_store(F, B_, r0 + 2 * NGW, M, nw, sh_off, sc_off, jbase, rps, jmul, H);
    }
}
__device__ __forceinline__ void final16_store(Frame& F, const v4u (&B)[2][8], int r0, int M, float* Y, const float* nw) {
    float rstd[2]; rows2_rstd(B, rstd);
    if (r0 >= M) return;
    float* xr = Y + (size_t)r0 * DM + F.lane * 8;
#pragma unroll
    for (int c = 0; c < 8; ++c)
#pragma unroll
        for (int h = 0; h < 2; ++h) { const f32x4 w4 = *(const GAS f32x4*)(nw + F.lane * 8 + c * 512 + 4 * h);
#pragma unroll
            for (int q = 0; q < 2; ++q) { unsigned u0 = h ? B[q][c].z : B[q][c].x, u1 = h ? B[q][c].w : B[q][c].y; asm volatile("" : "+v"(u0), "+v"(u1));
                *(GAS f32x4*)(xr + (size_t)q * DM + c * 512 + 4 * h) = pg8::h4lo(u0, u1) * rstd[q] * w4; } }
}
__device__ __forceinline__ void final16_rows(Frame& F, float* Y, int M, const float* nw) {
    const int gw = F.vcu * NWAVES + F.wave, NGW = F.G * NWAVES; const h16s* X = (const h16s*)Y;
    if (2 * gw >= M) return;
    v4u A_[2][8], B_[2][8]; rows2_load(A_, X, 2 * gw, 1, M, F.lane);
    for (int r0 = 2 * gw; r0 < M; r0 += 4 * NGW) {
        rows2_load(B_, X, r0 + 2 * NGW, 1, M, F.lane);
        final16_store(F, A_, r0, M, Y, nw);
        if (r0 + 2 * NGW >= M) break;
        rows2_load(A_, X, r0 + 4 * NGW, 1, M, F.lane);
        final16_store(F, B_, r0 + 2 * NGW, M, Y, nw);
    }
}
namespace att {
constexpr float SCALE = 0.088388347648318440f, C = SCALE * 1.4426950408889634f;
constexpr int SHM_T = 16384;
constexpr int OFF_V = 0, OFF_K = 2 * SHM_T, OFF_WS = 4 * SHM_T, OFF_TAB = OFF_WS + 4096, OFF_ROW = OFF_TAB + 4096;
#define KSWZ(row, colB) ((row) * 256 + ((colB) ^ (((row) & 7) << 4)))
#define SBAR() __builtin_amdgcn_sched_barrier(0)
__device__ __forceinline__ int crow(int r, int hi) { return (r & 3) + 8 * (r >> 2) + 4 * hi; }
constexpr bool L0(int LV, int r) { return LV != 2 || r >= 12; }
constexpr bool L1(int LV, int r) { return LV != 1 || r < 4; }
template <int LV> __device__ __forceinline__ void partialSM(f32x16& p0, f32x16& p1, float& m_reg, float& mn, float& alpha) {
  float pmax = -3.0e38f;
#pragma unroll
  for (int r = 0; r < 16; ++r) if (L0(LV, r)) pmax = fmaxf(pmax, p0[r]);
#pragma unroll
  for (int r = 0; r < 16; ++r) if (L1(LV, r)) pmax = fmaxf(pmax, p1[r]);
  { auto rr = __builtin_amdgcn_permlane32_swap(__float_as_uint(pmax), __float_as_uint(pmax), false, false);
    pmax = fmaxf(__uint_as_float(rr[0]), __uint_as_float(rr[1])); }
  if (__all(pmax <= m_reg)) { mn = m_reg; alpha = 1.f; }
  else { mn = fmaxf(m_reg, pmax); alpha = __builtin_amdgcn_exp2f((m_reg - mn) * C); m_reg = mn; }
  const float mnC = -mn * C; typedef float f2_ __attribute__((ext_vector_type(2))); const f2_ C2 = {C, C}, M2 = {mnC, mnC};
#pragma unroll
  for (int r = 0; r < 16; r += 2) { if (L0(LV, r)) { const f2_ t = __builtin_elementwise_fma((f2_){p0[r], p0[r + 1]}, C2, M2); p0[r] = __builtin_amdgcn_exp2f(t.x); p0[r + 1] = __builtin_amdgcn_exp2f(t.y); } else { p0[r] = 0.f; p0[r + 1] = 0.f; } }
#pragma unroll
  for (int r = 0; r < 16; r += 2) { if (L1(LV, r)) { const f2_ t = __builtin_elementwise_fma((f2_){p1[r], p1[r + 1]}, C2, M2); p1[r] = __builtin_amdgcn_exp2f(t.x); p1[r + 1] = __builtin_amdgcn_exp2f(t.y); } else { p1[r] = 0.f; p1[r + 1] = 0.f; } }
}
template <int LV> __device__ __forceinline__ void finishSM(f32x16& p0, f32x16& p1, float alpha, float& l_reg, bf16x8& pa0, bf16x8& pa1, bf16x8& pa2, bf16x8& pa3) {
  typedef float f2_ __attribute__((ext_vector_type(2))); f2_ s2 = {0.f, 0.f};
#pragma unroll
  for (int r = 0; r < 16; r += 2) if (L0(LV, r)) s2 += (f2_){p0[r], p0[r + 1]};
#pragma unroll
  for (int r = 0; r < 16; r += 2) if (L1(LV, r)) s2 += (f2_){p1[r], p1[r + 1]};
  float ps = s2.x + s2.y;
  { auto rr = __builtin_amdgcn_permlane32_swap(__float_as_uint(ps), __float_as_uint(ps), false, false);
    ps = __uint_as_float(rr[0]) + __uint_as_float(rr[1]); }
  l_reg = l_reg * alpha + ps;
#define PK4(P, BASE, OUT) do { unsigned a0 = pkbf(P[BASE + 0], P[BASE + 1]), a1 = pkbf(P[BASE + 2], P[BASE + 3]);   \
    unsigned b0 = pkbf(P[BASE + 4], P[BASE + 5]), b1 = pkbf(P[BASE + 6], P[BASE + 7]);                              \
    auto r0 = __builtin_amdgcn_permlane32_swap(a0, b0, false, false); auto r1 = __builtin_amdgcn_permlane32_swap(a1, b1, false, false); \
    v4u w = {r0[0], r1[0], r0[1], r1[1]}; OUT = __builtin_bit_cast(bf16x8, w); } while (0)
  if (LV != 2) PK4(p0, 0, pa0); else pa0 = bf16x8{};
  PK4(p0, 8, pa1); PK4(p1, 0, pa2);
  if (LV != 1) PK4(p1, 8, pa3); else pa3 = bf16x8{};
#undef PK4
}
__device__ __forceinline__ void qkt(f32x16& p0, f32x16& p1, const LAS unsigned char* Ks, const bf16x8* qr, int r32, int hi) {
  p0 = f32x16{}; p1 = f32x16{};
#pragma unroll
  for (int d0 = 0; d0 < 8; ++d0) { const int cb = (d0 * 16 + hi * 8) * 2;
    const bf16x8 b0 = *(const LAS bf16x8*)(Ks + KSWZ(r32, cb));
    const bf16x8 b1 = *(const LAS bf16x8*)(Ks + KSWZ(32 + r32, cb));
    p0 = __builtin_amdgcn_mfma_f32_32x32x16_bf16(b0, qr[d0], p0, 0, 0, 0);
    p1 = __builtin_amdgcn_mfma_f32_32x32x16_bf16(b1, qr[d0], p1, 0, 0, 0); }
}
__device__ __forceinline__ int v_st(int k, int c) { const int kk = (k & ~0xC) | ((k & 4) << 1) | ((k & 8) >> 1); return ((kk >> 3) * 4 + (c >> 5)) * 512 + ((kk & 7) * 32 + (c & 31)) * 2; }
__device__ __forceinline__ int v_rd_base(int lane) { return ((lane & 3) << 3) | (((lane >> 2) & 3) << 6) | (((lane >> 4) & 1) << 5) | (((lane >> 5) & 1) << 8); }
constexpr int v_rd_off(int d0, int ks, int half) { return d0 * 512 + ks * 4096 + half * 2048; }
template <int OFF> __device__ __forceinline__ s16x4 tr_read(int vb) {
  s16x4 r; asm volatile("ds_read_b64_tr_b16 %0, %1 offset:%2" : "=&v"(r) : "v"(vb), "i"(OFF) : "memory"); return r;
}
template <int D0, int LV> __device__ __forceinline__ void pv_one(f32x16& od, int vb, bf16x8 pa0, bf16x8 pa1, bf16x8 pa2, bf16x8 pa3) {
  s16x4 l0 = {}, h0 = {}, l3 = {}, h3 = {};
  if (LV != 2) { l0 = tr_read<v_rd_off(D0, 0, 0)>(vb); h0 = tr_read<v_rd_off(D0, 0, 1)>(vb); }
  const s16x4 l1 = tr_read<v_rd_off(D0, 1, 0)>(vb), h1 = tr_read<v_rd_off(D0, 1, 1)>(vb), l2 = tr_read<v_rd_off(D0, 2, 0)>(vb), h2 = tr_read<v_rd_off(D0, 2, 1)>(vb);
  if (LV != 1) { l3 = tr_read<v_rd_off(D0, 3, 0)>(vb); h3 = tr_read<v_rd_off(D0, 3, 1)>(vb); }
  asm volatile("s_waitcnt lgkmcnt(0)" ::: "memory"); SBAR();
#define PK(L, H) (bf16x8){L[0], L[1], L[2], L[3], H[0], H[1], H[2], H[3]}
  if (LV != 2) od = __builtin_amdgcn_mfma_f32_32x32x16_bf16(pa0, PK(l0, h0), od, 0, 0, 0);
  od = __builtin_amdgcn_mfma_f32_32x32x16_bf16(pa1, PK(l1, h1), od, 0, 0, 0);
  od = __builtin_amdgcn_mfma_f32_32x32x16_bf16(pa2, PK(l2, h2), od, 0, 0, 0);
  if (LV != 1) od = __builtin_amdgcn_mfma_f32_32x32x16_bf16(pa3, PK(l3, h3), od, 0, 0, 0);
#undef PK
}
template <int LV> __device__ __forceinline__ void pv_d0(f32x16* o, int vb, bf16x8 pa0, bf16x8 pa1, bf16x8 pa2, bf16x8 pa3) {
  pv_one<0, LV>(o[0], vb, pa0, pa1, pa2, pa3); pv_one<1, LV>(o[1], vb, pa0, pa1, pa2, pa3); pv_one<2, LV>(o[2], vb, pa0, pa1, pa2, pa3); pv_one<3, LV>(o[3], vb, pa0, pa1, pa2, pa3);
}
template <int LV> __device__ __forceinline__ void attn_tile(const LAS unsigned char* Kt, int vb, const bf16x8* qr, f32x16* o, float& m_reg, float& l_reg, LAS float* al_l, int r32, int hi, const LAS unsigned char* rowb, const int (&off0)[16], const int (&off1)[16]) {
  f32x16 p0, p1; float mn, alpha; bf16x8 pa0, pa1, pa2, pa3;
  qkt(p0, p1, Kt, qr, r32, hi);
  if (LV != 0) {
#pragma unroll
    for (int r = 0; r < 16; ++r) { if (L0(LV, r)) p0[r] += *(const LAS float*)(rowb + off0[r]); if (L1(LV, r)) p1[r] += *(const LAS float*)(rowb + off1[r]); } }
  partialSM<LV>(p0, p1, m_reg, mn, alpha);
  if (__any(alpha < 1.f)) { if (hi == 0) al_l[r32] = alpha; asm volatile("s_waitcnt lgkmcnt(0)" ::: "memory");
#pragma unroll
    for (int d = 0; d < 4; ++d)
#pragma unroll
      for (int r = 0; r < 16; ++r) o[d][r] *= al_l[crow(r, hi)]; }
  finishSM<LV>(p0, p1, alpha, l_reg, pa0, pa1, pa2, pa3); SBAR();
  pv_d0<LV>(o, vb, pa0, pa1, pa2, pa3);
}
__device__ __forceinline__ void attn_unit(LAS unsigned char* lds, const bf16* Qb, bf16* Ob, const bf16* Kl, const bf16* Vl, int ntl, int rho0, int r0, const bf16* Kc, const bf16* Vc, const float* rpb) {
  int tid_ = threadIdx.x; asm volatile("" : "+v"(tid_));
  const int tid = tid_, wid = __builtin_amdgcn_readfirstlane(tid >> 6), lane = tid & 63, r32 = lane & 31, hi = lane >> 5;
  LAS unsigned char* V_lds = lds + OFF_V; LAS unsigned char* K_lds = lds + OFF_K;
  LAS float* wsf = (LAS float*)(lds + OFF_WS) + wid * 64; LAS float* li_l = wsf; LAS float* al_l = wsf + 32;
  LAS float* tab = (LAS float*)(lds + OFF_TAB);
  if (ntl > 0) { for (int i = tid; i < 15 * 31; i += NWAVES * 64) tab[i] = rpb[i] * (1.0f / SCALE); }
  float m_reg = -1e30f, l_reg = 0.f; f32x16 o[4] = {}; bf16x8 qr[8];
  { const bf16* Qw = Qb + (size_t)(wid * 32 + r32) * 2048 + hi * 8;
#pragma unroll
    for (int d0 = 0; d0 < 8; ++d0) qr[d0] = *(const GAS bf16x8*)(Qw + d0 * 16); }
  const int rq = r0 + (wid >> 1), cq = 32 * (wid & 1) + r32;
  const int rs = min(max(rq - 4, 0), 56), cs = min(max(cq - 8, 0), 48);
  LAS unsigned char* rowb = lds + OFF_ROW + wid * 128;
  int off0[16], off1[16];
#pragma unroll
  for (int r = 0; r < 16; ++r) { const int kap = (r & 3) + 8 * (r >> 2) + 4 * hi; off0[r] = ((unsigned)(kap - cs) < 16u) ? (kap - cq + 15) * 4 : 124; off1[r] = ((unsigned)(kap + 32 - cs) < 16u) ? (kap + 32 - cq + 15) * 4 : 124; }
  const int sr = tid >> 4, sc = (tid & 15) * 8, vst0 = v_st(sr, sc), vst1 = v_st(32 + sr, sc), kst0 = KSWZ(sr, sc * 2), kst1 = KSWZ(32 + sr, sc * 2);
  const int vb0 = (int)(unsigned)(uintptr_t)V_lds + v_rd_base(lane);
  const int NT = ntl + 4;
  bf16x8 sv0, sv1, sk0, sk1;
#define SLOAD(t) do { const bf16* kp = ((t) < ntl) ? Kl + (size_t)(t) * 64 * 2048 : Kc + (size_t)((t) - ntl) * 64 * 2048; const bf16* vp = ((t) < ntl) ? Vl + (size_t)(t) * 64 * 2048 : Vc + (size_t)((t) - ntl) * 64 * 2048; \
    sv0 = *(const GAS bf16x8*)(vp + (size_t)sr * 2048 + sc); sv1 = *(const GAS bf16x8*)(vp + (size_t)(32 + sr) * 2048 + sc); sk0 = *(const GAS bf16x8*)(kp + (size_t)sr * 2048 + sc); sk1 = *(const GAS bf16x8*)(kp + (size_t)(32 + sr) * 2048 + sc); } while (0)
#define SWRITE(b) do { *(LAS bf16x8*)(V_lds + (b) * SHM_T + vst0) = sv0; *(LAS bf16x8*)(V_lds + (b) * SHM_T + vst1) = sv1; *(LAS bf16x8*)(K_lds + (b) * SHM_T + kst0) = sk0; *(LAS bf16x8*)(K_lds + (b) * SHM_T + kst1) = sk1; } while (0)
  SLOAD(0); SWRITE(0); __syncthreads();
#define TILE_STEP(LV_, t) do { const int b = (t) & 1; if ((t) + 1 < NT) SLOAD((t) + 1); \
    const int rho = rho0 + (t); const bool need = (LV_ == 0) || (rho >= rs && rho < rs + 8); \
    if (need) { if (LV_ != 0) { if (lane < 32) ((LAS float*)rowb)[lane] = lane < 31 ? tab[(rho - rq + 7) * 31 + lane] : -1e30f; } attn_tile<LV_>(K_lds + b * SHM_T, vb0 + b * SHM_T, qr, o, m_reg, l_reg, al_l, r32, hi, rowb, off0, off1); } \
    if ((t) + 1 < NT) SWRITE(b ^ 1); __syncthreads(); } while (0)
  if (wid & 1) { for (int t = 0; t < ntl; ++t) TILE_STEP(2, t); }
  else { for (int t = 0; t < ntl; ++t) TILE_STEP(1, t); }
  for (int t = ntl; t < NT; ++t) TILE_STEP(0, t);
#undef TILE_STEP
#undef SLOAD
#undef SWRITE
  if (hi == 0) li_l[r32] = l_reg; asm volatile("s_waitcnt lgkmcnt(0)" ::: "memory");
  float rli[16];
#pragma unroll
  for (int r = 0; r < 16; ++r) rli[r] = __builtin_amdgcn_rcpf(li_l[crow(r, hi)]);
  bf16* Ow = Ob + (size_t)(wid * 32) * 2048;
#pragma unroll
  for (int r = 0; r < 16; ++r) { const int orow = crow(r, hi);
#pragma unroll
    for (int d0 = 0; d0 < 4; ++d0) { const unsigned w = pkbf(o[d0][r] * rli[r], 0.f); Ow[(size_t)orow * 2048 + d0 * 32 + r32] = (bf16)(w & 0xffffu); } }
}
#undef KSWZ
#undef SBAR
}
__device__ __forceinline__ float sum8(float v) { v += __shfl_xor(v, 1); v += __shfl_xor(v, 2); v += __shfl_xor(v, 4); return v; }
__device__ __forceinline__ void rwkv_prep(Frame& F, const Args& A, const h16s* PR, int prow0, int Ms, int L, h16s* RS, h16s* KS, h16s* VS, h16s* KK, bf16* LA) {
    const int gw = F.vcu * NWAVES + F.wave, NGW = F.G * NWAVES; const float* mu = A.in[I_MU]; const float* k_k = A.in[I_KK];
    for (int s0 = 2 * gw; s0 < Ms; s0 += 2 * NGW) {
        const int t = s0 % L; const bool hp = t > 0, hn = t + 2 < L;
        const h16s* pc = PR + (size_t)(prow0 + s0) * C_RWKV_P + F.lane * 8;
#pragma unroll 4
        for (int c = 0; c < 13; ++c) {
            const int col = c * 512 + F.lane * 8; const v4u z4 = {0u, 0u, 0u, 0u};
            const v4u w0 = hp ? *(const GAS v4u*)(pc + c * 512 - C_RWKV_P) : z4, w1 = *(const GAS v4u*)(pc + c * 512), w2 = *(const GAS v4u*)(pc + c * 512 + C_RWKV_P), w3 = hn ? *(const GAS v4u*)(pc + c * 512 + 2 * C_RWKV_P) : z4;
            float x0[8], x1[8], x2[8], x3[8], m[8]; unpack_h8(w0, x0); unpack_h8(w1, x1); unpack_h8(w2, x2); unpack_h8(w3, x3);
            if (col < C_RWKV) { const f32x4 m0 = *(const GAS f32x4*)(mu + col), m1 = *(const GAS f32x4*)(mu + col + 4); m[0] = m0.x; m[1] = m0.y; m[2] = m0.z; m[3] = m0.w; m[4] = m1.x; m[5] = m1.y; m[6] = m1.z; m[7] = m1.w; }
            else {
#pragma unroll
                for (int e = 0; e < 8; ++e) m[e] = 0.f; }
#pragma unroll
            for (int q = 0; q < 2; ++q) { const int s = s0 + q;
                float x[8];
#pragma unroll
                for (int e = 0; e < 8; ++e) { const float xc = q ? x2[e] : x1[e], xp = q ? x1[e] : x0[e], xn = q ? x3[e] : x2[e]; x[e] = xc + m[e] * (0.5f * (xp + xn) - xc); }
                if (c < 12) {
                    v4u o; o.x = pkh(x[0], x[1]); o.y = pkh(x[2], x[3]); o.z = pkh(x[4], x[5]); o.w = pkh(x[6], x[7]);
                    h16s* dst = (c < 4 ? RS : c < 8 ? KS : VS) + (size_t)s * D_RW + (c & 3) * 512 + F.lane * 8;
                    *(GAS v4u*)dst = o;
                    if (c >= 4 && c < 8) { const int kc = (c - 4) * 512 + F.lane * 8; const f32x4 q0 = *(const GAS f32x4*)(k_k + kc), q1 = *(const GAS f32x4*)(k_k + kc + 4);
                        float y[8] = {x[0] * q0.x, x[1] * q0.y, x[2] * q0.z, x[3] * q0.w, x[4] * q1.x, x[5] * q1.y, x[6] * q1.z, x[7] * q1.w}; float ss = 0.f;
    #pragma unroll
                        for (int e = 0; e < 8; ++e) ss += y[e] * y[e];
                        ss = sum8(ss); const float inv = 1.0f / fmaxf(sqrtf(ss), 1e-12f);
                        v4u ko; ko.x = pkh(y[0] * inv, y[1] * inv); ko.y = pkh(y[2] * inv, y[3] * inv); ko.z = pkh(y[4] * inv, y[5] * inv); ko.w = pkh(y[6] * inv, y[7] * inv);
                        *(GAS v4u*)(KK + (size_t)s * D_RW + kc) = ko; }
                } else {
                    float y[8];
    #pragma unroll
                    for (int e = 0; e < 8; ++e) { const int j = F.lane * 8 + e; const float v = x[e];
                        const float th = 1.0f - 2.0f * __builtin_amdgcn_rcpf(1.0f + __builtin_amdgcn_exp2f(2.8853900817779268f * v));
                        y[e] = j < 96 ? th : j < 192 ? v : j < 448 ? sigm(v) : 0.f; }
                    v4u o; o.x = pkbf(y[0], y[1]); o.y = pkbf(y[2], y[3]); o.z = pkbf(y[4], y[5]); o.w = pkbf(y[6], y[7]);
                    if (F.lane < 24) *(GAS v4u*)(LA + (size_t)s * 256 + F.lane * 8) = o;
                    else if (F.lane < 56) *(GAS v4u*)(LA + (size_t)Ms * 256 + (size_t)s * 256 + (F.lane - 24) * 8) = o;
                    else *(GAS v4u*)(LA + (size_t)s * 256 + 192 + (F.lane - 56) * 8) = (v4u){0u, 0u, 0u, 0u};
                }
            }
        }
    }
}
typedef float f32x2 __attribute__((ext_vector_type(2)));
__device__ __forceinline__ float dpp_xor1(float x) { return __builtin_bit_cast(float, __builtin_amdgcn_update_dpp(0, __builtin_bit_cast(int, x), 0xB1, 0xf, 0xf, true)); }
__device__ __forceinline__ float dpp_xor2(float x) { return __builtin_bit_cast(float, __builtin_amdgcn_update_dpp(0, __builtin_bit_cast(int, x), 0x4E, 0xf, 0xf, true)); }
__device__ __forceinline__ float dpp_hmir(float x) { return __builtin_bit_cast(float, __builtin_amdgcn_update_dpp(0, __builtin_bit_cast(int, x), 0x141, 0xf, 0xf, true)); }
__device__ __forceinline__ float red8(float x) { x += dpp_xor1(x); x += dpp_xor2(x); x += dpp_hmir(x); return x; }
__device__ __forceinline__ float dpp_shr1(float x) { return __builtin_bit_cast(float, __builtin_amdgcn_update_dpp(__builtin_bit_cast(int, x), __builtin_bit_cast(int, x), 0x111, 0xf, 0xf, false)); }
__device__ __forceinline__ float dpp_shr2(float x) { return __builtin_bit_cast(float, __builtin_amdgcn_update_dpp(__builtin_bit_cast(int, x), __builtin_bit_cast(int, x), 0x112, 0xf, 0xf, false)); }
__device__ __forceinline__ float dpp_shr4(float x) { return __builtin_bit_cast(float, __builtin_amdgcn_update_dpp(__builtin_bit_cast(int, x), __builtin_bit_cast(int, x), 0x114, 0xf, 0xf, false)); }
constexpr int SC_U = 8, SC_STEP = 5 * 64, SC_OPS_F = SC_U * SC_STEP, SC_GAM_F = 64, SC_Y_F = SC_U * 512, SC_SLOT_F = 2 * SC_OPS_F + 2 * SC_GAM_F + 2 * SC_Y_F;
static_assert(2 * SC_SLOT_F * 4 <= RING_BYTES, "scan LDS");
struct ScanOps { f32x4 kk[2], bb[2], kd[2], r[2]; f32x2 v; };
__device__ __forceinline__ void scan_ld(ScanOps& o, const LAS float* ob, int kq, int v0) {
#pragma unroll
    for (int j = 0; j < 2; ++j) { o.kk[j] = *(const LAS f32x4*)(ob + 0 * 64 + kq * 8 + 4 * j); o.bb[j] = *(const LAS f32x4*)(ob + 1 * 64 + kq * 8 + 4 * j);
        o.kd[j] = *(const LAS f32x4*)(ob + 2 * 64 + kq * 8 + 4 * j); o.r[j] = *(const LAS f32x4*)(ob + 3 * 64 + kq * 8 + 4 * j); }
    o.v = *(const LAS f32x2*)(ob + 4 * 64 + v0);
}
__device__ __forceinline__ f32x2 lo2(f32x4 a) { return (f32x2){a.x, a.y}; }
__device__ __forceinline__ f32x2 hi2(f32x4 a) { return (f32x2){a.z, a.w}; }
__device__ __forceinline__ f32x2 h2x2(unsigned u) { typedef _Float16 hh2 __attribute__((ext_vector_type(2))); const hh2 h = __builtin_bit_cast(hh2, u); return (f32x2){(float)h.x, (float)h.y}; }
__device__ __forceinline__ f32x2 fma2(f32x2 a, f32x2 b, f32x2 c) { return __builtin_elementwise_fma(a, b, c); }
__device__ __forceinline__ f32x2 dot8(const f32x2 (&S)[4], const f32x4 (&x)[2]) { f32x2 p = S[0] * lo2(x[0]); p = fma2(S[1], hi2(x[0]), p); p = fma2(S[2], lo2(x[1]), p); p = fma2(S[3], hi2(x[1]), p); return p; }
__device__ __forceinline__ void rwkv_scan(Frame& F, const Args& A, int nseq, int L, int seq0_global, bool has_state, const h16s* RS, const h16s* KS, const h16s* VS, const h16s* KK,
                                          const h16s* DF, const h16s* DB, const h16s* AF, const h16s* AB, h16s* YF, h16s* YB, float* out_sf, float* out_sb) {
    const int nchains = nseq * NH_R * 2, nslots = nchains >= 2 * F.G ? 2 : 1; const int lane = F.lane, cs = F.wave >> 2, wq = F.wave & 3, kq = lane & 7, v0 = 16 * wq + 2 * (lane >> 3);
    const int ft = F.tid & 255, su = ft & 7, kp = ft >> 3;
    LAS float* const sl = (LAS float*)(F.lds + RING_OFF) + cs * SC_SLOT_F;
    const float* k_a = A.in[I_KA]; const int NC = L / SC_U;
    for (int it = 0; (it * F.G + F.vcu) * nslots < nchains; ++it) {
        const int chain = (it * F.G + F.vcu) * nslots + cs; const bool active = cs < nslots && chain < nchains;
        const int dir = chain & 1, head = (chain >> 1) & 31, seq = chain >> 6;
        const h16s* Dd = dir ? DB : DF; const h16s* Ad = dir ? AB : AF; h16s* Yd = dir ? YB : YF;
        const int colp = head * 64 + 2 * kp;
        f32x2 ka2 = (f32x2){0.f, 0.f}; if (active) ka2 = *(const GAS f32x2*)(k_a + colp); const f32x2 oka2 = (f32x2){1.0f - ka2.x, 1.0f - ka2.y};
        f32x2 Sa[4], Sb[4];
#pragma unroll
        for (int j = 0; j < 4; ++j) { Sa[j] = (f32x2){0.f, 0.f}; Sb[j] = (f32x2){0.f, 0.f}; }
        const size_t soff = (((size_t)(seq0_global + seq) * NH_R + head) * 64 + v0) * 64 + 8 * kq;
        if (active && has_state) { const float* sp = (dir ? A.in[I_SB] : A.in[I_SF]) + soff; const f32x4 a = *(const GAS f32x4*)sp, b = *(const GAS f32x4*)(sp + 4), c = *(const GAS f32x4*)(sp + 64), d = *(const GAS f32x4*)(sp + 68);
            Sa[0] = lo2(a); Sa[1] = hi2(a); Sa[2] = lo2(b); Sa[3] = hi2(b); Sb[0] = lo2(c); Sb[1] = hi2(c); Sb[2] = lo2(d); Sb[3] = hi2(d); }
        const int row0 = seq * L; const int tstart = dir ? L - 1 : 0, tstep = dir ? -1 : 1;
        struct Raw { unsigned r, k, kk, w, a, v; };
        Raw gA = {0, 0, 0, 0, 0, 0}, gB = {0, 0, 0, 0, 0, 0};
#define SC_GLOAD(g, c) do { const size_t ro = (size_t)(row0 + tstart + ((c) * SC_U + su) * tstep) * D_RW + colp; g.r = *(const GAS unsigned*)(RS + ro); g.k = *(const GAS unsigned*)(KS + ro); g.kk = *(const GAS unsigned*)(KK + ro); \
            g.w = *(const GAS unsigned*)(Dd + ro); g.a = *(const GAS unsigned*)(Ad + ro); g.v = *(const GAS unsigned*)(VS + ro); } while (0)
        f32x2 f_r, f_kk, f_v, f_kd, f_bb, f_gi, f_t, f_inv;
#define SC_F0(g) do { const f32x2 k2 = h2x2(g.k), a2 = h2x2(g.a); f_r = h2x2(g.r); f_kk = h2x2(g.kk); f_v = h2x2(g.v); f_gi = h2x2(g.w); f_kd = k2 * (a2 * ka2 + oka2); f_bb = f_kk * a2; \
            f_t.x = dpp_shr1(f_gi.x); f_t.y = dpp_shr1(f_gi.y); } while (0)
#define SC_F1() do { if (su >= 1) f_gi *= f_t; f_t.x = dpp_shr2(f_gi.x); f_t.y = dpp_shr2(f_gi.y); } while (0)
#define SC_F2() do { if (su >= 2) f_gi *= f_t; f_t.x = dpp_shr4(f_gi.x); f_t.y = dpp_shr4(f_gi.y); } while (0)
#define SC_F3() do { if (su >= 4) f_gi *= f_t; f_t.x = dpp_shr1(f_gi.x); f_t.y = dpp_shr1(f_gi.y); f_inv = (f32x2){__builtin_amdgcn_rcpf(f_gi.x), __builtin_amdgcn_rcpf(f_gi.y)}; } while (0)
#define SC_F4(b) do { const f32x2 ge = su >= 1 ? f_t : (f32x2){1.0f, 1.0f}; \
            LAS float* ob = sl + (b) * SC_OPS_F + su * SC_STEP + 2 * kp; *(LAS f32x2*)(ob) = ge * f_kk; *(LAS f32x2*)(ob + 64) = f_bb * f_inv; *(LAS f32x2*)(ob + 128) = f_kd * f_inv; *(LAS f32x2*)(ob + 192) = f_gi * f_r; *(LAS f32x2*)(ob + 256) = f_v; \
            if (su == SC_U - 1) *(LAS f32x2*)(sl + 2 * SC_OPS_F + (b) * SC_GAM_F + 2 * kp) = f_gi; } while (0)
#define SC_YSTORE(bb_, c_) do { const LAS f32x4* yp = (const LAS f32x4*)(sl + 2 * SC_OPS_F + 2 * SC_GAM_F + (bb_) * SC_Y_F + (su * 64 + 2 * kp) * 8); const f32x4 a0 = yp[0], a1 = yp[1], b0 = yp[2], b1 = yp[3]; \
            const float y0 = ((a0.x + a0.z) + (a1.x + a1.z)) + ((b0.x + b0.z) + (b1.x + b1.z)), y1 = ((a0.y + a0.w) + (a1.y + a1.w)) + ((b0.y + b0.w) + (b1.y + b1.w)); \
            *(GAS unsigned*)(Yd + (size_t)(row0 + tstart + ((c_) * SC_U + su) * tstep) * D_RW + colp) = pkh(y0, y1); } while (0)
        __syncthreads();
        if (active) { SC_GLOAD(gA, 0); SC_F0(gA); SC_F1(); SC_F2(); SC_F3(); SC_F4(0); if (NC > 1) SC_GLOAD(gA, 1); }
        __syncthreads();
        for (int c = 0; c < NC; ++c) {
            const int b = c & 1;
            LAS float* yst = sl + 2 * SC_OPS_F + 2 * SC_GAM_F + b * SC_Y_F;
            if (active) {
                const bool fill = c + 1 < NC;
                if (c + 2 < NC) SC_GLOAD(gB, c + 2);
                const LAS float* ops = sl + b * SC_OPS_F;
                ScanOps cur, nxt; scan_ld(cur, ops, kq, v0);
                f32x2 pa = dot8(Sa, cur.kk), pb = dot8(Sb, cur.kk);
#define SC_STEP_(s) do { \
                    if ((s) + 1 < SC_U) scan_ld(nxt, ops + ((s) + 1) * SC_STEP, kq, v0); \
                    const f32x2 vA = (f32x2){cur.v.x, cur.v.x}, vB = (f32x2){cur.v.y, cur.v.y}; \
                    float ra = pa.x + pa.y, rb = pb.x + pb.y; \
                    ra += dpp_xor1(ra); rb += dpp_xor1(rb); \
                    Sa[0] = fma2(vA, lo2(cur.kd[0]), Sa[0]); Sb[0] = fma2(vB, lo2(cur.kd[0]), Sb[0]); Sa[1] = fma2(vA, hi2(cur.kd[0]), Sa[1]); Sb[1] = fma2(vB, hi2(cur.kd[0]), Sb[1]); \
                    ra += dpp_xor2(ra); rb += dpp_xor2(rb); \
                    Sa[2] = fma2(vA, lo2(cur.kd[1]), Sa[2]); Sb[2] = fma2(vB, lo2(cur.kd[1]), Sb[2]); Sa[3] = fma2(vA, hi2(cur.kd[1]), Sa[3]); Sb[3] = fma2(vB, hi2(cur.kd[1]), Sb[3]); \
                    ra += dpp_hmir(ra); rb += dpp_hmir(rb); \
                    const f32x2 sA = (f32x2){-ra, -ra}, sB = (f32x2){-rb, -rb}; \
                    Sa[0] = fma2(sA, lo2(cur.bb[0]), Sa[0]); Sb[0] = fma2(sB, lo2(cur.bb[0]), Sb[0]); Sa[1] = fma2(sA, hi2(cur.bb[0]), Sa[1]); Sb[1] = fma2(sB, hi2(cur.bb[0]), Sb[1]); \
                    Sa[2] = fma2(sA, lo2(cur.bb[1]), Sa[2]); Sb[2] = fma2(sB, lo2(cur.bb[1]), Sb[2]); Sa[3] = fma2(sA, hi2(cur.bb[1]), Sa[3]); Sb[3] = fma2(sB, hi2(cur.bb[1]), Sb[3]); \
                    f32x2 ya = Sa[0] * lo2(cur.r[0]), yb = Sb[0] * lo2(cur.r[0]); \
                    if ((s) + 1 < SC_U) { pa = Sa[0] * lo2(nxt.kk[0]); pb = Sb[0] * lo2(nxt.kk[0]); } \
                    ya = fma2(Sa[1], hi2(cur.r[0]), ya); yb = fma2(Sb[1], hi2(cur.r[0]), yb); \
                    if ((s) + 1 < SC_U) { pa = fma2(Sa[1], hi2(nxt.kk[0]), pa); pb = fma2(Sb[1], hi2(nxt.kk[0]), pb); } \
                    ya = fma2(Sa[2], lo2(cur.r[1]), ya); yb = fma2(Sb[2], lo2(cur.r[1]), yb); \
                    if ((s) + 1 < SC_U) { pa = fma2(Sa[2], lo2(nxt.kk[1]), pa); pb = fma2(Sb[2], lo2(nxt.kk[1]), pb); } \
                    ya = fma2(Sa[3], hi2(cur.r[1]), ya); yb = fma2(Sb[3], hi2(cur.r[1]), yb); \
                    if ((s) + 1 < SC_U) { pa = fma2(Sa[3], hi2(nxt.kk[1]), pa); pb = fma2(Sb[3], hi2(nxt.kk[1]), pb); } \
                    *(LAS f32x2*)(yst + ((s) * 64 + v0) * 8 + 2 * kq) = (f32x2){ya.x + ya.y, yb.x + yb.y}; \
                    if ((s) + 1 < SC_U) cur = nxt; } while (0)
                SC_STEP_(0); SC_STEP_(1);
                if (c > 0) SC_YSTORE(b ^ 1, c - 1);
                if (fill) SC_F0(gA);
                SC_STEP_(2);
                if (fill) SC_F1();
                SC_STEP_(3);
                if (fill) SC_F2();
                SC_STEP_(4);
                if (fill) SC_F3();
                SC_STEP_(5);
                if (fill) SC_F4(b ^ 1);
                SC_STEP_(6); SC_STEP_(7);
#undef SC_STEP_
                { const LAS float* gp = sl + 2 * SC_OPS_F + b * SC_GAM_F + kq * 8; const f32x4 g0 = *(const LAS f32x4*)gp, g1 = *(const LAS f32x4*)(gp + 4);
                  Sa[0] *= lo2(g0); Sa[1] *= hi2(g0); Sa[2] *= lo2(g1); Sa[3] *= hi2(g1); Sb[0] *= lo2(g0); Sb[1] *= hi2(g0); Sb[2] *= lo2(g1); Sb[3] *= hi2(g1); }
                gA = gB;
            }
            __syncthreads();
        }
        if (active) SC_YSTORE((NC - 1) & 1, NC - 1);
#undef SC_GLOAD
#undef SC_F0
#undef SC_F1
#undef SC_F2
#undef SC_F3
#undef SC_F4
#undef SC_YSTORE
        if (active && out_sf) { float* dp = (dir ? out_sb : out_sf) + soff; *(GAS f32x4*)dp = (f32x4){Sa[0].x, Sa[0].y, Sa[1].x, Sa[1].y}; *(GAS f32x4*)(dp + 4) = (f32x4){Sa[2].x, Sa[2].y, Sa[3].x, Sa[3].y};
            *(GAS f32x4*)(dp + 64) = (f32x4){Sb[0].x, Sb[0].y, Sb[1].x, Sb[1].y}; *(GAS f32x4*)(dp + 68) = (f32x4){Sb[2].x, Sb[2].y, Sb[3].x, Sb[3].y}; }
    }
}
__device__ __forceinline__ void rwkv_post(Frame& F, const Args& A, int Ms, const h16s* RS, const h16s* KS, const h16s* VS, const h16s* AF, const h16s* AB, const h16s* LG, const h16s* YF, const h16s* YB, bf16* ORW  ) {
    const int gw = F.vcu * NWAVES + F.wave, NGW = F.G * NWAVES; const float *lnw = A.in[I_LNW], *lnb = A.in[I_LNB], *k_a = A.in[I_KA], *r_k = A.in[I_RK];
    for (int s = gw; s < Ms; s += NGW) {
#pragma unroll
        for (int c = 0; c < 4; ++c) { const int col = c * 512 + F.lane * 8; const size_t off = (size_t)s * D_RW + col;
            float yf[8], yb[8], r[8], k[8], v[8], af[8], ab[8], g[8], w[8], b[8], ka[8], rk[8];
            unpack_h8(*(const GAS v4u*)(YF + off), yf); unpack_h8(*(const GAS v4u*)(YB + off), yb); unpack_h8(*(const GAS v4u*)(RS + off), r); unpack_h8(*(const GAS v4u*)(KS + off), k);
            unpack_h8(*(const GAS v4u*)(VS + off), v); unpack_h8(*(const GAS v4u*)(AF + off), af); unpack_h8(*(const GAS v4u*)(AB + off), ab); unpack_h8(*(const GAS v4u*)(LG + off), g);
#pragma unroll
            for (int h = 0; h < 2; ++h) { const f32x4 a = *(const GAS f32x4*)(lnw + col + 4 * h), bb = *(const GAS f32x4*)(lnb + col + 4 * h), cc = *(const GAS f32x4*)(k_a + col + 4 * h), dd = *(const GAS f32x4*)(r_k + col + 4 * h);
                w[4 * h] = a.x; w[4 * h + 1] = a.y; w[4 * h + 2] = a.z; w[4 * h + 3] = a.w; b[4 * h] = bb.x; b[4 * h + 1] = bb.y; b[4 * h + 2] = bb.z; b[4 * h + 3] = bb.w;
                ka[4 * h] = cc.x; ka[4 * h + 1] = cc.y; ka[4 * h + 2] = cc.z; ka[4 * h + 3] = cc.w; rk[4 * h] = dd.x; rk[4 * h + 1] = dd.y; rk[4 * h + 2] = dd.z; rk[4 * h + 3] = dd.w; }
            float sf = 0.f, sb = 0.f, bf_ = 0.f, bb_ = 0.f;
#pragma unroll
            for (int e = 0; e < 8; ++e) { sf += yf[e]; sb += yb[e]; const float t = r[e] * k[e] * rk[e]; bf_ += t * (1.0f + (af[e] - 1.0f) * ka[e]); bb_ += t * (1.0f + (ab[e] - 1.0f) * ka[e]); }
            sf = sum8(sf) * (1.0f / 64.0f); sb = sum8(sb) * (1.0f / 64.0f); bf_ = sum8(bf_); bb_ = sum8(bb_);
            float qf = 0.f, qb = 0.f;
#pragma unroll
            for (int e = 0; e < 8; ++e) { yf[e] -= sf; yb[e] -= sb; qf += yf[e] * yf[e]; qb += yb[e] * yb[e]; }
            const float rf = 1.0f / sqrtf(sum8(qf) * (1.0f / 64.0f) + LNX_EPS), rb = 1.0f / sqrtf(sum8(qb) * (1.0f / 64.0f) + LNX_EPS);
            float o[8];
#pragma unroll
            for (int e = 0; e < 8; ++e) o[e] = ((yf[e] * rf + yb[e] * rb) * w[e] + 2.0f * b[e] + (bf_ + bb_) * v[e]) * g[e];
            v4u ow; ow.x = pkbf(o[0], o[1]); ow.y = pkbf(o[2], o[3]); ow.z = pkbf(o[4], o[5]); ow.w = pkbf(o[6], o[7]);
            *(GAS v4u*)(ORW + off) = ow; }
    }
}
__global__ void __launch_bounds__(NWAVES * 64, 2) fwd_kernel(Args args) {
    const Args& A = args;
    extern __shared__ __attribute__((aligned(16))) unsigned char lds[];
    Frame F;
    F.lds = (LAS unsigned char*)lds;
    F.MISC = (volatile LAS unsigned*)(F.lds + MISC_OFF);
    F.tid = threadIdx.x; F.lane = F.tid & 63; F.wave = __builtin_amdgcn_readfirstlane(F.tid >> 6);
    F.G = gridDim.x; { const int bx = blockIdx.x; F.vcu = (F.G % 8 == 0) ? (bx % 8) * (F.G / 8) + bx / 8 : bx; }
    F.ws = args.ws; F.out = args.out; F.ctl = (gu32*)(args.ws + WS_CTL);
    for (int u = F.tid; u < (LDS_BYTES - LDSCTL_OFF) / 4; u += NWAVES * 64) ((LAS unsigned*)(F.lds + LDSCTL_OFF))[u] = 0u;
    __syncthreads();
    XcdBarrier bar = xcd_barrier_post((unsigned*)(F.ctl + CW_BAR), F.MISC + 8);
#define GRID_BAR() xcd_barrier(bar)
    unsigned char* ws = args.ws;
    bf16* const H = (bf16*)(ws + WS_H); bf16* const Qb = (bf16*)(ws + WS_Q); bf16* const Kb = (bf16*)(ws + WS_K); bf16* const Vb = (bf16*)(ws + WS_V);
    h16s* const PR = (h16s*)(ws + WS_PR); bf16* const ORW = (bf16*)(ws + WS_ORW); bf16* const MID = (bf16*)(ws + WS_MID); bf16* const U = (bf16*)(ws + WS_U);
    const float* const MOD = (const float*)(ws + WS_MOD);

#ifndef PHMASK
#define PHMASK 0xffffffffu
#endif
#define PH(n) RELANE(); if constexpr ((PHMASK >> (n)) & 1u)
#define RELANE() do { int t_ = threadIdx.x; asm volatile("" : "+v"(t_)); F.tid = t_; F.lane = t_ & 63; } while (0)
    PH(0) p0_prologue(F, A); GRID_BAR();
    PH(1) p0b_mod_finalize(F, A); GRID_BAR();

    const bool flip = ((int)blockIdx.x & 1) != 0;
    int two = 2; asm volatile("" : "+s"(two));
    bf16* const HLAT = (bf16*)(ws + WS_HLAT);
    PH(2) modnorm_rows<false>(F, A.in[I_XP], T_CTX, A.in[I_N1], 0, DM, 0, L_CTX, 0, H); GRID_BAR();
    for (int g = 0; g < 2; ++g) {
        const int M = g ? T_LAT : T_CTX, L = g ? L_LAT : L_CTX, jbase = g, jmul = g, ppb = L / 256;
        const float* X = g ? A.in[I_XS] : A.in[I_XP]; float* Y = F.out + O_Y + (g ? (size_t)T_CTX * DM : 0); bf16* PG = (bf16*)Y;
        for (int ph = 0; ph < two; ++ph) {
          if ((ph == 0) != flip) {
            PH(3) { pg8::Gemm gm{g ? HLAT : H, (const bf16*)(ws + WS_WIN), M, N_IN_P, DM}; pg8::StaticOrder S; S.init(M, N_IN_P, F.G, (int)blockIdx.x);
              pg8::EpiProj E{Qb, Kb, Vb, PR, PG, g ? nullptr : F.out + O_NK, g ? nullptr : F.out + O_NV};
              pg8::gemm_phase<pg8::EpiProj, pg8::StaticOrder, true, true>(F.lds + RING_OFF, gm, S, E); }
            if (g == 0) { __syncthreads(); PH(16) { const int nextra = ((T_CTX / 256) * (N_IN_P / 256)) % F.G, bx = (int)blockIdx.x;
                  if (nextra == 0) late_weight_copies(F, A, bx, F.G); else if (bx >= nextra) late_weight_copies(F, A, bx - nextra, F.G - nextra); } }
          } else if (g == 1) { PH(15) final16_rows(F, F.out + O_Y, T_CTX, A.in[I_NF]); }
        }
        GRID_BAR();
        bf16* const Ob = Qb;
        const int nseq = g ? B_LAT : B_CTX;
        h16s *RS = (h16s*)(ws + WS_RS), *KS = (h16s*)(ws + WS_KS), *VS = (h16s*)(ws + WS_VS), *KKb = (h16s*)(ws + WS_KK), *DF = (h16s*)(ws + WS_DF), *DB = (h16s*)(ws + WS_DB), *AF = (h16s*)(ws + WS_AF), *AB = (h16s*)(ws + WS_AB);
        h16s *LG = (h16s*)(ws + WS_LG), *YF = (h16s*)(ws + WS_YF), *YB = (h16s*)(ws + (g ? WS_YB_LAT : WS_YB_CTX)); bf16* LA = (bf16*)(ws + WS_LA);
        const bool flipA = (((int)blockIdx.x >> 3) & 1) != 0;
        for (int ph = 0; ph < two; ++ph) {
          if ((ph == 0) != flipA) {
            PH(4) { if (g == 0) { for (int u = F.vcu; u < B_CTX * NH_A; u += F.G) { const int b = u >> 4, h = u & 15; const size_t base = (size_t)b * L_CTX * 2048 + h * 128;
                    att::attn_unit(F.lds + RING_OFF, Qb + base, Ob + base, Kb, Vb, 0, 0, 0, Kb + base, Vb + base, nullptr); } }
            else { const bf16* CK = (const bf16*)(ws + WS_CK); const bf16* CV = (const bf16*)(ws + WS_CV);
                for (int u = F.vcu; u < B_LAT * NH_A * 16; u += F.G) { const int rg = u & 15, h = (u >> 4) & 15, b = u >> 8; const int r0 = 4 * rg, rho0 = min(max(r0 - 4, 0), 56), rho1 = min(max(r0 - 1, 0), 56) + 8;
                    const size_t qbase = ((size_t)b * L_LAT + (size_t)rg * 256) * 2048 + h * 128, lbase = ((size_t)b * L_LAT + (size_t)rho0 * 64) * 2048 + h * 128, cbase = (size_t)b * 256 * 2048 + h * 128;
                    att::attn_unit(F.lds + RING_OFF, Qb + qbase, Ob + qbase, Kb + lbase, Vb + lbase, rho1 - rho0, rho0, r0, CK + cbase, CV + cbase, A.in[I_RPB] + h * 15 * 31); } } }
          } else { PH(5) rwkv_prep(F, A, PR, 0, M, L, RS, KS, VS, KKb, LA); }
        }
        GRID_BAR();
        {   int klora = 256; asm volatile("" : "+s"(klora));
            PH(6) { pg8::Gemm gm{LA, (const bf16*)(ws + WS_WLORA), M, 8192, klora}; pg8::StaticOrder S; S.init(M, 8192, F.G, (int)blockIdx.x);
              pg8::EpiLora E{{DF, DB, AF, AB, LG}, A.in[I_W0], A.in[I_A0], 0};
              pg8::gemm_phase<pg8::EpiLora, pg8::StaticOrder, true, true>(F.lds + RING_OFF, gm, S, E); }
            PH(6) { pg8::Gemm gm{LA + (size_t)M * 256, (const bf16*)(ws + WS_WLORA) + (size_t)8192 * 256, M, 2048, klora}; pg8::StaticOrder S; S.init(M, 2048, F.G, (int)blockIdx.x);
              pg8::EpiLora E{{DF, DB, AF, AB, LG}, A.in[I_W0], A.in[I_A0], 4};
              pg8::gemm_phase<pg8::EpiLora, pg8::StaticOrder, true, true>(F.lds + RING_OFF, gm, S, E); }
            GRID_BAR();
            PH(7) rwkv_scan(F, A, nseq, L, 0, g != 0, RS, KS, VS, KKb, DF, DB, AF, AB, YF, YB, g ? nullptr : F.out + O_SF, g ? nullptr : F.out + O_SB);
            GRID_BAR();
        }
        for (int ph = 0; ph < two; ++ph) {
          if ((ph == 0) != flip) {
            PH(9) { pg8::Gemm gm{Qb, (const bf16*)(ws + WS_WOA), M, DM, D_ATT}; pg8::StaticOrder S; S.init(M, DM, F.G, (int)blockIdx.x);
              pg8::EpiGate<false> E{MID, PG, 0};
              pg8::gemm_phase<pg8::EpiGate<false>, pg8::StaticOrder, true, true>(F.lds + RING_OFF, gm, S, E); }
          } else { PH(8) rwkv_post(F, A, M, RS, KS, VS, AF, AB, LG, YF, YB, ORW); }
        }
        GRID_BAR();
        PH(10) { pg8::Gemm gm{ORW, (const bf16*)(ws + WS_WOR), M, DM, D_RW}; pg8::StaticOrder S; S.init(M, DM, F.G, (int)blockIdx.x);
          pg8::EpiGate<true> E{MID, PG, DM};
          pg8::gemm_phase<pg8::EpiGate<true>, pg8::StaticOrder, true, true>(F.lds + RING_OFF, gm, S, E); }
        GRID_BAR();
        PH(11) { pg8::Gemm gm{MID, (const bf16*)(ws + WS_WOUT), M, DM, DM}; pg8::StaticOrder S; S.init(M, DM, F.G, (int)blockIdx.x);
          pg8::EpiResid<true> E{X, (bf16*)Y, MOD + 2 * DM, jbase, ppb, jmul};
          pg8::gemm_phase<pg8::EpiResid<true>, pg8::StaticOrder, true, true>(F.lds + RING_OFF, gm, S, E); }
        GRID_BAR();
        PH(12) modnorm16_rows(F, (const h16s*)Y, M, A.in[I_N2], 3 * DM, 4 * DM, jbase, L, jmul, H); GRID_BAR();
        PH(13) { pg8::Gemm gm{H, (const bf16*)(ws + WS_WM1), M, D_FF, DM}; pg8::StaticOrder S; S.init(M, D_FF, F.G, (int)blockIdx.x);
          pg8::EpiRelu2 E{U};
          pg8::gemm_phase<pg8::EpiRelu2, pg8::StaticOrder, true, true>(F.lds + RING_OFF, gm, S, E); }
        GRID_BAR();
        for (int ph = 0; ph < two; ++ph) {
          if ((ph == 0) != flip) {
            PH(14) { pg8::Gemm gm{U, (const bf16*)(ws + WS_WM2), M, DM, D_FF}; pg8::StaticOrder S; S.init(M, DM, F.G, (int)blockIdx.x);
              pg8::EpiResid<false> E{nullptr, (bf16*)Y, MOD + 5 * DM, jbase, ppb, jmul};
              pg8::gemm_phase<pg8::EpiResid<false>, pg8::StaticOrder, true, true>(F.lds + RING_OFF, gm, S, E); }
          } else if (g == 0) { PH(2) modnorm_rows<false>(F, A.in[I_XS], T_LAT, A.in[I_N1], 0, DM, 1, L_LAT, 1, HLAT); }
        }
        GRID_BAR();
        if (g == 1) { PH(15) final16_rows(F, Y, M, A.in[I_NF]); }
    }
#undef GRID_BAR
}

extern "C" void kernel_launch(void* const* d_in, const int* in_sizes, int n_in, void* d_out, int out_size, void* d_ws, size_t ws_size, hipStream_t stream) {
    static int grid = 0;
    if (grid == 0) {
        if (n_in != 31 || ws_size < WS_END) { fprintf(stderr, "kernel_launch: need 31 inputs and >= %zu bytes of workspace; got %d, %zu\n", (size_t)WS_END, n_in, ws_size); grid = -1; return; }
        int dev = 0, cus = 0, per_cu = 0;
        if (hipGetDevice(&dev) != hipSuccess || hipDeviceGetAttribute(&cus, hipDeviceAttributeMultiprocessorCount, dev) != hipSuccess) { grid = -1; return; }
        if (hipFuncSetAttribute((const void*)fwd_kernel, hipFuncAttributeMaxDynamicSharedMemorySize, LDS_BYTES) != hipSuccess) { fprintf(stderr, "kernel_launch: hipFuncSetAttribute failed\n"); grid = -1; return; }
        if (hipOccupancyMaxActiveBlocksPerMultiprocessor(&per_cu, (const void*)fwd_kernel, NWAVES * 64, LDS_BYTES) != hipSuccess || per_cu < 1) fprintf(stderr, "kernel_launch: occupancy query reports %d\n", per_cu);
        (void)hipGetLastError();
        grid = cus;
    }
    if (grid < 0) return;
    if (hipMemsetAsync((char*)d_ws + WS_CTL, 0, CTL_ZERO_BYTES, stream) != hipSuccess) return;
    Args a{};
    for (int i = 0; i < 31; ++i) a.in[i] = (const float*)d_in[i];
    a.out = (float*)d_out; a.ws = (unsigned char*)d_ws;
    hipLaunchKernelGGL(fwd_kernel, dim3(grid), dim3(NWAVES * 64), LDS_BYTES, stream, a);
    const hipError_t le = hipPeekAtLastError();
    if (le != hipSuccess) fprintf(stderr, "kernel_launch: launch failed: %s\n", hipGetErrorName(le));
}
```

```cpp
#include <hip/hip_runtime.h>
#include <cstdio>
#include <cstdint>
namespace pg8 {
#define PG8_LAS __attribute__((address_space(3)))
typedef unsigned short bf16_t;
typedef short bf16x8 __attribute__((ext_vector_type(8)));
typedef float f32x4 __attribute__((ext_vector_type(4)));
typedef unsigned u32x4 __attribute__((ext_vector_type(4)));
constexpr int BM = 256, BK = 64, HALF = 128, HTB = HALF * BK * 2  , STAGE_BYTES = 8 * HTB, NXCD = 8, WGM = 8;

__host__ __device__ __forceinline__ int lds_byte(int r, int c) { const int st = (r >> 4) * 2 + (c >> 5), rr = r & 15, cc = c & 31, ob = rr * 64 + cc * 2; return st * 1024 + (ob ^ (((ob >> 9) & 1) << 5)); }
__host__ __device__ __forceinline__ void stage_rc(int b, int& R, int& C) { const int st = b / 1024, sb = b % 1024, swz = sb ^ (((sb >> 9) & 1) << 5); R = (st >> 1) * 16 + swz / 64; C = (st & 1) * 32 + (swz % 64) / 2; }
__host__ __device__ __forceinline__ int perm32(int rho) { const int n = rho >> 4, i = rho & 15; return 8 * (i >> 2) + 4 * n + (i & 3); }

struct Unit { int pm, pn; };
struct Gemm { const bf16_t* A; const bf16_t* Bt; int M, N, K; };

struct StaticOrder {
    int nM, nN, nwg, G, c;
    __host__ __device__ void init(int M, int N, int G_, int c_) { nM = M / BM; nN = N / BM; nwg = nM * nN; G = G_; c = c_; }
    __host__ __device__ bool next(int i, Unit& u) const {
        const long L = (long)i * G + c; if (L >= nwg) return false;
        int wgid = (int)L; { const int q = nwg / NXCD, r = nwg % NXCD, xcd = wgid % NXCD, off = wgid / NXCD; wgid = (xcd < r ? xcd * (q + 1) : r * (q + 1) + (xcd - r) * q) + off; }
        const int nig = WGM * nN, gid = wgid / nig, fm = gid * WGM, gsz = (nM - fm) < WGM ? (nM - fm) : WGM;
        u.pm = fm + ((wgid % nig) % gsz); u.pn = (wgid % nig) / gsz; return true;
    }
    __device__ __forceinline__ void a_ready(const Unit&) const {}
    __device__ __forceinline__ void done(const Unit&) const {}
};

__device__ __forceinline__ unsigned cvt_pk_bf16(float lo, float hi) { unsigned r; asm volatile("v_cvt_pk_bf16_f32 %0, %1, %2" : "=v"(r) : "v"(lo), "v"(hi)); return r; }
typedef _Float16 h16x2 __attribute__((ext_vector_type(2)));
__device__ __forceinline__ unsigned cvt_pk_f16(float lo, float hi) { h16x2 v = {(_Float16)lo, (_Float16)hi}; return __builtin_bit_cast(unsigned, v); }
__device__ __forceinline__ float sigmoidf_(float x) { return __builtin_amdgcn_rcpf(1.0f + __builtin_amdgcn_exp2f(-1.4426950408889634f * x)); }
__device__ __forceinline__ float bf_lo(unsigned u) { return __builtin_bit_cast(float, u << 16); }
__device__ __forceinline__ float bf_hi(unsigned u) { return __builtin_bit_cast(float, u & 0xffff0000u); }

struct EpiProj {
    static constexpr bool PERM = true, AFTER_DRAIN = false;
    bf16_t *Q, *K, *V, *PR, *PG; float *NK, *NV;
    __device__ __forceinline__ void operator()(const f32x4 (&acc)[2][2][4][2], const Unit& u, int wr, int wc, int fr, int fq) const {
        const int row0 = u.pm * BM + wr * 64 + fr, pn = u.pn;
        bf16_t* base; int ld, colt, mode = 0; float* fb = nullptr;
        if (pn < 8) { base = Q; ld = 2048; colt = pn * 256; }
        else if (pn < 16) { base = K; ld = 2048; colt = (pn - 8) * 256; fb = NK; }
        else if (pn < 24) { base = V; ld = 2048; colt = (pn - 16) * 256; fb = NV; }
        else if (pn < 50) { base = PR; ld = 6656; colt = (pn - 24) * 256; mode = 1; }
        else { base = PG; ld = 8192; colt = (pn - 50) * 256; mode = 2; }
        const int col0 = colt + wc * 32 + 8 * fq;
#pragma unroll
        for (int ai = 0; ai < 2; ++ai)
#pragma unroll
            for (int m = 0; m < 4; ++m) { const size_t r = (size_t)(row0 + ai * HALF + m * 16); bf16_t* rowp = base + r * ld + col0;
#pragma unroll
                for (int bj = 0; bj < 2; ++bj) { f32x4 v0 = acc[ai][bj][m][0], v1 = acc[ai][bj][m][1]; u32x4 w;
                    if (mode == 2) { v0 = (f32x4){sigmoidf_(v0[0]), sigmoidf_(v0[1]), sigmoidf_(v0[2]), sigmoidf_(v0[3])}; v1 = (f32x4){sigmoidf_(v1[0]), sigmoidf_(v1[1]), sigmoidf_(v1[2]), sigmoidf_(v1[3])}; }
                    if (mode == 1) { w.x = cvt_pk_f16(v0[0], v0[1]); w.y = cvt_pk_f16(v0[2], v0[3]); w.z = cvt_pk_f16(v1[0], v1[1]); w.w = cvt_pk_f16(v1[2], v1[3]); }
                    else { w.x = cvt_pk_bf16(v0[0], v0[1]); w.y = cvt_pk_bf16(v0[2], v0[3]); w.z = cvt_pk_bf16(v1[0], v1[1]); w.w = cvt_pk_bf16(v1[2], v1[3]); }
                    *(u32x4*)(rowp + bj * HALF) = w;
                    if (fb) { float* fp = fb + r * 2048 + col0 + bj * HALF; *(f32x4*)fp = v0; *(f32x4*)(fp + 4) = v1; } } }
    }
};
struct EpiLora {
    static constexpr bool PERM = true, AFTER_DRAIN = false;
    bf16_t* OUT[5]; const float *w0, *a0; int selb;
    __device__ __forceinline__ void operator()(const f32x4 (&acc)[2][2][4][2], const Unit& u, int wr, int wc, int fr, int fq) const {
        const int row0 = u.pm * BM + wr * 64 + fr, sel = selb + (u.pn >> 3), colt = (u.pn & 7) * 256, col0 = colt + wc * 32 + 8 * fq;
        bf16_t* base = sel == 0 ? OUT[0] : sel == 1 ? OUT[1] : sel == 2 ? OUT[2] : sel == 3 ? OUT[3] : OUT[4];
        const float* bias = sel < 2 ? w0 + sel * 2048 : a0 + (sel - 2) * 2048;
        f32x4 bv[2][2];
#pragma unroll
        for (int bj = 0; bj < 2; ++bj)
#pragma unroll
            for (int n = 0; n < 2; ++n) bv[bj][n] = sel < 4 ? *(const f32x4*)(bias + col0 + bj * HALF + 4 * n) : (f32x4){0.f, 0.f, 0.f, 0.f};
#pragma unroll
        for (int ai = 0; ai < 2; ++ai)
#pragma unroll
            for (int m = 0; m < 4; ++m) { bf16_t* rowp = base + (size_t)(row0 + ai * HALF + m * 16) * 2048 + col0;
#pragma unroll
                for (int bj = 0; bj < 2; ++bj) { f32x4 v0 = acc[ai][bj][m][0] + bv[bj][0], v1 = acc[ai][bj][m][1] + bv[bj][1];
                    if (sel < 4) {
#pragma unroll
                        for (int e = 0; e < 4; ++e) { v0[e] = sigmoidf_(v0[e]); v1[e] = sigmoidf_(v1[e]); }
                        if (sel < 2) {
#pragma unroll
                            for (int e = 0; e < 4; ++e) { v0[e] = __builtin_amdgcn_exp2f(-0.87503716f * v0[e]); v1[e] = __builtin_amdgcn_exp2f(-0.87503716f * v1[e]); } } }
                    u32x4 w; w.x = cvt_pk_f16(v0[0], v0[1]); w.y = cvt_pk_f16(v0[2], v0[3]); w.z = cvt_pk_f16(v1[0], v1[1]); w.w = cvt_pk_f16(v1[2], v1[3]);
                    *(u32x4*)(rowp + bj * HALF) = w; } }
    }
};
template <bool ADD> struct EpiGate {
    static constexpr bool PERM = true, AFTER_DRAIN = false;
    bf16_t* O; const bf16_t* G; int goff;
    __device__ __forceinline__ void operator()(const f32x4 (&acc)[2][2][4][2], const Unit& u, int wr, int wc, int fr, int fq) const {
        const int row0 = u.pm * BM + wr * 64 + fr, col0 = u.pn * BM + wc * 32 + 8 * fq;
#pragma unroll
        for (int ai = 0; ai < 2; ++ai)
#pragma unroll
            for (int m = 0; m < 4; ++m) { const size_t r = (size_t)(row0 + ai * HALF + m * 16); bf16_t* rowp = O + r * 4096 + col0; const bf16_t* gp = G + r * 8192 + goff + col0;
#pragma unroll
                for (int bj = 0; bj < 2; ++bj) { const u32x4 g = *(const u32x4*)(gp + bj * HALF); const f32x4 a0 = acc[ai][bj][m][0], a1 = acc[ai][bj][m][1];
                    float o[8] = {a0[0] * bf_lo(g.x), a0[1] * bf_hi(g.x), a0[2] * bf_lo(g.y), a0[3] * bf_hi(g.y), a1[0] * bf_lo(g.z), a1[1] * bf_hi(g.z), a1[2] * bf_lo(g.w), a1[3] * bf_hi(g.w)};
                    if (ADD) { const u32x4 p = *(const u32x4*)(rowp + bj * HALF); o[0] += bf_lo(p.x); o[1] += bf_hi(p.x); o[2] += bf_lo(p.y); o[3] += bf_hi(p.y); o[4] += bf_lo(p.z); o[5] += bf_hi(p.z); o[6] += bf_lo(p.w); o[7] += bf_hi(p.w); }
                    u32x4 w; w.x = cvt_pk_bf16(o[0], o[1]); w.y = cvt_pk_bf16(o[2], o[3]); w.z = cvt_pk_bf16(o[4], o[5]); w.w = cvt_pk_bf16(o[6], o[7]);
                    *(u32x4*)(rowp + bj * HALF) = w; } }
    }
};
__device__ __forceinline__ f32x4 h4lo(unsigned a, unsigned b) { typedef _Float16 hh2 __attribute__((ext_vector_type(2))); const hh2 x = __builtin_bit_cast(hh2, a), y = __builtin_bit_cast(hh2, b); return (f32x4){(float)x.x, (float)x.y, (float)y.x, (float)y.y}; }
template <bool RF32> struct EpiResid {
    static constexpr bool PERM = true, AFTER_DRAIN = false;
    const float* R32; bf16_t* XH; const float* gt; int jbase, ppb, jmul;
    __device__ __forceinline__ void operator()(const f32x4 (&acc)[2][2][4][2], const Unit& u, int wr, int wc, int fr, int fq) const {
        const int row0 = u.pm * BM + wr * 64 + fr, col0 = u.pn * BM + wc * 32 + 8 * fq;
        const float* g = gt + (size_t)(jbase + (u.pm / ppb) * jmul) * 24576 + col0;
        f32x4 gv[2][2];
#pragma unroll
        for (int bj = 0; bj < 2; ++bj)
#pragma unroll
            for (int n = 0; n < 2; ++n) gv[bj][n] = *(const f32x4*)(g + bj * HALF + 4 * n);
#pragma unroll
        for (int ai = 0; ai < 2; ++ai)
#pragma unroll
            for (int m = 0; m < 4; ++m) { const size_t row = (size_t)(row0 + ai * HALF + m * 16); bf16_t* xp = XH + row * 8192 + col0;
#pragma unroll
                for (int bj = 0; bj < 2; ++bj) { f32x4 r0, r1;
                    if (RF32) { const float* rp = R32 + row * 4096 + col0 + bj * HALF; r0 = *(const f32x4*)rp; r1 = *(const f32x4*)(rp + 4); }
                    else { const u32x4 h = *(const u32x4*)(xp + bj * HALF); r0 = h4lo(h.x, h.y); r1 = h4lo(h.z, h.w); }
                    const f32x4 y0 = r0 + gv[bj][0] * acc[ai][bj][m][0], y1 = r1 + gv[bj][1] * acc[ai][bj][m][1];
                    u32x4 w; w.x = cvt_pk_f16(y0[0], y0[1]); w.y = cvt_pk_f16(y0[2], y0[3]); w.z = cvt_pk_f16(y1[0], y1[1]); w.w = cvt_pk_f16(y1[2], y1[3]);
                    *(u32x4*)(xp + bj * HALF) = w; } }
    }
};
struct EpiRelu2 {
    static constexpr bool PERM = true, AFTER_DRAIN = false;
    bf16_t* U;
    __device__ __forceinline__ void operator()(const f32x4 (&acc)[2][2][4][2], const Unit& u, int wr, int wc, int fr, int fq) const {
        const int row0 = u.pm * BM + wr * 64 + fr, col0 = u.pn * BM + wc * 32 + 8 * fq;
#pragma unroll
        for (int ai = 0; ai < 2; ++ai)
#pragma unroll
            for (int m = 0; m < 4; ++m) { bf16_t* rowp = U + (size_t)(row0 + ai * HALF + m * 16) * 16384 + col0;
#pragma unroll
                for (int bj = 0; bj < 2; ++bj) { f32x4 v0 = acc[ai][bj][m][0], v1 = acc[ai][bj][m][1];
#pragma unroll
                    for (int e = 0; e < 4; ++e) { const float a = fmaxf(v0[e], 0.f), b = fmaxf(v1[e], 0.f); v0[e] = a * a; v1[e] = b * b; }
                    u32x4 w; w.x = cvt_pk_bf16(v0[0], v0[1]); w.y = cvt_pk_bf16(v0[2], v0[3]); w.z = cvt_pk_bf16(v1[0], v1[1]); w.w = cvt_pk_bf16(v1[2], v1[3]);
                    *(u32x4*)(rowp + bj * HALF) = w; } }
    }
};

template <class Epi, class Sched, bool ALIGN_EPI = false, bool SP2 = false>
__device__ __forceinline__ void gemm_phase(PG8_LAS unsigned char* lds, const Gemm g, const Sched& S, const Epi& E) {
    int tid_ = threadIdx.x; asm volatile("" : "+v"(tid_));
    const int tid = tid_, wid = __builtin_amdgcn_readfirstlane(tid >> 6), lane = tid & 63, wr = wid >> 2, wc = wid & 3, fr = lane & 15, fq = lane >> 4;
    const int K = g.K, nt = K / BK;
    unsigned voffA[2], voffB[2];
#pragma unroll
    for (int i = 0; i < 2; ++i) { int R, C; stage_rc(tid * 16 + i * 8192, R, C); const int Rb = Epi::PERM ? ((R & ~31) + perm32(R & 31)) : R;
        voffA[i] = (unsigned)(R * K + C) * 2u; voffB[i] = (unsigned)(Rb * K + C) * 2u; }
    const size_t kstep = (size_t)(BK * 2);
    const size_t hstep = (size_t)HALF * K * 2;
    const size_t tstep = 2 * hstep;
    const unsigned ldsw = (unsigned)wid * 1024u;
    const int aoff = lds_byte(wr * 64 + fr, fq * 8), boff = lds_byte(wc * 32 + fr, fq * 8);
#define PG8_SA(b, h) (((b) * 2 + (h)) * HTB)
#define PG8_SB(b, h) ((4 + (b) * 2 + (h)) * HTB)
#define PG8_STAGE(bufoff, gbase, voff) do { _Pragma("unroll") for (int _i = 0; _i < 2; ++_i) \
        __builtin_amdgcn_global_load_lds((const unsigned*)((const char*)(gbase) + (voff)[_i]), (PG8_LAS unsigned*)(lds + (bufoff) + ldsw + _i * 8192), 16, 0, 0); } while (0)
#define PG8_LDA(dst, b, h) do { _Pragma("unroll") for (int m = 0; m < 4; ++m) _Pragma("unroll") for (int k = 0; k < 2; ++k) dst[m][k] = *(const PG8_LAS bf16x8*)(lds + PG8_SA(b, h) + aoff + m * 2048 + k * 1024); } while (0)
#define PG8_LDB(dst, b, h) do { _Pragma("unroll") for (int n = 0; n < 2; ++n) _Pragma("unroll") for (int k = 0; k < 2; ++k) dst[n][k] = *(const PG8_LAS bf16x8*)(lds + PG8_SB(b, h) + boff + n * 2048 + k * 1024); } while (0)
#define PG8_MMA(ai, bj, At, Bt) do { __builtin_amdgcn_s_setprio(1); _Pragma("unroll") for (int m = 0; m < 4; ++m) _Pragma("unroll") for (int n = 0; n < 2; ++n) _Pragma("unroll") for (int k = 0; k < 2; ++k) \
        acc[ai][bj][m][n] = __builtin_amdgcn_mfma_f32_16x16x32_bf16(Bt[n][k], At[m][k], acc[ai][bj][m][n], 0, 0, 0); __builtin_amdgcn_s_setprio(0); } while (0)
#define PG8_WAIT_V(n) asm volatile("s_waitcnt vmcnt(" #n ")" ::: "memory")
#define PG8_WAIT_L(n) asm volatile("s_waitcnt lgkmcnt(" #n ")" ::: "memory")
#define PG8_BAR __builtin_amdgcn_s_barrier()
#define PG8_SCHED __builtin_amdgcn_sched_barrier(0)
    Unit cur, nxt; int ui = 0;
    if (!S.next(0, cur)) return;
    f32x4 acc[2][2][4][2];
#pragma unroll
    for (int a = 0; a < 2; ++a)
#pragma unroll
        for (int b = 0; b < 2; ++b)
#pragma unroll
            for (int m = 0; m < 4; ++m)
#pragma unroll
                for (int n = 0; n < 2; ++n) acc[a][b][m][n] = (f32x4){0.f, 0.f, 0.f, 0.f};
    bf16x8 At[4][2], B0[2][2], B1[2][2];
    const char* cA = (const char*)g.A + (size_t)cur.pm * tstep; const char* cB = (const char*)g.Bt + (size_t)cur.pn * tstep;
    S.a_ready(cur);
    if constexpr (SP2) {
        PG8_STAGE(PG8_SB(0, 0), cB, voffB); PG8_STAGE(PG8_SB(0, 1), cB + hstep, voffB); PG8_STAGE(PG8_SA(0, 0), cA, voffA); PG8_STAGE(PG8_SA(0, 1), cA + hstep, voffA);
        if (wr == 1) PG8_BAR;
        PG8_WAIT_V(2); PG8_BAR;
        PG8_STAGE(PG8_SB(1, 0), cB + kstep, voffB); PG8_STAGE(PG8_SA(1, 0), cA + kstep, voffA); PG8_STAGE(PG8_SB(1, 1), cB + hstep + kstep, voffB);
        PG8_WAIT_V(6); PG8_BAR;
    } else {
        PG8_STAGE(PG8_SB(0, 0), cB, voffB); PG8_STAGE(PG8_SA(0, 0), cA, voffA); PG8_STAGE(PG8_SB(0, 1), cB + hstep, voffB); PG8_STAGE(PG8_SA(0, 1), cA + hstep, voffA);
        if (wr == 1) PG8_BAR;
        PG8_WAIT_V(4); PG8_BAR;
        PG8_STAGE(PG8_SB(1, 0), cB + kstep, voffB); PG8_STAGE(PG8_SA(1, 0), cA + kstep, voffA); PG8_STAGE(PG8_SB(1, 1), cB + hstep + kstep, voffB);
        PG8_WAIT_V(6); PG8_BAR;
    }
    for (;;) {
        const bool has_next = S.next(ui + 1, nxt);
        const char* nA = has_next ? (const char*)g.A + (size_t)nxt.pm * tstep : cA; const char* nB = has_next ? (const char*)g.Bt + (size_t)nxt.pn * tstep : cB;
        for (int t = 0; t < nt; t += 2) {
            const bool last = (t == nt - 2);
            const char* a1 = cA + (size_t)(t + 1) * kstep;
            const char* a2 = last ? nA : cA + (size_t)(t + 2) * kstep; const char* b2 = last ? nB : cB + (size_t)(t + 2) * kstep;
            const char* a3 = a2 + kstep; const char* b3 = b2 + kstep;
            if (last && has_next) S.a_ready(nxt);
            if constexpr (SP2) {
            PG8_LDB(B0, 0, 0); PG8_LDB(B1, 0, 1); PG8_SCHED; PG8_LDA(At, 0, 0); PG8_STAGE(PG8_SA(1, 1), a1 + hstep, voffA);
            PG8_WAIT_V(8); PG8_WAIT_L(0); PG8_BAR; PG8_MMA(0, 0, At, B0); PG8_MMA(0, 1, At, B1); PG8_BAR; PG8_SCHED;
            PG8_LDA(At, 0, 1); PG8_STAGE(PG8_SB(0, 0), b2, voffB); PG8_STAGE(PG8_SB(0, 1), b2 + hstep, voffB); PG8_STAGE(PG8_SA(0, 0), a2, voffA);
            PG8_WAIT_V(8); PG8_WAIT_L(0); PG8_BAR; PG8_MMA(1, 0, At, B0); PG8_MMA(1, 1, At, B1); PG8_BAR; PG8_SCHED;
            PG8_LDB(B0, 1, 0); PG8_LDB(B1, 1, 1); PG8_SCHED; PG8_LDA(At, 1, 0); PG8_STAGE(PG8_SA(0, 1), a2 + hstep, voffA);
            PG8_WAIT_V(8); PG8_WAIT_L(0); PG8_BAR; PG8_MMA(0, 0, At, B0); PG8_MMA(0, 1, At, B1); PG8_BAR; PG8_SCHED;
            PG8_LDA(At, 1, 1); PG8_STAGE(PG8_SB(1, 0), b3, voffB); PG8_STAGE(PG8_SB(1, 1), b3 + hstep, voffB); PG8_STAGE(PG8_SA(1, 0), a3, voffA);
            PG8_WAIT_V(8); PG8_WAIT_L(0); PG8_BAR; PG8_MMA(1, 0, At, B0); PG8_MMA(1, 1, At, B1); PG8_BAR; PG8_SCHED;
            } else {
            PG8_LDB(B0, 0, 0); PG8_SCHED; PG8_LDA(At, 0, 0); PG8_STAGE(PG8_SA(1, 1), a1 + hstep, voffA);
            PG8_WAIT_L(8); PG8_BAR; PG8_WAIT_L(0); PG8_MMA(0, 0, At, B0); PG8_BAR; PG8_SCHED;
            PG8_LDB(B1, 0, 1); PG8_STAGE(PG8_SB(0, 0), b2, voffB);
            PG8_BAR; PG8_WAIT_L(0); PG8_MMA(0, 1, At, B1); PG8_BAR;
            PG8_LDA(At, 0, 1); PG8_STAGE(PG8_SA(0, 0), a2, voffA);
            PG8_BAR; PG8_WAIT_L(0); PG8_MMA(1, 0, At, B0); PG8_BAR; PG8_SCHED;
            PG8_STAGE(PG8_SB(0, 1), b2 + hstep, voffB);
            PG8_WAIT_V(6); PG8_BAR; PG8_MMA(1, 1, At, B1); PG8_BAR;
            PG8_LDB(B0, 1, 0); PG8_SCHED; PG8_LDA(At, 1, 0); PG8_STAGE(PG8_SA(0, 1), a2 + hstep, voffA);
            PG8_WAIT_L(8); PG8_BAR; PG8_WAIT_L(0); PG8_MMA(0, 0, At, B0); PG8_BAR; PG8_SCHED;
            PG8_LDB(B1, 1, 1); PG8_STAGE(PG8_SB(1, 0), b3, voffB);
            PG8_BAR; PG8_WAIT_L(0); PG8_MMA(0, 1, At, B1); PG8_BAR;
            PG8_LDA(At, 1, 1); PG8_STAGE(PG8_SA(1, 0), a3, voffA);
            PG8_BAR; PG8_WAIT_L(0); PG8_MMA(1, 0, At, B0); PG8_BAR; PG8_SCHED;
            PG8_STAGE(PG8_SB(1, 1), b3 + hstep, voffB);
            PG8_WAIT_V(6); PG8_BAR; PG8_MMA(1, 1, At, B1); PG8_BAR;
            }
        }
        if constexpr (ALIGN_EPI) { if (wr == 0) PG8_BAR; }
        if constexpr (!Epi::AFTER_DRAIN) { E(acc, cur, wr, wc, fr, fq); S.done(cur); }
        if (!has_next) break;
#pragma unroll
        for (int a = 0; a < 2; ++a)
#pragma unroll
            for (int b = 0; b < 2; ++b)
#pragma unroll
                for (int m = 0; m < 4; ++m)
#pragma unroll
                    for (int n = 0; n < 2; ++n) acc[a][b][m][n] = (f32x4){0.f, 0.f, 0.f, 0.f};
        cur = nxt; cA = nA; cB = nB; ++ui;
        if constexpr (ALIGN_EPI) { if (wr == 1) PG8_BAR; }
    }
    PG8_WAIT_V(0);
    if constexpr (!ALIGN_EPI) { if (wr == 0) PG8_BAR; }
    PG8_BAR;
    if constexpr (Epi::AFTER_DRAIN) { E.fused(acc, cur, wr, wc, fr, fq, lds, wid, lane); S.done(cur); }
#undef PG8_SA
#undef PG8_SB
#undef PG8_STAGE
#undef PG8_LDA
#undef PG8_LDB
#undef PG8_MMA
#undef PG8_WAIT_V
#undef PG8_WAIT_L
#undef PG8_BAR
#undef PG8_SCHED
}
}


constexpr int NWAVES = 8;
constexpr int DM = 4096, T_CTX = 8192, T_LAT = 32768, L_CTX = 256, L_LAT = 4096, B_CTX = 32, B_LAT = 8;
constexpr int NH_A = 16, DH_A = 128, D_ATT = 2048, NH_R = 32, DH_R = 64, D_RW = 2048;
constexpr int C_RWKV = 6592, C_RWKV_P = 6656, D_IN = 20928, N_IN_P = 20992, D_FF = 16384, N_LORA = 10240, K_LORA = 512, NMOD = 24576;
constexpr float RMS_EPS = 1e-6f, LNX_EPS = 64e-5f;
constexpr size_t MiB = 1u << 20;
constexpr size_t WS_CTL = 0, CTL_ZERO_BYTES = 1 * MiB;
constexpr size_t WS_MODP = 1 * MiB;
constexpr size_t WS_MOD = 8 * MiB;
constexpr size_t WS_WIN = 9 * MiB;
constexpr size_t WS_WOA = 173 * MiB, WS_WOR = 189 * MiB, WS_WOUT = 205 * MiB;
constexpr size_t WS_WM1 = 237 * MiB, WS_WM2 = 365 * MiB;
constexpr size_t WS_WLORA = 493 * MiB;
constexpr size_t WS_CK = 503 * MiB, WS_CV = 511 * MiB;
constexpr size_t WS_H = 520 * MiB;
constexpr size_t WS_Q = 776 * MiB, WS_K = 904 * MiB, WS_V = 1032 * MiB;
constexpr size_t WS_PR = 1160 * MiB;
constexpr size_t WS_ORW = 1832 * MiB;
constexpr size_t WS_HLAT = 1576 * MiB;
constexpr size_t WS_MID = 1160 * MiB;
constexpr size_t WS_U = 776 * MiB;
constexpr size_t WS_END = 2048 * MiB;
constexpr size_t WS_RS = 520 * MiB, WS_KS = 648 * MiB, WS_VS = 1576 * MiB, WS_KK = 1704 * MiB;
constexpr size_t WS_DF = 1160 * MiB, WS_DB = 1288 * MiB, WS_AF = 1416 * MiB, WS_YF = WS_ORW, WS_AB = WS_K, WS_LG = WS_V;
constexpr size_t WS_YB_CTX = 1960 * MiB, WS_YB_LAT = WS_WIN, WS_LA = 2016 * MiB;
static_assert(WS_U + (size_t)T_LAT * D_FF * 2 <= WS_END && WS_LA + (size_t)T_LAT * K_LORA * 2 <= WS_END && WS_YB_CTX + (size_t)T_CTX * D_RW * 2 <= WS_LA && WS_YF + (size_t)T_LAT * D_RW * 2 <= WS_YB_CTX && WS_MID + (size_t)T_LAT * DM * 2 <= WS_AF, "d_ws map");
constexpr int CW_BAR = 4096;
constexpr int RING_OFF = 0, RING_BYTES = 131072;
constexpr int LDSCTL_OFF = RING_BYTES, MISC_OFF = LDSCTL_OFF + 320;
constexpr int LDS_BYTES = 147456;

#define GAS __attribute__((address_space(1)))
#define LAS __attribute__((address_space(3)))
typedef unsigned short bf16;
typedef unsigned v4u __attribute__((ext_vector_type(4)));
typedef float f32x4 __attribute__((ext_vector_type(4)));
typedef short bf16x8 __attribute__((ext_vector_type(8)));
typedef GAS unsigned gu32;
typedef GAS unsigned long long gu64;
#define RLX_AGENT __ATOMIC_RELAXED, __HIP_MEMORY_SCOPE_AGENT
#define LDS_WAIT() asm volatile("s_waitcnt lgkmcnt(0)" ::: "memory")
#define VM_WAIT() asm volatile("s_waitcnt vmcnt(0)" ::: "memory")
__device__ __forceinline__ unsigned long long rt() { return __builtin_amdgcn_s_memrealtime(); }
__device__ __forceinline__ unsigned f2bf(float f) { unsigned u = __builtin_bit_cast(unsigned, f); return (u + 0x7fffu + ((u >> 16) & 1u)) >> 16; }
__device__ __forceinline__ unsigned pk2(float lo, float hi) { return f2bf(lo) | (f2bf(hi) << 16); }

#define XB_TMO      128
#define XB_XCNT(j)  (256  + 64 * (j))
#define XB_XSUB(j)  (1280 + 64 * (j))
#define XB_XGEN(j)  (2304 + 64 * (j))
#define XB_TOP      3328
#define XB_TOPGEN   3392
#define XCD_BAR_WORDS 3456
#define XB_SPIN_CAP (1u << 18)

__device__ __forceinline__ unsigned xb_ld(unsigned* p)              { return __hip_atomic_load(p, __ATOMIC_RELAXED, __HIP_MEMORY_SCOPE_AGENT); }
__device__ __forceinline__ unsigned xb_add(unsigned* p, unsigned v) { return __hip_atomic_fetch_add(p, v, __ATOMIC_RELAXED, __HIP_MEMORY_SCOPE_AGENT); }
__device__ __forceinline__ unsigned xb_xcc_id() { return (unsigned)__builtin_amdgcn_s_getreg((3 << 11) | 20) & 0xFu; }
#define XB_SPIN(cond, bar) do { unsigned _sp = 0; while (cond) { __builtin_amdgcn_s_sleep(1); \
    if ((++_sp & 255u) == 0u) { if (xb_ld(&(bar)[XB_TMO])) break; if (_sp > XB_SPIN_CAP) { atomicAdd(&(bar)[XB_TMO], 1u); break; } } } } while (0)

struct XcdBarrier {
    unsigned* bar; unsigned x;
    volatile LAS unsigned* st;
};

__device__ __forceinline__ XcdBarrier xcd_barrier_post(unsigned* bar, volatile LAS unsigned* st) {
    XcdBarrier b; b.bar = bar; b.x = xb_xcc_id(); b.st = st;
    if (threadIdx.x == 0) (void)xb_add(&bar[XB_XCNT(b.x)], 1u);
    return b;
}
__device__ __forceinline__ void xcd_barrier_complete(unsigned* bar, unsigned x, unsigned& nloc, unsigned& nx) {
    const unsigned G = gridDim.x * gridDim.y * gridDim.z;
    unsigned sum, cnt, mine, sp = 0u;
    for (;;) {
        sum = 0u; cnt = 0u; mine = 0u;
#pragma unroll
        for (unsigned j = 0; j < 16; ++j) { const unsigned c = xb_ld(&bar[XB_XCNT(j)]); sum += c; cnt += (c > 0u) ? 1u : 0u; mine = (j == x) ? c : mine; }
        if (sum == G) break;
        __builtin_amdgcn_s_sleep(1);
        if ((++sp & 255u) == 0u) { if (xb_ld(&bar[XB_TMO])) break; if (sp > XB_SPIN_CAP) { atomicAdd(&bar[XB_TMO], 1u); break; } }
    }
    nloc = mine > 0u ? mine : 1u; nx = cnt > 0u ? cnt : 1u;
}

__device__ __forceinline__ void xcd_barrier(const XcdBarrier& b) {
    asm volatile("s_waitcnt vmcnt(0)" ::: "memory");
    __syncthreads();
    if (threadIdx.x == 0) {
        unsigned* bar = b.bar;
        __builtin_amdgcn_s_waitcnt(0);
        unsigned nloc = b.st[0], nx = b.st[1];
        if (nloc == 0u) { xcd_barrier_complete(bar, b.x, nloc, nx); b.st[0] = nloc; b.st[1] = nx; }
        const unsigned old = xb_add(&bar[XB_XSUB(b.x)], 1u);
        const unsigned gen = old / nloc;
        if (old + 1u == (gen + 1u) * nloc) {
            __builtin_amdgcn_fence(__ATOMIC_RELEASE, "agent");
            asm volatile("s_waitcnt vmcnt(0)" ::: "memory");
            const unsigned og = xb_add(&bar[XB_TOP], 1u);
            const unsigned tg = og / nx;
            if (og + 1u == (tg + 1u) * nx) xb_add(&bar[XB_TOPGEN], 1u);
            else XB_SPIN(xb_ld(&bar[XB_TOPGEN]) == tg, bar);
            __builtin_amdgcn_fence(__ATOMIC_ACQUIRE, "agent");
            xb_add(&bar[XB_XGEN(b.x)], 1u);
            asm volatile("s_waitcnt vmcnt(0)" ::: "memory");
        } else {
            XB_SPIN(xb_ld(&bar[XB_XGEN(b.x)]) == gen, bar);
            __builtin_amdgcn_fence(__ATOMIC_ACQUIRE, "agent");
            asm volatile("s_waitcnt vmcnt(0)" ::: "memory");
        }
    }
    __syncthreads();
}

typedef unsigned short h16s;
typedef _Float16 h16x8 __attribute__((ext_vector_type(8)));
typedef float f32x16 __attribute__((ext_vector_type(16)));
typedef short s16x4 __attribute__((ext_vector_type(4)));
struct Frame {
    LAS unsigned char* lds;
    volatile LAS unsigned* MISC;
    gu32* ctl;
    int tid, lane, wave;
    int vcu, G;
    unsigned char* ws;
    float* out;
};
struct Args { const float* in[31]; float* out; unsigned char* ws; };
enum { I_XP = 0, I_XS, I_CK, I_CV, I_SF, I_SB, I_C, I_CCTX, I_WMOD, I_BMOD, I_N1, I_N2, I_NF, I_WIN, I_MU, I_RPB, I_W0, I_W2, I_A0, I_A2, I_G2, I_KK, I_KA, I_RK, I_LNW, I_LNB, I_WOA, I_WOR, I_WOUT, I_WM1, I_WM2 };
constexpr size_t O_Y = 0, O_NK = (size_t)(T_CTX + T_LAT) * DM, O_NV = O_NK + (size_t)T_CTX * D_ATT, O_SF = O_NV + (size_t)T_CTX * D_ATT, O_SB = O_SF + (size_t)B_CTX * NH_R * 64 * 64;

__device__ __forceinline__ float wave_sum(float v) {
#pragma unroll
    for (int o = 1; o < 64; o <<= 1) v += __shfl_xor(v, o);
    return v;
}
__device__ __forceinline__ unsigned pkbf(float lo, float hi) { return pg8::cvt_pk_bf16(lo, hi); }
__device__ __forceinline__ unsigned pkh(float lo, float hi) { return pg8::cvt_pk_f16(lo, hi); }
__device__ __forceinline__ float sigm(float x) { return pg8::sigmoidf_(x); }
__device__ __forceinline__ void unpack_h8(const v4u w, float (&f)[8]) { const h16x8 h = __builtin_bit_cast(h16x8, w);
#pragma unroll
    for (int e = 0; e < 8; ++e) f[e] = (float)h[e]; }

__device__ __forceinline__ void p0_transpose_item(const float* W, int ldw, int col_off, int nblk, bf16* WT, int ldt, int row_off, LAS float* scr, int item, int lane) {
    const int kb = item / nblk, nb = item % nblk, k0 = 64 * kb, n0 = 32 * nb;
    { f32x4 t[8]; const int kr = lane >> 3, nq = (lane & 7) * 4;
#pragma unroll
      for (int i = 0; i < 8; ++i) t[i] = *(const GAS f32x4*)(W + (size_t)(k0 + 8 * i + kr) * ldw + col_off + n0 + nq);
#pragma unroll
      for (int i = 0; i < 8; ++i) { LAS float* d = scr + (8 * i + kr) * 33 + nq; d[0] = t[i].x; d[1] = t[i].y; d[2] = t[i].z; d[3] = t[i].w; } }
    LDS_WAIT(); asm volatile("" ::: "memory");
    const int c = lane & 7;
#pragma unroll
    for (int j = 0; j < 4; ++j) { const int n = (lane >> 3) + 8 * j; const LAS float* s = scr + (8 * c) * 33 + n;
        v4u o; o.x = pkbf(s[0 * 33], s[1 * 33]); o.y = pkbf(s[2 * 33], s[3 * 33]); o.z = pkbf(s[4 * 33], s[5 * 33]); o.w = pkbf(s[6 * 33], s[7 * 33]);
        *(GAS v4u*)(WT + (size_t)(row_off + n0 + n) * ldt + k0 + 8 * c) = o; }
    LDS_WAIT(); asm volatile("" ::: "memory");
}
struct TDesc { const float* W; bf16* WT; int ldw, lgn, ldt, item; };
__device__ __forceinline__ TDesc late_desc(const Args& A, unsigned char* ws, int r) {
    constexpr int E0 = 32 * 128, E1 = E0 + 32 * 128, E2 = E1 + 64 * 128, E3 = E2 + 64 * 512;
    const int sel = (r >= E0) + (r >= E1) + (r >= E2) + (r >= E3);
    const int base = sel == 0 ? 0 : sel == 1 ? E0 : sel == 2 ? E1 : sel == 3 ? E2 : E3;
    const int widx = sel == 0 ? I_WOA : sel == 1 ? I_WOR : sel == 2 ? I_WOUT : sel == 3 ? I_WM1 : I_WM2;
    const size_t woff = sel == 0 ? WS_WOA : sel == 1 ? WS_WOR : sel == 2 ? WS_WOUT : sel == 3 ? WS_WM1 : WS_WM2;
    const int ldw = sel == 3 ? D_FF : DM, lgn = sel == 3 ? 9 : 7, ldt = sel == 0 ? D_ATT : sel == 1 ? D_RW : sel == 4 ? D_FF : DM;
    typedef const float* fptr; const __attribute__((address_space(4))) fptr* kin = (const __attribute__((address_space(4))) fptr*)__builtin_amdgcn_kernarg_segment_ptr();
    return TDesc{kin[widx], (bf16*)(ws + woff), ldw, lgn, ldt, r - base};
}
constexpr int LATE_ITEMS = 32 * 128 + 32 * 128 + 64 * 128 + 64 * 512 + 256 * 128;
__device__ __forceinline__ void late_load(f32x4 (&t)[8], const TDesc& d, int lane) {
    const int kb = d.item >> d.lgn, nb = d.item & ((1 << d.lgn) - 1), k0 = 64 * kb, n0 = 32 * nb, kr = lane >> 3, nq = (lane & 7) * 4;
#pragma unroll
    for (int i = 0; i < 8; ++i) t[i] = *(const GAS f32x4*)(d.W + (size_t)(k0 + 8 * i + kr) * d.ldw + n0 + nq);
}
__device__ __forceinline__ void late_finish(const f32x4 (&t)[8], const TDesc& d, LAS float* scr, int lane) {
    const int kb = d.item >> d.lgn, nb = d.item & ((1 << d.lgn) - 1), k0 = 64 * kb, n0 = 32 * nb, kr = lane >> 3, nq = (lane & 7) * 4;
#pragma unroll
    for (int i = 0; i < 8; ++i) { LAS float* q = scr + (8 * i + kr) * 33 + nq; q[0] = t[i].x; q[1] = t[i].y; q[2] = t[i].z; q[3] = t[i].w; }
    LDS_WAIT(); asm volatile("" ::: "memory");
    const int c = lane & 7;
#pragma unroll
    for (int j = 0; j < 4; ++j) { const int n = (lane >> 3) + 8 * j; const LAS float* sp = scr + (8 * c) * 33 + n;
        v4u o; o.x = pkbf(sp[0 * 33], sp[1 * 33]); o.y = pkbf(sp[2 * 33], sp[3 * 33]); o.z = pkbf(sp[4 * 33], sp[5 * 33]); o.w = pkbf(sp[6 * 33], sp[7 * 33]);
        *(GAS v4u*)(d.WT + (size_t)(n0 + n) * d.ldt + k0 + 8 * c) = o; }
    LDS_WAIT(); asm volatile("" ::: "memory");
}
__device__ __forceinline__ void late_weight_copies(Frame& F, const Args& A, int part, int nparts) {
    LAS float* scr = (LAS float*)(F.lds + RING_OFF + F.wave * 16384);
    int w0 = part * NWAVES + F.wave; const int st = nparts * NWAVES;
    asm volatile("" : "+v"(w0));
    if (w0 >= LATE_ITEMS) return;
    f32x4 ta[8], tb[8], tc[8];
#define LATE_LD(T, IT) late_load(T, late_desc(A, F.ws, min((IT), LATE_ITEMS - 1)), F.lane)
#define LATE_FN(T, IT) late_finish(T, late_desc(A, F.ws, (IT)), scr, F.lane)
    LATE_LD(ta, w0); LATE_LD(tb, w0 + st);
    for (int it = w0;;) {
        LATE_LD(tc, it + 2 * st); LATE_FN(ta, it); if (it + st >= LATE_ITEMS) break;
        LATE_LD(ta, it + 3 * st); LATE_FN(tb, it + st); if (it + 2 * st >= LATE_ITEMS) break;
        LATE_LD(tb, it + 4 * st); LATE_FN(tc, it + 2 * st); if (it + 3 * st >= LATE_ITEMS) break;
        it += 3 * st;
    }
#undef LATE_LD
#undef LATE_FN
}
__device__ __forceinline__ void p0_prologue(Frame& F, const Args& A) {
    const int gw = F.vcu * NWAVES + F.wave, NGW = F.G * NWAVES, gt = gw * 64 + F.lane, NGT = NGW * 64;
    unsigned char* ws = F.ws;
    { LAS float* scr = (LAS float*)(F.lds + RING_OFF + F.wave * 16384);
      constexpr int I_A = 64 * 398, I_B = 64 * 256, NITEMS = I_A + I_B;
      for (int it = gw; it < NITEMS; it += NGW) { int r = it;
          if (r < I_A) { p0_transpose_item(A.in[I_WIN], D_IN, 0, 398, (bf16*)(ws + WS_WIN), DM, 0, scr, r, F.lane); continue; } r -= I_A;
          p0_transpose_item(A.in[I_WIN], D_IN, 12736, 256, (bf16*)(ws + WS_WIN), DM, 12800, scr, r, F.lane);
      } }
    { GAS v4u* p = (GAS v4u*)((bf16*)(ws + WS_WIN) + (size_t)12736 * DM); const int n = 64 * DM / 8; for (int i = gt; i < n; i += NGT) p[i] = (v4u){0u, 0u, 0u, 0u}; }
    { bf16* WL = (bf16*)(ws + WS_WLORA); const float *w2 = A.in[I_W2], *a2 = A.in[I_A2], *g2 = A.in[I_G2];
      for (int i = gt; i < N_LORA * 256 / 2; i += NGT) { const int n = i >> 7, k = (i & 127) * 2; const int sel = n >> 11, col = n & 2047; float v[2];
#pragma unroll
          for (int e = 0; e < 2; ++e) { const int kk = k + e; float x = 0.f;
              if (sel < 2) { if (kk < 96) x = w2[((size_t)sel * 96 + kk) * 2048 + col]; }
              else if (sel < 4) { if (kk >= 96 && kk < 192) x = a2[((size_t)(sel - 2) * 96 + (kk - 96)) * 2048 + col]; }
              else x = g2[(size_t)kk * 2048 + col];
              v[e] = x; }
          ((GAS unsigned*)WL)[i] = pkbf(v[0], v[1]); } }
    { const int n8 = B_LAT * 256 * 2048 / 8;
      for (int i = gt; i < 2 * n8; i += NGT) { const bool isk = i < n8; const int j = isk ? i : i - n8; const float* src = (isk ? A.in[I_CK] : A.in[I_CV]) + (size_t)j * 8;
          const f32x4 a = *(const GAS f32x4*)src, b = *(const GAS f32x4*)(src + 4); v4u o; o.x = pkbf(a.x, a.y); o.y = pkbf(a.z, a.w); o.z = pkbf(b.x, b.y); o.w = pkbf(b.z, b.w);
          *((GAS v4u*)(ws + (isk ? WS_CK : WS_CV)) + j) = o; } }
    { LAS float* sc = (LAS float*)(F.lds + RING_OFF); LAS float* red = sc + 9 * 512; const float* wm = A.in[I_WMOD]; float* MODP = (float*)(ws + WS_MODP);
      for (int it = F.vcu; it < 96 * 8; it += F.G) { const int cb = it % 96, ks = it / 96;
          for (int idx = F.tid; idx < 9 * 512; idx += NWAVES * 64) { const int j = idx >> 9, kk = idx & 511, k = ks * 512 + kk; const float c = j == 0 ? A.in[I_CCTX][k] : A.in[I_C][(size_t)(j - 1) * DM + k]; sc[idx] = c * sigm(c); }
          __syncthreads();
          f32x4 acc[9];
#pragma unroll
          for (int j = 0; j < 9; ++j) acc[j] = (f32x4){0.f, 0.f, 0.f, 0.f};
          const float* wp = wm + (size_t)(ks * 512 + F.wave * 64) * NMOD + cb * 256 + F.lane * 4;
#pragma unroll 8
          for (int r = 0; r < 64; ++r) { const f32x4 w4 = *(const GAS f32x4*)(wp + (size_t)r * NMOD); const int kk = F.wave * 64 + r;
#pragma unroll
              for (int j = 0; j < 9; ++j) acc[j] += w4 * sc[j * 512 + kk]; }
#pragma unroll
          for (int j = 0; j < 9; ++j) *(LAS f32x4*)(red + (F.wave * 9 + j) * 256 + F.lane * 4) = acc[j];
          __syncthreads();
          for (int idx = F.tid; idx < 9 * 256; idx += NWAVES * 64) { const int j = idx >> 8, c = idx & 255; float s = 0.f;
#pragma unroll
              for (int w = 0; w < 8; ++w) s += red[(w * 9 + j) * 256 + c];
              MODP[((size_t)ks * 9 + j) * NMOD + cb * 256 + c] = s; }
          __syncthreads(); } }
}
__device__ __forceinline__ void p0b_mod_finalize(Frame& F, const Args& A) {
    const int gt = (F.vcu * NWAVES + F.wave) * 64 + F.lane, NGT = F.G * NWAVES * 64; const float* MODP = (const float*)(F.ws + WS_MODP); float* MOD = (float*)(F.ws + WS_MOD);
    for (int i = gt; i < 9 * NMOD; i += NGT) { const int n = i % NMOD; float s = A.in[I_BMOD][n];
#pragma unroll
        for (int ks = 0; ks < 8; ++ks) s += MODP[(size_t)ks * 9 * NMOD + i];
        MOD[i] = s; }
}
template <bool XF16> __device__ __forceinline__ void modnorm_rows(Frame& F, const void* Xv, int M, const float* nw, int sh_off, int sc_off, int jbase, int rps, int jmul, bf16* H) {
    static_assert(!XF16, "fp16 rows: modnorm16_rows");
    const int gw = F.vcu * NWAVES + F.wave, NGW = F.G * NWAVES; const float* MOD = (const float*)(F.ws + WS_MOD);
    for (int row0 = 2 * gw; row0 < M; row0 += 2 * NGW) {
        f32x4 v[2][8][2]; float ss[2] = {0.f, 0.f};
#pragma unroll
        for (int q = 0; q < 2; ++q) { const float* xr = (const float*)Xv + (size_t)(row0 + q) * DM + F.lane * 8;
#pragma unroll
            for (int c = 0; c < 8; ++c) { v[q][c][0] = *(const GAS f32x4*)(xr + c * 512); v[q][c][1] = *(const GAS f32x4*)(xr + c * 512 + 4); } }
#pragma unroll
        for (int q = 0; q < 2; ++q)
#pragma unroll
            for (int c = 0; c < 8; ++c)
                ss[q] += (v[q][c][0].x * v[q][c][0].x + v[q][c][0].y * v[q][c][0].y) + (v[q][c][0].z * v[q][c][0].z + v[q][c][0].w * v[q][c][0].w) + (v[q][c][1].x * v[q][c][1].x + v[q][c][1].y * v[q][c][1].y) + (v[q][c][1].z * v[q][c][1].z + v[q][c][1].w * v[q][c][1].w);
        const float rstd[2] = {1.0f / sqrtf(wave_sum(ss[0]) * (1.0f / DM) + RMS_EPS), 1.0f / sqrtf(wave_sum(ss[1]) * (1.0f / DM) + RMS_EPS)};
        const float* mj = MOD + (size_t)(jbase + (row0 / rps) * jmul) * NMOD + F.lane * 8; bf16* hr = H + (size_t)row0 * DM + F.lane * 8;
#pragma unroll
        for (int c = 0; c < 8; ++c) { unsigned ow[2][4];
#pragma unroll
            for (int h = 0; h < 2; ++h) { const f32x4 w4 = *(const GAS f32x4*)(nw + F.lane * 8 + c * 512 + 4 * h), s4 = *(const GAS f32x4*)(mj + sc_off + c * 512 + 4 * h), b4 = *(const GAS f32x4*)(mj + sh_off + c * 512 + 4 * h);
                const f32x4 cf = w4 * (s4 + 1.0f);
#pragma unroll
                for (int q = 0; q < 2; ++q) { const f32x4 y = v[q][c][h] * rstd[q] * cf + b4; ow[q][2 * h] = pkbf(y.x, y.y); ow[q][2 * h + 1] = pkbf(y.z, y.w); } }
#pragma unroll
            for (int q = 0; q < 2; ++q) { v4u o; o.x = ow[q][0]; o.y = ow[q][1]; o.z = ow[q][2]; o.w = ow[q][3]; *(GAS v4u*)(hr + (size_t)q * DM + c * 512) = o; } }
    }
}
__device__ __forceinline__ void final_norm_rows(Frame& F, float* Y, int M, const float* nw) {
    const int gw = F.vcu * NWAVES + F.wave, NGW = F.G * NWAVES;
    for (int row0 = gw; row0 < M; row0 += 2 * NGW) {
        f32x4 v[2][8][2]; float ss[2] = {0.f, 0.f}; const bool two = row0 + NGW < M;
#pragma unroll
        for (int q = 0; q < 2; ++q) { const int row = q ? (two ? row0 + NGW : row0) : row0;
#pragma unroll
            for (int c = 0; c < 8; ++c) { const v4u h = *(const GAS v4u*)((const h16s*)(Y + (size_t)row * DM) + F.lane * 8 + c * 512); v[q][c][0] = pg8::h4lo(h.x, h.y); v[q][c][1] = pg8::h4lo(h.z, h.w); } }
#pragma unroll
        for (int q = 0; q < 2; ++q)
#pragma unroll
            for (int c = 0; c < 8; ++c)
                ss[q] += (v[q][c][0].x * v[q][c][0].x + v[q][c][0].y * v[q][c][0].y) + (v[q][c][0].z * v[q][c][0].z + v[q][c][0].w * v[q][c][0].w) + (v[q][c][1].x * v[q][c][1].x + v[q][c][1].y * v[q][c][1].y) + (v[q][c][1].z * v[q][c][1].z + v[q][c][1].w * v[q][c][1].w);
        const float rstd0 = 1.0f / sqrtf(wave_sum(ss[0]) * (1.0f / DM) + RMS_EPS), rstd1 = 1.0f / sqrtf(wave_sum(ss[1]) * (1.0f / DM) + RMS_EPS);
        asm volatile("s_waitcnt vmcnt(0)" ::: "memory");
#pragma unroll
        for (int q = 0; q < 2; ++q) { if (q == 1 && !two) break; float* xr = Y + (size_t)(row0 + q * NGW) * DM + F.lane * 8; const float rstd = q ? rstd1 : rstd0;
#pragma unroll
            for (int c = 0; c < 8; ++c)
#pragma unroll
                for (int h = 0; h < 2; ++h) { const f32x4 w4 = *(const GAS f32x4*)(nw + F.lane * 8 + c * 512 + 4 * h); *(GAS f32x4*)(xr + c * 512 + 4 * h) = v[q][c][h] * rstd * w4; } }
    }
}
#define SSQ4(V) (((V).x * (V).x + (V).y * (V).y) + ((V).z * (V).z + (V).w * (V).w))
__device__ __forceinline__ void rows2_load(v4u (&B)[2][8], const h16s* X, int r0, int NGW, int M, int lane) {
#pragma unroll
    for (int q = 0; q < 2; ++q) { const int row = min(r0 + q * NGW, M - 1);
#pragma unroll
        for (int c = 0; c < 8; ++c) B[q][c] = *(const GAS v4u*)(X + (size_t)row * 8192 + lane * 8 + c * 512); }
}
__device__ __forceinline__ void rows2_rstd(const v4u (&B)[2][8], float (&rstd)[2]) {
    float ss[2] = {0.f, 0.f};
#pragma unroll
    for (int q = 0; q < 2; ++q)
#pragma unroll
        for (int c = 0; c < 8; ++c) { const f32x4 a = pg8::h4lo(B[q][c].x, B[q][c].y), b = pg8::h4lo(B[q][c].z, B[q][c].w); ss[q] += SSQ4(a) + SSQ4(b); }
#pragma unroll
    for (int q = 0; q < 2; ++q) rstd[q] = 1.0f / sqrtf(wave_sum(ss[q]) * (1.0f / DM) + RMS_EPS);
}
__device__ __forceinline__ void modnorm16_store(Frame& F, const v4u (&B)[2][8], int r0, int M, const float* nw, int sh_off, int sc_off, int jbase, int rps, int jmul, bf16* H) {
    const float* MOD = (const float*)(F.ws + WS_MOD); float rstd[2]; rows2_rstd(B, rstd);
    if (r0 >= M) return;
    const float* mj = MOD + (size_t)(jbase + (r0 / rps) * jmul) * NMOD + F.lane * 8; bf16* hr = H + (size_t)r0 * DM + F.lane * 8;
#pragma unroll
    for (int c = 0; c < 8; ++c) { unsigned ow[2][4];
#pragma unroll
        for (int h = 0; h < 2; ++h) { const f32x4 w4 = *(const GAS f32x4*)(nw + F.lane * 8 + c * 512 + 4 * h), s4 = *(const GAS f32x4*)(mj + sc_off + c * 512 + 4 * h), b4 = *(const GAS f32x4*)(mj + sh_off + c * 512 + 4 * h);
            const f32x4 cf = w4 * (s4 + 1.0f);
#pragma unroll
            for (int q = 0; q < 2; ++q) { unsigned u0 = h ? B[q][c].z : B[q][c].x, u1 = h ? B[q][c].w : B[q][c].y; asm volatile("" : "+v"(u0), "+v"(u1));
                const f32x4 x = pg8::h4lo(u0, u1);
                const f32x4 y = x * rstd[q] * cf + b4; ow[q][2 * h] = pkbf(y.x, y.y); ow[q][2 * h + 1] = pkbf(y.z, y.w); } }
#pragma unroll
        for (int q = 0; q < 2; ++q) { v4u o; o.x = ow[q][0]; o.y = ow[q][1]; o.z = ow[q][2]; o.w = ow[q][3]; *(GAS v4u*)(hr + (size_t)q * DM + c * 512) = o; }
        if (c & 1) asm volatile("" ::: "memory"); }
}
__device__ __forceinline__ void modnorm16_rows(Frame& F, const h16s* X, int M, const float* nw, int sh_off, int sc_off, int jbase, int rps, int jmul, bf16* H) {
    const int gw = F.vcu * NWAVES + F.wave, NGW = F.G * NWAVES;
    if (2 * gw >= M) return;
    v4u A_[2][8], B_[2][8]; rows2_load(A_, X, 2 * gw, 1, M, F.lane);
    for (int r0 = 2 * gw; r0 < M; r0 += 4 * NGW) {
        rows2_load(B_, X, r0 + 2 * NGW, 1, M, F.lane);
        modnorm16_store(F, A_, r0, M, nw, sh_off, sc_off, jbase, rps, jmul, H);
        if (r0 + 2 * NGW >= M) break;
        rows2_load(A_, X, r0 + 4 * NGW, 1, M, F.lane);
        modnorm16_store(F, B_, r0 + 2 * NGW, M, nw, sh_off, sc_off, jbase, rps, jmul, H);
    }
}
__device__ __forceinline__ void final16_store(Frame& F, const v4u (&B)[2][8], int r0, int M, float* Y, const float* nw) {
    float rstd[2]; rows2_rstd(B, rstd);
    if (r0 >= M) return;
    float* xr = Y + (size_t)r0 * DM + F.lane * 8;
#pragma unroll
    for (int c = 0; c < 8; ++c)
#pragma unroll
        for (int h = 0; h < 2; ++h) { const f32x4 w4 = *(const GAS f32x4*)(nw + F.lane * 8 + c * 512 + 4 * h);
#pragma unroll
            for (int q = 0; q < 2; ++q) { unsigned u0 = h ? B[q][c].z : B[q][c].x, u1 = h ? B[q][c].w : B[q][c].y; asm volatile("" : "+v"(u0), "+v"(u1));
                *(GAS f32x4*)(xr + (size_t)q * DM + c * 512 + 4 * h) = pg8::h4lo(u0, u1) * rstd[q] * w4; } }
}
__device__ __forceinline__ void final16_rows(Frame& F, float* Y, int M, const float* nw) {
    const int gw = F.vcu * NWAVES + F.wave, NGW = F.G * NWAVES; const h16s* X = (const h16s*)Y;
    if (2 * gw >= M) return;
    v4u A_[2][8], B_[2][8]; rows2_load(A_, X, 2 * gw, 1, M, F.lane);
    for (int r0 = 2 * gw; r0 < M; r0 += 4 * NGW) {
        rows2_load(B_, X, r0 + 2 * NGW, 1, M, F.lane);
        final16_store(F, A_, r0, M, Y, nw);
        if (r0 + 2 * NGW >= M) break;
        rows2_load(A_, X, r0 + 4 * NGW, 1, M, F.lane);
        final16_store(F, B_, r0 + 2 * NGW, M, Y, nw);
    }
}
namespace att {
constexpr float SCALE = 0.088388347648318440f, C = SCALE * 1.4426950408889634f;
constexpr int SHM_T = 16384;
constexpr int OFF_V = 0, OFF_K = 2 * SHM_T, OFF_WS = 4 * SHM_T, OFF_TAB = OFF_WS + 4096, OFF_ROW = OFF_TAB + 4096;
#define KSWZ(row, colB) ((row) * 256 + ((colB) ^ (((row) & 7) << 4)))
#define SBAR() __builtin_amdgcn_sched_barrier(0)
__device__ __forceinline__ int crow(int r, int hi) { return (r & 3) + 8 * (r >> 2) + 4 * hi; }
constexpr bool L0(int LV, int r) { return LV != 2 || r >= 12; }
constexpr bool L1(int LV, int r) { return LV != 1 || r < 4; }
template <int LV> __device__ __forceinline__ void partialSM(f32x16& p0, f32x16& p1, float& m_reg, float& mn, float& alpha) {
  float pmax = -3.0e38f;
#pragma unroll
  for (int r = 0; r < 16; ++r) if (L0(LV, r)) pmax = fmaxf(pmax, p0[r]);
#pragma unroll
  for (int r = 0; r < 16; ++r) if (L1(LV, r)) pmax = fmaxf(pmax, p1[r]);
  { auto rr = __builtin_amdgcn_permlane32_swap(__float_as_uint(pmax), __float_as_uint(pmax), false, false);
    pmax = fmaxf(__uint_as_float(rr[0]), __uint_as_float(rr[1])); }
  if (__all(pmax <= m_reg)) { mn = m_reg; alpha = 1.f; }
  else { mn = fmaxf(m_reg, pmax); alpha = __builtin_amdgcn_exp2f((m_reg - mn) * C); m_reg = mn; }
  const float mnC = -mn * C; typedef float f2_ __attribute__((ext_vector_type(2))); const f2_ C2 = {C, C}, M2 = {mnC, mnC};
#pragma unroll
  for (int r = 0; r < 16; r += 2) { if (L0(LV, r)) { const f2_ t = __builtin_elementwise_fma((f2_){p0[r], p0[r + 1]}, C2, M2); p0[r] = __builtin_amdgcn_exp2f(t.x); p0[r + 1] = __builtin_amdgcn_exp2f(t.y); } else { p0[r] = 0.f; p0[r + 1] = 0.f; } }
#pragma unroll
  for (int r = 0; r < 16; r += 2) { if (L1(LV, r)) { const f2_ t = __builtin_elementwise_fma((f2_){p1[r], p1[r + 1]}, C2, M2); p1[r] = __builtin_amdgcn_exp2f(t.x); p1[r + 1] = __builtin_amdgcn_exp2f(t.y); } else { p1[r] = 0.f; p1[r + 1] = 0.f; } }
}
template <int LV> __device__ __forceinline__ void finishSM(f32x16& p0, f32x16& p1, float alpha, float& l_reg, bf16x8& pa0, bf16x8& pa1, bf16x8& pa2, bf16x8& pa3) {
  typedef float f2_ __attribute__((ext_vector_type(2))); f2_ s2 = {0.f, 0.f};
#pragma unroll
  for (int r = 0; r < 16; r += 2) if (L0(LV, r)) s2 += (f2_){p0[r], p0[r + 1]};
#pragma unroll
  for (int r = 0; r < 16; r += 2) if (L1(LV, r)) s2 += (f2_){p1[r], p1[r + 1]};
  float ps = s2.x + s2.y;
  { auto rr = __builtin_amdgcn_permlane32_swap(__float_as_uint(ps), __float_as_uint(ps), false, false);
    ps = __uint_as_float(rr[0]) + __uint_as_float(rr[1]); }
  l_reg = l_reg * alpha + ps;
#define PK4(P, BASE, OUT) do { unsigned a0 = pkbf(P[BASE + 0], P[BASE + 1]), a1 = pkbf(P[BASE + 2], P[BASE + 3]);   \
    unsigned b0 = pkbf(P[BASE + 4], P[BASE + 5]), b1 = pkbf(P[BASE + 6], P[BASE + 7]);                              \
    auto r0 = __builtin_amdgcn_permlane32_swap(a0, b0, false, false); auto r1 = __builtin_amdgcn_permlane32_swap(a1, b1, false, false); \
    v4u w = {r0[0], r1[0], r0[1], r1[1]}; OUT = __builtin_bit_cast(bf16x8, w); } while (0)
  if (LV != 2) PK4(p0, 0, pa0); else pa0 = bf16x8{};
  PK4(p0, 8, pa1); PK4(p1, 0, pa2);
  if (LV != 1) PK4(p1, 8, pa3); else pa3 = bf16x8{};
#undef PK4
}
__device__ __forceinline__ void qkt(f32x16& p0, f32x16& p1, const LAS unsigned char* Ks, const bf16x8* qr, int r32, int hi) {
  p0 = f32x16{}; p1 = f32x16{};
#pragma unroll
  for (int d0 = 0; d0 < 8; ++d0) { const int cb = (d0 * 16 + hi * 8) * 2;
    const bf16x8 b0 = *(const LAS bf16x8*)(Ks + KSWZ(r32, cb));
    const bf16x8 b1 = *(const LAS bf16x8*)(Ks + KSWZ(32 + r32, cb));
    p0 = __builtin_amdgcn_mfma_f32_32x32x16_bf16(b0, qr[d0], p0, 0, 0, 0);
    p1 = __builtin_amdgcn_mfma_f32_32x32x16_bf16(b1, qr[d0], p1, 0, 0, 0); }
}
__device__ __forceinline__ int v_st(int k, int c) { const int kk = (k & ~0xC) | ((k & 4) << 1) | ((k & 8) >> 1); return ((kk >> 3) * 4 + (c >> 5)) * 512 + ((kk & 7) * 32 + (c & 31)) * 2; }
__device__ __forceinline__ int v_rd_base(int lane) { return ((lane & 3) << 3) | (((lane >> 2) & 3) << 6) | (((lane >> 4) & 1) << 5) | (((lane >> 5) & 1) << 8); }
constexpr int v_rd_off(int d0, int ks, int half) { return d0 * 512 + ks * 4096 + half * 2048; }
template <int OFF> __device__ __forceinline__ s16x4 tr_read(int vb) {
  s16x4 r; asm volatile("ds_read_b64_tr_b16 %0, %1 offset:%2" : "=&v"(r) : "v"(vb), "i"(OFF) : "memory"); return r;
}
template <int D0, int LV> __device__ __forceinline__ void pv_one(f32x16& od, int vb, bf16x8 pa0, bf16x8 pa1, bf16x8 pa2, bf16x8 pa3) {
  s16x4 l0 = {}, h0 = {}, l3 = {}, h3 = {};
  if (LV != 2) { l0 = tr_read<v_rd_off(D0, 0, 0)>(vb); h0 = tr_read<v_rd_off(D0, 0, 1)>(vb); }
  const s16x4 l1 = tr_read<v_rd_off(D0, 1, 0)>(vb), h1 = tr_read<v_rd_off(D0, 1, 1)>(vb), l2 = tr_read<v_rd_off(D0, 2, 0)>(vb), h2 = tr_read<v_rd_off(D0, 2, 1)>(vb);
  if (LV != 1) { l3 = tr_read<v_rd_off(D0, 3, 0)>(vb); h3 = tr_read<v_rd_off(D0, 3, 1)>(vb); }
  asm volatile("s_waitcnt lgkmcnt(0)" ::: "memory"); SBAR();
#define PK(L, H) (bf16x8){L[0], L[1], L[2], L[3], H[0], H[1], H[2], H[3]}
  if (LV != 2) od = __builtin_amdgcn_mfma_f32_32x32x16_bf16(pa0, PK(l0, h0), od, 0, 0, 0);
  od = __builtin_amdgcn_mfma_f32_32x32x16_bf16(pa1, PK(l1, h1), od, 0, 0, 0);
  od = __builtin_amdgcn_mfma_f32_32x32x16_bf16(pa2, PK(l2, h2), od, 0, 0, 0);
  if (LV != 1) od = __builtin_amdgcn_mfma_f32_32x32x16_bf16(pa3, PK(l3, h3), od, 0, 0, 0);
#undef PK
}
template <int LV> __device__ __forceinline__ void pv_d0(f32x16* o, int vb, bf16x8 pa0, bf16x8 pa1, bf16x8 pa2, bf16x8 pa3) {
  pv_one<0, LV>(o[0], vb, pa0, pa1, pa2, pa3); pv_one<1, LV>(o[1], vb, pa0, pa1, pa2, pa3); pv_one<2, LV>(o[2], vb, pa0, pa1, pa2, pa3); pv_one<3, LV>(o[3], vb, pa0, pa1, pa2, pa3);
}
template <int LV> __device__ __forceinline__ void attn_tile(const LAS unsigned char* Kt, int vb, const bf16x8* qr, f32x16* o, float& m_reg, float& l_reg, LAS float* al_l, int r32, int hi, const LAS unsigned char* rowb, const int (&off0)[16], const int (&off1)[16]) {
  f32x16 p0, p1; float mn, alpha; bf16x8 pa0, pa1, pa2, pa3;
  qkt(p0, p1, Kt, qr, r32, hi);
  if (LV != 0) {
#pragma unroll
    for (int r = 0; r < 16; ++r) { if (L0(LV, r)) p0[r] += *(const LAS float*)(rowb + off0[r]); if (L1(LV, r)) p1[r] += *(const LAS float*)(rowb + off1[r]); } }
  partialSM<LV>(p0, p1, m_reg, mn, alpha);
  if (__any(alpha < 1.f)) { if (hi == 0) al_l[r32] = alpha; asm volatile("s_waitcnt lgkmcnt(0)" ::: "memory");
#pragma unroll
    for (int d = 0; d < 4; ++d)
#pragma unroll
      for (int r = 0; r < 16; ++r) o[d][r] *= al_l[crow(r, hi)]; }
  finishSM<LV>(p0, p1, alpha, l_reg, pa0, pa1, pa2, pa3); SBAR();
  pv_d0<LV>(o, vb, pa0, pa1, pa2, pa3);
}
__device__ __forceinline__ void attn_unit(LAS unsigned char* lds, const bf16* Qb, bf16* Ob, const bf16* Kl, const bf16* Vl, int ntl, int rho0, int r0, const bf16* Kc, const bf16* Vc, const float* rpb) {
  int tid_ = threadIdx.x; asm volatile("" : "+v"(tid_));
  const int tid = tid_, wid = __builtin_amdgcn_readfirstlane(tid >> 6), lane = tid & 63, r32 = lane & 31, hi = lane >> 5;
  LAS unsigned char* V_lds = lds + OFF_V; LAS unsigned char* K_lds = lds + OFF_K;
  LAS float* wsf = (LAS float*)(lds + OFF_WS) + wid * 64; LAS float* li_l = wsf; LAS float* al_l = wsf + 32;
  LAS float* tab = (LAS float*)(lds + OFF_TAB);
  if (ntl > 0) { for (int i = tid; i < 15 * 31; i += NWAVES * 64) tab[i] = rpb[i] * (1.0f / SCALE); }
  float m_reg = -1e30f, l_reg = 0.f; f32x16 o[4] = {}; bf16x8 qr[8];
  { const bf16* Qw = Qb + (size_t)(wid * 32 + r32) * 2048 + hi * 8;
#pragma unroll
    for (int d0 = 0; d0 < 8; ++d0) qr[d0] = *(const GAS bf16x8*)(Qw + d0 * 16); }
  const int rq = r0 + (wid >> 1), cq = 32 * (wid & 1) + r32;
  const int rs = min(max(rq - 4, 0), 56), cs = min(max(cq - 8, 0), 48);
  LAS unsigned char* rowb = lds + OFF_ROW + wid * 128;
  int off0[16], off1[16];
#pragma unroll
  for (int r = 0; r < 16; ++r) { const int kap = (r & 3) + 8 * (r >> 2) + 4 * hi; off0[r] = ((unsigned)(kap - cs) < 16u) ? (kap - cq + 15) * 4 : 124; off1[r] = ((unsigned)(kap + 32 - cs) < 16u) ? (kap + 32 - cq + 15) * 4 : 124; }
  const int sr = tid >> 4, sc = (tid & 15) * 8, vst0 = v_st(sr, sc), vst1 = v_st(32 + sr, sc), kst0 = KSWZ(sr, sc * 2), kst1 = KSWZ(32 + sr, sc * 2);
  const int vb0 = (int)(unsigned)(uintptr_t)V_lds + v_rd_base(lane);
  const int NT = ntl + 4;
  bf16x8 sv0, sv1, sk0, sk1;
#define SLOAD(t) do { const bf16* kp = ((t) < ntl) ? Kl + (size_t)(t) * 64 * 2048 : Kc + (size_t)((t) - ntl) * 64 * 2048; const bf16* vp = ((t) < ntl) ? Vl + (size_t)(t) * 64 * 2048 : Vc + (size_t)((t) - ntl) * 64 * 2048; \
    sv0 = *(const GAS bf16x8*)(vp + (size_t)sr * 2048 + sc); sv1 = *(const GAS bf16x8*)(vp + (size_t)(32 + sr) * 2048 + sc); sk0 = *(const GAS bf16x8*)(kp + (size_t)sr * 2048 + sc); sk1 = *(const GAS bf16x8*)(kp + (size_t)(32 + sr) * 2048 + sc); } while (0)
#define SWRITE(b) do { *(LAS bf16x8*)(V_lds + (b) * SHM_T + vst0) = sv0; *(LAS bf16x8*)(V_lds + (b) * SHM_T + vst1) = sv1; *(LAS bf16x8*)(K_lds + (b) * SHM_T + kst0) = sk0; *(LAS bf16x8*)(K_lds + (b) * SHM_T + kst1) = sk1; } while (0)
  SLOAD(0); SWRITE(0); __syncthreads();
#define TILE_STEP(LV_, t) do { const int b = (t) & 1; if ((t) + 1 < NT) SLOAD((t) + 1); \
    const int rho = rho0 + (t); const bool need = (LV_ == 0) || (rho >= rs && rho < rs + 8); \
    if (need) { if (LV_ != 0) { if (lane < 32) ((LAS float*)rowb)[lane] = lane < 31 ? tab[(rho - rq + 7) * 31 + lane] : -1e30f; } attn_tile<LV_>(K_lds + b * SHM_T, vb0 + b * SHM_T, qr, o, m_reg, l_reg, al_l, r32, hi, rowb, off0, off1); } \
    if ((t) + 1 < NT) SWRITE(b ^ 1); __syncthreads(); } while (0)
  if (wid & 1) { for (int t = 0; t < ntl; ++t) TILE_STEP(2, t); }
  else { for (int t = 0; t < ntl; ++t) TILE_STEP(1, t); }
  for (int t = ntl; t < NT; ++t) TILE_STEP(0, t);
#undef TILE_STEP
#undef SLOAD
#undef SWRITE
  if (hi == 0) li_l[r32] = l_reg; asm volatile("s_waitcnt lgkmcnt(0)" ::: "memory");
  float rli[16];
#pragma unroll
  for (int r = 0; r < 16; ++r) rli[r] = __builtin_amdgcn_rcpf(li_l[crow(r, hi)]);
  bf16* Ow = Ob + (size_t)(wid * 32) * 2048;
#pragma unroll
  for (int r = 0; r < 16; ++r) { const int orow = crow(r, hi);
#pragma unroll
    for (int d0 = 0; d0 < 4; ++d0) { const unsigned w = pkbf(o[d0][r] * rli[r], 0.f); Ow[(size_t)orow * 2048 + d0 * 32 + r32] = (bf16)(w & 0xffffu); } }
}
#undef KSWZ
#undef SBAR
}
__device__ __forceinline__ float sum8(float v) { v += __shfl_xor(v, 1); v += __shfl_xor(v, 2); v += __shfl_xor(v, 4); return v; }
__device__ __forceinline__ void rwkv_prep(Frame& F, const Args& A, const h16s* PR, int prow0, int Ms, int L, h16s* RS, h16s* KS, h16s* VS, h16s* KK, bf16* LA) {
    const int gw = F.vcu * NWAVES + F.wave, NGW = F.G * NWAVES; const float* mu = A.in[I_MU]; const float* k_k = A.in[I_KK];
    for (int s0 = 2 * gw; s0 < Ms; s0 += 2 * NGW) {
        const int t = s0 % L; const bool hp = t > 0, hn = t + 2 < L;
        const h16s* pc = PR + (size_t)(prow0 + s0) * C_RWKV_P + F.lane * 8;
#pragma unroll 4
        for (int c = 0; c < 13; ++c) {
            const int col = c * 512 + F.lane * 8; const v4u z4 = {0u, 0u, 0u, 0u};
            const v4u w0 = hp ? *(const GAS v4u*)(pc + c * 512 - C_RWKV_P) : z4, w1 = *(const GAS v4u*)(pc + c * 512), w2 = *(const GAS v4u*)(pc + c * 512 + C_RWKV_P), w3 = hn ? *(const GAS v4u*)(pc + c * 512 + 2 * C_RWKV_P) : z4;
            float x0[8], x1[8], x2[8], x3[8], m[8]; unpack_h8(w0, x0); unpack_h8(w1, x1); unpack_h8(w2, x2); unpack_h8(w3, x3);
            if (col < C_RWKV) { const f32x4 m0 = *(const GAS f32x4*)(mu + col), m1 = *(const GAS f32x4*)(mu + col + 4); m[0] = m0.x; m[1] = m0.y; m[2] = m0.z; m[3] = m0.w; m[4] = m1.x; m[5] = m1.y; m[6] = m1.z; m[7] = m1.w; }
            else {
#pragma unroll
                for (int e = 0; e < 8; ++e) m[e] = 0.f; }
#pragma unroll
            for (int q = 0; q < 2; ++q) { const int s = s0 + q;
                float x[8];
#pragma unroll
                for (int e = 0; e < 8; ++e) { const float xc = q ? x2[e] : x1[e], xp = q ? x1[e] : x0[e], xn = q ? x3[e] : x2[e]; x[e] = xc + m[e] * (0.5f * (xp + xn) - xc); }
                if (c < 12) {
                    v4u o; o.x = pkh(x[0], x[1]); o.y = pkh(x[2], x[3]); o.z = pkh(x[4], x[5]); o.w = pkh(x[6], x[7]);
                    h16s* dst = (c < 4 ? RS : c < 8 ? KS : VS) + (size_t)s * D_RW + (c & 3) * 512 + F.lane * 8;
                    *(GAS v4u*)dst = o;
                    if (c >= 4 && c < 8) { const int kc = (c - 4) * 512 + F.lane * 8; const f32x4 q0 = *(const GAS f32x4*)(k_k + kc), q1 = *(const GAS f32x4*)(k_k + kc + 4);
                        float y[8] = {x[0] * q0.x, x[1] * q0.y, x[2] * q0.z, x[3] * q0.w, x[4] * q1.x, x[5] * q1.y, x[6] * q1.z, x[7] * q1.w}; float ss = 0.f;
    #pragma unroll
                        for (int e = 0; e < 8; ++e) ss += y[e] * y[e];
                        ss = sum8(ss); const float inv = 1.0f / fmaxf(sqrtf(ss), 1e-12f);
                        v4u ko; ko.x = pkh(y[0] * inv, y[1] * inv); ko.y = pkh(y[2] * inv, y[3] * inv); ko.z = pkh(y[4] * inv, y[5] * inv); ko.w = pkh(y[6] * inv, y[7] * inv);
                        *(GAS v4u*)(KK + (size_t)s * D_RW + kc) = ko; }
                } else {
                    float y[8];
    #pragma unroll
                    for (int e = 0; e < 8; ++e) { const int j = F.lane * 8 + e; const float v = x[e];
                        const float th = 1.0f - 2.0f * __builtin_amdgcn_rcpf(1.0f + __builtin_amdgcn_exp2f(2.8853900817779268f * v));
                        y[e] = j < 96 ? th : j < 192 ? v : j < 448 ? sigm(v) : 0.f; }
                    v4u o; o.x = pkbf(y[0], y[1]); o.y = pkbf(y[2], y[3]); o.z = pkbf(y[4], y[5]); o.w = pkbf(y[6], y[7]);
                    if (F.lane < 24) *(GAS v4u*)(LA + (size_t)s * 256 + F.lane * 8) = o;
                    else if (F.lane < 56) *(GAS v4u*)(LA + (size_t)Ms * 256 + (size_t)s * 256 + (F.lane - 24) * 8) = o;
                    else *(GAS v4u*)(LA + (size_t)s * 256 + 192 + (F.lane - 56) * 8) = (v4u){0u, 0u, 0u, 0u};
                }
            }
        }
    }
}
typedef float f32x2 __attribute__((ext_vector_type(2)));
__device__ __forceinline__ float dpp_xor1(float x) { return __builtin_bit_cast(float, __builtin_amdgcn_update_dpp(0, __builtin_bit_cast(int, x), 0xB1, 0xf, 0xf, true)); }
__device__ __forceinline__ float dpp_xor2(float x) { return __builtin_bit_cast(float, __builtin_amdgcn_update_dpp(0, __builtin_bit_cast(int, x), 0x4E, 0xf, 0xf, true)); }
__device__ __forceinline__ float dpp_hmir(float x) { return __builtin_bit_cast(float, __builtin_amdgcn_update_dpp(0, __builtin_bit_cast(int, x), 0x141, 0xf, 0xf, true)); }
__device__ __forceinline__ float red8(float x) { x += dpp_xor1(x); x += dpp_xor2(x); x += dpp_hmir(x); return x; }
__device__ __forceinline__ float dpp_shr1(float x) { return __builtin_bit_cast(float, __builtin_amdgcn_update_dpp(__builtin_bit_cast(int, x), __builtin_bit_cast(int, x), 0x111, 0xf, 0xf, false)); }
__device__ __forceinline__ float dpp_shr2(float x) { return __builtin_bit_cast(float, __builtin_amdgcn_update_dpp(__builtin_bit_cast(int, x), __builtin_bit_cast(int, x), 0x112, 0xf, 0xf, false)); }
__device__ __forceinline__ float dpp_shr4(float x) { return __builtin_bit_cast(float, __builtin_amdgcn_update_dpp(__builtin_bit_cast(int, x), __builtin_bit_cast(int, x), 0x114, 0xf, 0xf, false)); }
constexpr int SC_U = 8, SC_STEP = 5 * 64, SC_OPS_F = SC_U * SC_STEP, SC_GAM_F = 64, SC_Y_F = SC_U * 512, SC_SLOT_F = 2 * SC_OPS_F + 2 * SC_GAM_F + 2 * SC_Y_F;
static_assert(2 * SC_SLOT_F * 4 <= RING_BYTES, "scan LDS");
struct ScanOps { f32x4 kk[2], bb[2], kd[2], r[2]; f32x2 v; };
__device__ __forceinline__ void scan_ld(ScanOps& o, const LAS float* ob, int kq, int v0) {
#pragma unroll
    for (int j = 0; j < 2; ++j) { o.kk[j] = *(const LAS f32x4*)(ob + 0 * 64 + kq * 8 + 4 * j); o.bb[j] = *(const LAS f32x4*)(ob + 1 * 64 + kq * 8 + 4 * j);
        o.kd[j] = *(const LAS f32x4*)(ob + 2 * 64 + kq * 8 + 4 * j); o.r[j] = *(const LAS f32x4*)(ob + 3 * 64 + kq * 8 + 4 * j); }
    o.v = *(const LAS f32x2*)(ob + 4 * 64 + v0);
}
__device__ __forceinline__ f32x2 lo2(f32x4 a) { return (f32x2){a.x, a.y}; }
__device__ __forceinline__ f32x2 hi2(f32x4 a) { return (f32x2){a.z, a.w}; }
__device__ __forceinline__ f32x2 h2x2(unsigned u) { typedef _Float16 hh2 __attribute__((ext_vector_type(2))); const hh2 h = __builtin_bit_cast(hh2, u); return (f32x2){(float)h.x, (float)h.y}; }
__device__ __forceinline__ f32x2 fma2(f32x2 a, f32x2 b, f32x2 c) { return __builtin_elementwise_fma(a, b, c); }
__device__ __forceinline__ f32x2 dot8(const f32x2 (&S)[4], const f32x4 (&x)[2]) { f32x2 p = S[0] * lo2(x[0]); p = fma2(S[1], hi2(x[0]), p); p = fma2(S[2], lo2(x[1]), p); p = fma2(S[3], hi2(x[1]), p); return p; }
__device__ __forceinline__ void rwkv_scan(Frame& F, const Args& A, int nseq, int L, int seq0_global, bool has_state, const h16s* RS, const h16s* KS, const h16s* VS, const h16s* KK,
                                          const h16s* DF, const h16s* DB, const h16s* AF, const h16s* AB, h16s* YF, h16s* YB, float* out_sf, float* out_sb) {
    const int nchains = nseq * NH_R * 2, nslots = nchains >= 2 * F.G ? 2 : 1; const int lane = F.lane, cs = F.wave >> 2, wq = F.wave & 3, kq = lane & 7, v0 = 16 * wq + 2 * (lane >> 3);
    const int ft = F.tid & 255, su = ft & 7, kp = ft >> 3;
    LAS float* const sl = (LAS float*)(F.lds + RING_OFF) + cs * SC_SLOT_F;
    const float* k_a = A.in[I_KA]; const int NC = L / SC_U;
    for (int it = 0; (it * F.G + F.vcu) * nslots < nchains; ++it) {
        const int chain = (it * F.G + F.vcu) * nslots + cs; const bool active = cs < nslots && chain < nchains;
        const int dir = chain & 1, head = (chain >> 1) & 31, seq = chain >> 6;
        const h16s* Dd = dir ? DB : DF; const h16s* Ad = dir ? AB : AF; h16s* Yd = dir ? YB : YF;
        const int colp = head * 64 + 2 * kp;
        f32x2 ka2 = (f32x2){0.f, 0.f}; if (active) ka2 = *(const GAS f32x2*)(k_a + colp); const f32x2 oka2 = (f32x2){1.0f - ka2.x, 1.0f - ka2.y};
        f32x2 Sa[4], Sb[4];
#pragma unroll
        for (int j = 0; j < 4; ++j) { Sa[j] = (f32x2){0.f, 0.f}; Sb[j] = (f32x2){0.f, 0.f}; }
        const size_t soff = (((size_t)(seq0_global + seq) * NH_R + head) * 64 + v0) * 64 + 8 * kq;
        if (active && has_state) { const float* sp = (dir ? A.in[I_SB] : A.in[I_SF]) + soff; const f32x4 a = *(const GAS f32x4*)sp, b = *(const GAS f32x4*)(sp + 4), c = *(const GAS f32x4*)(sp + 64), d = *(const GAS f32x4*)(sp + 68);
            Sa[0] = lo2(a); Sa[1] = hi2(a); Sa[2] = lo2(b); Sa[3] = hi2(b); Sb[0] = lo2(c); Sb[1] = hi2(c); Sb[2] = lo2(d); Sb[3] = hi2(d); }
        const int row0 = seq * L; const int tstart = dir ? L - 1 : 0, tstep = dir ? -1 : 1;
        struct Raw { unsigned r, k, kk, w, a, v; };
        Raw gA = {0, 0, 0, 0, 0, 0}, gB = {0, 0, 0, 0, 0, 0};
#define SC_GLOAD(g, c) do { const size_t ro = (size_t)(row0 + tstart + ((c) * SC_U + su) * tstep) * D_RW + colp; g.r = *(const GAS unsigned*)(RS + ro); g.k = *(const GAS unsigned*)(KS + ro); g.kk = *(const GAS unsigned*)(KK + ro); \
            g.w = *(const GAS unsigned*)(Dd + ro); g.a = *(const GAS unsigned*)(Ad + ro); g.v = *(const GAS unsigned*)(VS + ro); } while (0)
        f32x2 f_r, f_kk, f_v, f_kd, f_bb, f_gi, f_t, f_inv;
#define SC_F0(g) do { const f32x2 k2 = h2x2(g.k), a2 = h2x2(g.a); f_r = h2x2(g.r); f_kk = h2x2(g.kk); f_v = h2x2(g.v); f_gi = h2x2(g.w); f_kd = k2 * (a2 * ka2 + oka2); f_bb = f_kk * a2; \
            f_t.x = dpp_shr1(f_gi.x); f_t.y = dpp_shr1(f_gi.y); } while (0)
#define SC_F1() do { if (su >= 1) f_gi *= f_t; f_t.x = dpp_shr2(f_gi.x); f_t.y = dpp_shr2(f_gi.y); } while (0)
#define SC_F2() do { if (su >= 2) f_gi *= f_t; f_t.x = dpp_shr4(f_gi.x); f_t.y = dpp_shr4(f_gi.y); } while (0)
#define SC_F3() do { if (su >= 4) f_gi *= f_t; f_t.x = dpp_shr1(f_gi.x); f_t.y = dpp_shr1(f_gi.y); f_inv = (f32x2){__builtin_amdgcn_rcpf(f_gi.x), __builtin_amdgcn_rcpf(f_gi.y)}; } while (0)
#define SC_F4(b) do { const f32x2 ge = su >= 1 ? f_t : (f32x2){1.0f, 1.0f}; \
            LAS float* ob = sl + (b) * SC_OPS_F + su * SC_STEP + 2 * kp; *(LAS f32x2*)(ob) = ge * f_kk; *(LAS f32x2*)(ob + 64) = f_bb * f_inv; *(LAS f32x2*)(ob + 128) = f_kd * f_inv; *(LAS f32x2*)(ob + 192) = f_gi * f_r; *(LAS f32x2*)(ob + 256) = f_v; \
            if (su == SC_U - 1) *(LAS f32x2*)(sl + 2 * SC_OPS_F + (b) * SC_GAM_F + 2 * kp) = f_gi; } while (0)
#define SC_YSTORE(bb_, c_) do { const LAS f32x4* yp = (const LAS f32x4*)(sl + 2 * SC_OPS_F + 2 * SC_GAM_F + (bb_) * SC_Y_F + (su * 64 + 2 * kp) * 8); const f32x4 a0 = yp[0], a1 = yp[1], b0 = yp[2], b1 = yp[3]; \
            const float y0 = ((a0.x + a0.z) + (a1.x + a1.z)) + ((b0.x + b0.z) + (b1.x + b1.z)), y1 = ((a0.y + a0.w) + (a1.y + a1.w)) + ((b0.y + b0.w) + (b1.y + b1.w)); \
            *(GAS unsigned*)(Yd + (size_t)(row0 + tstart + ((c_) * SC_U + su) * tstep) * D_RW + colp) = pkh(y0, y1); } while (0)
        __syncthreads();
        if (active) { SC_GLOAD(gA, 0); SC_F0(gA); SC_F1(); SC_F2(); SC_F3(); SC_F4(0); if (NC > 1) SC_GLOAD(gA, 1); }
        __syncthreads();
        for (int c = 0; c < NC; ++c) {
            const int b = c & 1;
            LAS float* yst = sl + 2 * SC_OPS_F + 2 * SC_GAM_F + b * SC_Y_F;
            if (active) {
                const bool fill = c + 1 < NC;
                if (c + 2 < NC) SC_GLOAD(gB, c + 2);
                const LAS float* ops = sl + b * SC_OPS_F;
                ScanOps cur, nxt; scan_ld(cur, ops, kq, v0);
                f32x2 pa = dot8(Sa, cur.kk), pb = dot8(Sb, cur.kk);
#define SC_STEP_(s) do { \
                    if ((s) + 1 < SC_U) scan_ld(nxt, ops + ((s) + 1) * SC_STEP, kq, v0); \
                    const f32x2 vA = (f32x2){cur.v.x, cur.v.x}, vB = (f32x2){cur.v.y, cur.v.y}; \
                    float ra = pa.x + pa.y, rb = pb.x + pb.y; \
                    ra += dpp_xor1(ra); rb += dpp_xor1(rb); \
                    Sa[0] = fma2(vA, lo2(cur.kd[0]), Sa[0]); Sb[0] = fma2(vB, lo2(cur.kd[0]), Sb[0]); Sa[1] = fma2(vA, hi2(cur.kd[0]), Sa[1]); Sb[1] = fma2(vB, hi2(cur.kd[0]), Sb[1]); \
                    ra += dpp_xor2(ra); rb += dpp_xor2(rb); \
                    Sa[2] = fma2(vA, lo2(cur.kd[1]), Sa[2]); Sb[2] = fma2(vB, lo2(cur.kd[1]), Sb[2]); Sa[3] = fma2(vA, hi2(cur.kd[1]), Sa[3]); Sb[3] = fma2(vB, hi2(cur.kd[1]), Sb[3]); \
                    ra += dpp_hmir(ra); rb += dpp_hmir(rb); \
                    const f32x2 sA = (f32x2){-ra, -ra}, sB = (f32x2){-rb, -rb}; \
                    Sa[0] = fma2(sA, lo2(cur.bb[0]), Sa[0]); Sb[0] = fma2(sB, lo2(cur.bb[0]), Sb[0]); Sa[1] = fma2(sA, hi2(cur.bb[0]), Sa[1]); Sb[1] = fma2(sB, hi2(cur.bb[0]), Sb[1]); \
                    Sa[2] = fma2(sA, lo2(cur.bb[1]), Sa[2]); Sb[2] = fma2(sB, lo2(cur.bb[1]), Sb[2]); Sa[3] = fma2(sA, hi2(cur.bb[1]), Sa[3]); Sb[3] = fma2(sB, hi2(cur.bb[1]), Sb[3]); \
                    f32x2 ya = Sa[0] * lo2(cur.r[0]), yb = Sb[0] * lo2(cur.r[0]); \
                    if ((s) + 1 < SC_U) { pa = Sa[0] * lo2(nxt.kk[0]); pb = Sb[0] * lo2(nxt.kk[0]); } \
                    ya = fma2(Sa[1], hi2(cur.r[0]), ya); yb = fma2(Sb[1], hi2(cur.r[0]), yb); \
                    if ((s) + 1 < SC_U) { pa = fma2(Sa[1], hi2(nxt.kk[0]), pa); pb = fma2(Sb[1], hi2(nxt.kk[0]), pb); } \
                    ya = fma2(Sa[2], lo2(cur.r[1]), ya); yb = fma2(Sb[2], lo2(cur.r[1]), yb); \
                    if ((s) + 1 < SC_U) { pa = fma2(Sa[2], lo2(nxt.kk[1]), pa); pb = fma2(Sb[2], lo2(nxt.kk[1]), pb); } \
                    ya = fma2(Sa[3], hi2(cur.r[1]), ya); yb = fma2(Sb[3], hi2(cur.r[1]), yb); \
                    if ((s) + 1 < SC_U) { pa = fma2(Sa[3], hi2(nxt.kk[1]), pa); pb = fma2(Sb[3], hi2(nxt.kk[1]), pb); } \
                    *(LAS f32x2*)(yst + ((s) * 64 + v0) * 8 + 2 * kq) = (f32x2){ya.x + ya.y, yb.x + yb.y}; \
                    if ((s) + 1 < SC_U) cur = nxt; } while (0)
                SC_STEP_(0); SC_STEP_(1);
                if (c > 0) SC_YSTORE(b ^ 1, c - 1);
                if (fill) SC_F0(gA);
                SC_STEP_(2);
                if (fill) SC_F1();
                SC_STEP_(3);
                if (fill) SC_F2();
                SC_STEP_(4);
                if (fill) SC_F3();
                SC_STEP_(5);
                if (fill) SC_F4(b ^ 1);
                SC_STEP_(6); SC_STEP_(7);
#undef SC_STEP_
                { const LAS float* gp = sl + 2 * SC_OPS_F + b * SC_GAM_F + kq * 8; const f32x4 g0 = *(const LAS f32x4*)gp, g1 = *(const LAS f32x4*)(gp + 4);
                  Sa[0] *= lo2(g0); Sa[1] *= hi2(g0); Sa[2] *= lo2(g1); Sa[3] *= hi2(g1); Sb[0] *= lo2(g0); Sb[1] *= hi2(g0); Sb[2] *= lo2(g1); Sb[3] *= hi2(g1); }
                gA = gB;
            }
            __syncthreads();
        }
        if (active) SC_YSTORE((NC - 1) & 1, NC - 1);
#undef SC_GLOAD
#undef SC_F0
#undef SC_F1
#undef SC_F2
#undef SC_F3
#undef SC_F4
#undef SC_YSTORE
        if (active && out_sf) { float* dp = (dir ? out_sb : out_sf) + soff; *(GAS f32x4*)dp = (f32x4){Sa[0].x, Sa[0].y, Sa[1].x, Sa[1].y}; *(GAS f32x4*)(dp + 4) = (f32x4){Sa[2].x, Sa[2].y, Sa[3].x, Sa[3].y};
            *(GAS f32x4*)(dp + 64) = (f32x4){Sb[0].x, Sb[0].y, Sb[1].x, Sb[1].y}; *(GAS f32x4*)(dp + 68) = (f32x4){Sb[2].x, Sb[2].y, Sb[3].x, Sb[3].y}; }
    }
}
__device__ __forceinline__ void rwkv_post(Frame& F, const Args& A, int Ms, const h16s* RS, const h16s* KS, const h16s* VS, const h16s* AF, const h16s* AB, const h16s* LG, const h16s* YF, const h16s* YB, bf16* ORW  ) {
    const int gw = F.vcu * NWAVES + F.wave, NGW = F.G * NWAVES; const float *lnw = A.in[I_LNW], *lnb = A.in[I_LNB], *k_a = A.in[I_KA], *r_k = A.in[I_RK];
    for (int s = gw; s < Ms; s += NGW) {
#pragma unroll
        for (int c = 0; c < 4; ++c) { const int col = c * 512 + F.lane * 8; const size_t off = (size_t)s * D_RW + col;
            float yf[8], yb[8], r[8], k[8], v[8], af[8], ab[8], g[8], w[8], b[8], ka[8], rk[8];
            unpack_h8(*(const GAS v4u*)(YF + off), yf); unpack_h8(*(const GAS v4u*)(YB + off), yb); unpack_h8(*(const GAS v4u*)(RS + off), r); unpack_h8(*(const GAS v4u*)(KS + off), k);
            unpack_h8(*(const GAS v4u*)(VS + off), v); unpack_h8(*(const GAS v4u*)(AF + off), af); unpack_h8(*(const GAS v4u*)(AB + off), ab); unpack_h8(*(const GAS v4u*)(LG + off), g);
#pragma unroll
            for (int h = 0; h < 2; ++h) { const f32x4 a = *(const GAS f32x4*)(lnw + col + 4 * h), bb = *(const GAS f32x4*)(lnb + col + 4 * h), cc = *(const GAS f32x4*)(k_a + col + 4 * h), dd = *(const GAS f32x4*)(r_k + col + 4 * h);
                w[4 * h] = a.x; w[4 * h + 1] = a.y; w[4 * h + 2] = a.z; w[4 * h + 3] = a.w; b[4 * h] = bb.x; b[4 * h + 1] = bb.y; b[4 * h + 2] = bb.z; b[4 * h + 3] = bb.w;
                ka[4 * h] = cc.x; ka[4 * h + 1] = cc.y; ka[4 * h + 2] = cc.z; ka[4 * h + 3] = cc.w; rk[4 * h] = dd.x; rk[4 * h + 1] = dd.y; rk[4 * h + 2] = dd.z; rk[4 * h + 3] = dd.w; }
            float sf = 0.f, sb = 0.f, bf_ = 0.f, bb_ = 0.f;
#pragma unroll
            for (int e = 0; e < 8; ++e) { sf += yf[e]; sb += yb[e]; const float t = r[e] * k[e] * rk[e]; bf_ += t * (1.0f + (af[e] - 1.0f) * ka[e]); bb_ += t * (1.0f + (ab[e] - 1.0f) * ka[e]); }
            sf = sum8(sf) * (1.0f / 64.0f); sb = sum8(sb) * (1.0f / 64.0f); bf_ = sum8(bf_); bb_ = sum8(bb_);
            float qf = 0.f, qb = 0.f;
#pragma unroll
            for (int e = 0; e < 8; ++e) { yf[e] -= sf; yb[e] -= sb; qf += yf[e] * yf[e]; qb += yb[e] * yb[e]; }
            const float rf = 1.0f / sqrtf(sum8(qf) * (1.0f / 64.0f) + LNX_EPS), rb = 1.0f / sqrtf(sum8(qb) * (1.0f / 64.0f) + LNX_EPS);
            float o[8];
#pragma unroll
            for (int e = 0; e < 8; ++e) o[e] = ((yf[e] * rf + yb[e] * rb) * w[e] + 2.0f * b[e] + (bf_ + bb_) * v[e]) * g[e];
            v4u ow; ow.x = pkbf(o[0], o[1]); ow.y = pkbf(o[2], o[3]); ow.z = pkbf(o[4], o[5]); ow.w = pkbf(o[6], o[7]);
            *(GAS v4u*)(ORW + off) = ow; }
    }
}
__global__ void __launch_bounds__(NWAVES * 64, 2) fwd_kernel(Args args) {
    const Args& A = args;
    extern __shared__ __attribute__((aligned(16))) unsigned char lds[];
    Frame F;
    F.lds = (LAS unsigned char*)lds;
    F.MISC = (volatile LAS unsigned*)(F.lds + MISC_OFF);
    F.tid = threadIdx.x; F.lane = F.tid & 63; F.wave = __builtin_amdgcn_readfirstlane(F.tid >> 6);
    F.G = gridDim.x; { const int bx = blockIdx.x; F.vcu = (F.G % 8 == 0) ? (bx % 8) * (F.G / 8) + bx / 8 : bx; }
    F.ws = args.ws; F.out = args.out; F.ctl = (gu32*)(args.ws + WS_CTL);
    for (int u = F.tid; u < (LDS_BYTES - LDSCTL_OFF) / 4; u += NWAVES * 64) ((LAS unsigned*)(F.lds + LDSCTL_OFF))[u] = 0u;
    __syncthreads();
    XcdBarrier bar = xcd_barrier_post((unsigned*)(F.ctl + CW_BAR), F.MISC + 8);
#define GRID_BAR() xcd_barrier(bar)
    unsigned char* ws = args.ws;
    bf16* const H = (bf16*)(ws + WS_H); bf16* const Qb = (bf16*)(ws + WS_Q); bf16* const Kb = (bf16*)(ws + WS_K); bf16* const Vb = (bf16*)(ws + WS_V);
    h16s* const PR = (h16s*)(ws + WS_PR); bf16* const ORW = (bf16*)(ws + WS_ORW); bf16* const MID = (bf16*)(ws + WS_MID); bf16* const U = (bf16*)(ws + WS_U);
    const float* const MOD = (const float*)(ws + WS_MOD);

#ifndef PHMASK
#define PHMASK 0xffffffffu
#endif
#define PH(n) RELANE(); if constexpr ((PHMASK >> (n)) & 1u)
#define RELANE() do { int t_ = threadIdx.x; asm volatile("" : "+v"(t_)); F.tid = t_; F.lane = t_ & 63; } while (0)
    PH(0) p0_prologue(F, A); GRID_BAR();
    PH(1) p0b_mod_finalize(F, A); GRID_BAR();

    const bool flip = ((int)blockIdx.x & 2) != 0;
    int two = 2; asm volatile("" : "+s"(two));
    bf16* const HLAT = (bf16*)(ws + WS_HLAT);
    PH(2) modnorm_rows<false>(F, A.in[I_XP], T_CTX, A.in[I_N1], 0, DM, 0, L_CTX, 0, H); GRID_BAR();
    for (int g = 0; g < 2; ++g) {
        const int M = g ? T_LAT : T_CTX, L = g ? L_LAT : L_CTX, jbase = g, jmul = g, ppb = L / 256;
        const float* X = g ? A.in[I_XS] : A.in[I_XP]; float* Y = F.out + O_Y + (g ? (size_t)T_CTX * DM : 0); bf16* PG = (bf16*)Y;
        for (int ph = 0; ph < two; ++ph) {
          if ((ph == 0) != flip) {
            PH(3) { pg8::Gemm gm{g ? HLAT : H, (const bf16*)(ws + WS_WIN), M, N_IN_P, DM}; pg8::StaticOrder S; S.init(M, N_IN_P, F.G, (int)blockIdx.x);
              pg8::EpiProj E{Qb, Kb, Vb, PR, PG, g ? nullptr : F.out + O_NK, g ? nullptr : F.out + O_NV};
              pg8::gemm_phase<pg8::EpiProj, pg8::StaticOrder, true, true>(F.lds + RING_OFF, gm, S, E); }
            if (g == 0) { __syncthreads(); PH(16) { const int nextra = ((T_CTX / 256) * (N_IN_P / 256)) % F.G, bx = (int)blockIdx.x;
                  if (nextra == 0) late_weight_copies(F, A, bx, F.G); else if (bx >= nextra) late_weight_copies(F, A, bx - nextra, F.G - nextra); } }
          } else if (g == 1) { PH(15) final16_rows(F, F.out + O_Y, T_CTX, A.in[I_NF]); }
        }
        GRID_BAR();
        bf16* const Ob = Qb;
        const int nseq = g ? B_LAT : B_CTX;
        h16s *RS = (h16s*)(ws + WS_RS), *KS = (h16s*)(ws + WS_KS), *VS = (h16s*)(ws + WS_VS), *KKb = (h16s*)(ws + WS_KK), *DF = (h16s*)(ws + WS_DF), *DB = (h16s*)(ws + WS_DB), *AF = (h16s*)(ws + WS_AF), *AB = (h16s*)(ws + WS_AB);
        h16s *LG = (h16s*)(ws + WS_LG), *YF = (h16s*)(ws + WS_YF), *YB = (h16s*)(ws + (g ? WS_YB_LAT : WS_YB_CTX)); bf16* LA = (bf16*)(ws + WS_LA);
        for (int ph = 0; ph < two; ++ph) {
          if ((ph == 0) != flip) {
            PH(4) { if (g == 0) { for (int u = F.vcu; u < B_CTX * NH_A; u += F.G) { const int b = u >> 4, h = u & 15; const size_t base = (size_t)b * L_CTX * 2048 + h * 128;
                    att::attn_unit(F.lds + RING_OFF, Qb + base, Ob + base, Kb, Vb, 0, 0, 0, Kb + base, Vb + base, nullptr); } }
            else { const bf16* CK = (const bf16*)(ws + WS_CK); const bf16* CV = (const bf16*)(ws + WS_CV);
                for (int u = F.vcu; u < B_LAT * NH_A * 16; u += F.G) { const int rg = u & 15, h = (u >> 4) & 15, b = u >> 8; const int r0 = 4 * rg, rho0 = min(max(r0 - 4, 0), 56), rho1 = min(max(r0 - 1, 0), 56) + 8;
                    const size_t qbase = ((size_t)b * L_LAT + (size_t)rg * 256) * 2048 + h * 128, lbase = ((size_t)b * L_LAT + (size_t)rho0 * 64) * 2048 + h * 128, cbase = (size_t)b * 256 * 2048 + h * 128;
                    att::attn_unit(F.lds + RING_OFF, Qb + qbase, Ob + qbase, Kb + lbase, Vb + lbase, rho1 - rho0, rho0, r0, CK + cbase, CV + cbase, A.in[I_RPB] + h * 15 * 31); } } }
          } else { PH(5) rwkv_prep(F, A, PR, 0, M, L, RS, KS, VS, KKb, LA); }
        }
        GRID_BAR();
        {   int klora = 256; asm volatile("" : "+s"(klora));
            PH(6) { pg8::Gemm gm{LA, (const bf16*)(ws + WS_WLORA), M, 8192, klora}; pg8::StaticOrder S; S.init(M, 8192, F.G, (int)blockIdx.x);
              pg8::EpiLora E{{DF, DB, AF, AB, LG}, A.in[I_W0], A.in[I_A0], 0};
              pg8::gemm_phase<pg8::EpiLora, pg8::StaticOrder, true, true>(F.lds + RING_OFF, gm, S, E); }
            PH(6) { pg8::Gemm gm{LA + (size_t)M * 256, (const bf16*)(ws + WS_WLORA) + (size_t)8192 * 256, M, 2048, klora}; pg8::StaticOrder S; S.init(M, 2048, F.G, (int)blockIdx.x);
              pg8::EpiLora E{{DF, DB, AF, AB, LG}, A.in[I_W0], A.in[I_A0], 4};
              pg8::gemm_phase<pg8::EpiLora, pg8::StaticOrder, true, true>(F.lds + RING_OFF, gm, S, E); }
            GRID_BAR();
            PH(7) rwkv_scan(F, A, nseq, L, 0, g != 0, RS, KS, VS, KKb, DF, DB, AF, AB, YF, YB, g ? nullptr : F.out + O_SF, g ? nullptr : F.out + O_SB);
            GRID_BAR();
        }
        for (int ph = 0; ph < two; ++ph) {
          if ((ph == 0) != flip) {
            PH(9) { pg8::Gemm gm{Qb, (const bf16*)(ws + WS_WOA), M, DM, D_ATT}; pg8::StaticOrder S; S.init(M, DM, F.G, (int)blockIdx.x);
              pg8::EpiGate<false> E{MID, PG, 0};
              pg8::gemm_phase<pg8::EpiGate<false>, pg8::StaticOrder, true, true>(F.lds + RING_OFF, gm, S, E); }
          } else { PH(8) rwkv_post(F, A, M, RS, KS, VS, AF, AB, LG, YF, YB, ORW); }
        }
        GRID_BAR();
        PH(10) { pg8::Gemm gm{ORW, (const bf16*)(ws + WS_WOR), M, DM, D_RW}; pg8::StaticOrder S; S.init(M, DM, F.G, (int)blockIdx.x);
          pg8::EpiGate<true> E{MID, PG, DM};
          pg8::gemm_phase<pg8::EpiGate<true>, pg8::StaticOrder, true, true>(F.lds + RING_OFF, gm, S, E); }
        GRID_BAR();
        PH(11) { pg8::Gemm gm{MID, (const bf16*)(ws + WS_WOUT), M, DM, DM}; pg8::StaticOrder S; S.init(M, DM, F.G, (int)blockIdx.x);
          pg8::EpiResid<true> E{X, (bf16*)Y, MOD + 2 * DM, jbase, ppb, jmul};
          pg8::gemm_phase<pg8::EpiResid<true>, pg8::StaticOrder, true, true>(F.lds + RING_OFF, gm, S, E); }
        GRID_BAR();
        PH(12) modnorm16_rows(F, (const h16s*)Y, M, A.in[I_N2], 3 * DM, 4 * DM, jbase, L, jmul, H); GRID_BAR();
        PH(13) { pg8::Gemm gm{H, (const bf16*)(ws + WS_WM1), M, D_FF, DM}; pg8::StaticOrder S; S.init(M, D_FF, F.G, (int)blockIdx.x);
          pg8::EpiRelu2 E{U};
          pg8::gemm_phase<pg8::EpiRelu2, pg8::StaticOrder, true, true>(F.lds + RING_OFF, gm, S, E); }
        GRID_BAR();
        for (int ph = 0; ph < two; ++ph) {
          if ((ph == 0) != flip) {
            PH(14) { pg8::Gemm gm{U, (const bf16*)(ws + WS_WM2), M, DM, D_FF}; pg8::StaticOrder S; S.init(M, DM, F.G, (int)blockIdx.x);
              pg8::EpiResid<false> E{nullptr, (bf16*)Y, MOD + 5 * DM, jbase, ppb, jmul};
              pg8::gemm_phase<pg8::EpiResid<false>, pg8::StaticOrder, true, true>(F.lds + RING_OFF, gm, S, E); }
          } else if (g == 0) { PH(2) modnorm_rows<false>(F, A.in[I_XS], T_LAT, A.in[I_N1], 0, DM, 1, L_LAT, 1, HLAT); }
        }
        GRID_BAR();
        if (g == 1) { PH(15) final16_rows(F, Y, M, A.in[I_NF]); }
    }
#undef GRID_BAR
}

extern "C" void kernel_launch(void* const* d_in, const int* in_sizes, int n_in, void* d_out, int out_size, void* d_ws, size_t ws_size, hipStream_t stream) {
    static int grid = 0;
    if (grid == 0) {
        if (n_in != 31 || ws_size < WS_END) { fprintf(stderr, "kernel_launch: need 31 inputs and >= %zu bytes of workspace; got %d, %zu\n", (size_t)WS_END, n_in, ws_size); grid = -1; return; }
        int dev = 0, cus = 0, per_cu = 0;
        if (hipGetDevice(&dev) != hipSuccess || hipDeviceGetAttribute(&cus, hipDeviceAttributeMultiprocessorCount, dev) != hipSuccess) { grid = -1; return; }
        if (hipFuncSetAttribute((const void*)fwd_kernel, hipFuncAttributeMaxDynamicSharedMemorySize, LDS_BYTES) != hipSuccess) { fprintf(stderr, "kernel_launch: hipFuncSetAttribute failed\n"); grid = -1; return; }
        if (hipOccupancyMaxActiveBlocksPerMultiprocessor(&per_cu, (const void*)fwd_kernel, NWAVES * 64, LDS_BYTES) != hipSuccess || per_cu < 1) fprintf(stderr, "kernel_launch: occupancy query reports %d\n", per_cu);
        (void)hipGetLastError();
        grid = cus;
    }
    if (grid < 0) return;
    if (hipMemsetAsync((char*)d_ws + WS_CTL, 0, CTL_ZERO_BYTES, stream) != hipSuccess) return;
    Args a{};
    for (int i = 0; i < 31; ++i) a.in[i] = (const float*)d_in[i];
    a.out = (float*)d_out; a.ws = (unsigned char*)d_ws;
    hipLaunchKernelGGL(fwd_kernel, dim3(grid), dim3(NWAVES * 64), LDS_BYTES, stream, a);
    const hipError_t le = hipPeekAtLastError();
    if (le != hipSuccess) fprintf(stderr, "kernel_launch: launch failed: %s\n", hipGetErrorName(le));
}
```

```cpp
#include <hip/hip_runtime.h>
#include <cstdio>
#include <cstdint>
namespace pg8 {
#define PG8_LAS __attribute__((address_space(3)))
typedef unsigned short bf16_t;
typedef short bf16x8 __attribute__((ext_vector_type(8)));
typedef float f32x4 __attribute__((ext_vector_type(4)));
typedef unsigned u32x4 __attribute__((ext_vector_type(4)));
constexpr int BM = 256, BK = 64, HALF = 128, HTB = HALF * BK * 2  , STAGE_BYTES = 8 * HTB, NXCD = 8, WGM = 8;

__host__ __device__ __forceinline__ int lds_byte(int r, int c) { const int st = (r >> 4) * 2 + (c >> 5), rr = r & 15, cc = c & 31, ob = rr * 64 + cc * 2; return st * 1024 + (ob ^ (((ob >> 9) & 1) << 5)); }
__host__ __device__ __forceinline__ void stage_rc(int b, int& R, int& C) { const int st = b / 1024, sb = b % 1024, swz = sb ^ (((sb >> 9) & 1) << 5); R = (st >> 1) * 16 + swz / 64; C = (st & 1) * 32 + (swz % 64) / 2; }
__host__ __device__ __forceinline__ int perm32(int rho) { const int n = rho >> 4, i = rho & 15; return 8 * (i >> 2) + 4 * n + (i & 3); }

struct Unit { int pm, pn; };
struct Gemm { const bf16_t* A; const bf16_t* Bt; int M, N, K; };

struct StaticOrder {
    int nM, nN, nwg, G, c;
    __host__ __device__ void init(int M, int N, int G_, int c_) { nM = M / BM; nN = N / BM; nwg = nM * nN; G = G_; c = c_; }
    __host__ __device__ bool next(int i, Unit& u) const {
        const long L = (long)i * G + c; if (L >= nwg) return false;
        int wgid = (int)L; { const int q = nwg / NXCD, r = nwg % NXCD, xcd = wgid % NXCD, off = wgid / NXCD; wgid = (xcd < r ? xcd * (q + 1) : r * (q + 1) + (xcd - r) * q) + off; }
        const int nig = WGM * nN, gid = wgid / nig, fm = gid * WGM, gsz = (nM - fm) < WGM ? (nM - fm) : WGM;
        u.pm = fm + ((wgid % nig) % gsz); u.pn = (wgid % nig) / gsz; return true;
    }
    __device__ __forceinline__ void a_ready(const Unit&) const {}
    __device__ __forceinline__ void done(const Unit&) const {}
};

__device__ __forceinline__ unsigned cvt_pk_bf16(float lo, float hi) { unsigned r; asm volatile("v_cvt_pk_bf16_f32 %0, %1, %2" : "=v"(r) : "v"(lo), "v"(hi)); return r; }
typedef _Float16 h16x2 __attribute__((ext_vector_type(2)));
__device__ __forceinline__ unsigned cvt_pk_f16(float lo, float hi) { h16x2 v = {(_Float16)lo, (_Float16)hi}; return __builtin_bit_cast(unsigned, v); }
__device__ __forceinline__ float sigmoidf_(float x) { return __builtin_amdgcn_rcpf(1.0f + __builtin_amdgcn_exp2f(-1.4426950408889634f * x)); }
__device__ __forceinline__ float bf_lo(unsigned u) { return __builtin_bit_cast(float, u << 16); }
__device__ __forceinline__ float bf_hi(unsigned u) { return __builtin_bit_cast(float, u & 0xffff0000u); }

struct EpiProj {
    static constexpr bool PERM = true, AFTER_DRAIN = false;
    bf16_t *Q, *K, *V, *PR, *PG; float *NK, *NV;
    __device__ __forceinline__ void operator()(const f32x4 (&acc)[2][2][4][2], const Unit& u, int wr, int wc, int fr, int fq) const {
        const int row0 = u.pm * BM + wr * 64 + fr, pn = u.pn;
        bf16_t* base; int ld, colt, mode = 0; float* fb = nullptr;
        if (pn < 8) { base = Q; ld = 2048; colt = pn * 256; }
        else if (pn < 16) { base = K; ld = 2048; colt = (pn - 8) * 256; fb = NK; }
        else if (pn < 24) { base = V; ld = 2048; colt = (pn - 16) * 256; fb = NV; }
        else if (pn < 50) { base = PR; ld = 6656; colt = (pn - 24) * 256; mode = 1; }
        else { base = PG; ld = 8192; colt = (pn - 50) * 256; mode = 2; }
        const int col0 = colt + wc * 32 + 8 * fq;
#pragma unroll
        for (int ai = 0; ai < 2; ++ai)
#pragma unroll
            for (int m = 0; m < 4; ++m) { const size_t r = (size_t)(row0 + ai * HALF + m * 16); bf16_t* rowp = base + r * ld + col0;
#pragma unroll
                for (int bj = 0; bj < 2; ++bj) { f32x4 v0 = acc[ai][bj][m][0], v1 = acc[ai][bj][m][1]; u32x4 w;
                    if (mode == 2) { v0 = (f32x4){sigmoidf_(v0[0]), sigmoidf_(v0[1]), sigmoidf_(v0[2]), sigmoidf_(v0[3])}; v1 = (f32x4){sigmoidf_(v1[0]), sigmoidf_(v1[1]), sigmoidf_(v1[2]), sigmoidf_(v1[3])}; }
                    if (mode == 1) { w.x = cvt_pk_f16(v0[0], v0[1]); w.y = cvt_pk_f16(v0[2], v0[3]); w.z = cvt_pk_f16(v1[0], v1[1]); w.w = cvt_pk_f16(v1[2], v1[3]); }
                    else { w.x = cvt_pk_bf16(v0[0], v0[1]); w.y = cvt_pk_bf16(v0[2], v0[3]); w.z = cvt_pk_bf16(v1[0], v1[1]); w.w = cvt_pk_bf16(v1[2], v1[3]); }
                    *(u32x4*)(rowp + bj * HALF) = w;
                    if (fb) { float* fp = fb + r * 2048 + col0 + bj * HALF; *(f32x4*)fp = v0; *(f32x4*)(fp + 4) = v1; } } }
    }
};
struct EpiLora {
    static constexpr bool PERM = true, AFTER_DRAIN = false;
    bf16_t* OUT[5]; const float *w0, *a0; int selb;
    __device__ __forceinline__ void operator()(const f32x4 (&acc)[2][2][4][2], const Unit& u, int wr, int wc, int fr, int fq) const {
        const int row0 = u.pm * BM + wr * 64 + fr, sel = selb + (u.pn >> 3), colt = (u.pn & 7) * 256, col0 = colt + wc * 32 + 8 * fq;
        bf16_t* base = sel == 0 ? OUT[0] : sel == 1 ? OUT[1] : sel == 2 ? OUT[2] : sel == 3 ? OUT[3] : OUT[4];
        const float* bias = sel < 2 ? w0 + sel * 2048 : a0 + (sel - 2) * 2048;
        f32x4 bv[2][2];
#pragma unroll
        for (int bj = 0; bj < 2; ++bj)
#pragma unroll
            for (int n = 0; n < 2; ++n) bv[bj][n] = sel < 4 ? *(const f32x4*)(bias + col0 + bj * HALF + 4 * n) : (f32x4){0.f, 0.f, 0.f, 0.f};
#pragma unroll
        for (int ai = 0; ai < 2; ++ai)
#pragma unroll
            for (int m = 0; m < 4; ++m) { bf16_t* rowp = base + (size_t)(row0 + ai * HALF + m * 16) * 2048 + col0;
#pragma unroll
                for (int bj = 0; bj < 2; ++bj) { f32x4 v0 = acc[ai][bj][m][0] + bv[bj][0], v1 = acc[ai][bj][m][1] + bv[bj][1];
                    if (sel < 4) {
#pragma unroll
                        for (int e = 0; e < 4; ++e) { v0[e] = sigmoidf_(v0[e]); v1[e] = sigmoidf_(v1[e]); }
                        if (sel < 2) {
#pragma unroll
                            for (int e = 0; e < 4; ++e) { v0[e] = __builtin_amdgcn_exp2f(-0.87503716f * v0[e]); v1[e] = __builtin_amdgcn_exp2f(-0.87503716f * v1[e]); } } }
                    u32x4 w; w.x = cvt_pk_f16(v0[0], v0[1]); w.y = cvt_pk_f16(v0[2], v0[3]); w.z = cvt_pk_f16(v1[0], v1[1]); w.w = cvt_pk_f16(v1[2], v1[3]);
                    *(u32x4*)(rowp + bj * HALF) = w; } }
    }
};
template <bool ADD> struct EpiGate {
    static constexpr bool PERM = true, AFTER_DRAIN = false;
    bf16_t* O; const bf16_t* G; int goff;
    __device__ __forceinline__ void operator()(const f32x4 (&acc)[2][2][4][2], const Unit& u, int wr, int wc, int fr, int fq) const {
        const int row0 = u.pm * BM + wr * 64 + fr, col0 = u.pn * BM + wc * 32 + 8 * fq;
#pragma unroll
        for (int ai = 0; ai < 2; ++ai)
#pragma unroll
            for (int m = 0; m < 4; ++m) { const size_t r = (size_t)(row0 + ai * HALF + m * 16); bf16_t* rowp = O + r * 4096 + col0; const bf16_t* gp = G + r * 8192 + goff + col0;
#pragma unroll
                for (int bj = 0; bj < 2; ++bj) { const u32x4 g = *(const u32x4*)(gp + bj * HALF); const f32x4 a0 = acc[ai][bj][m][0], a1 = acc[ai][bj][m][1];
                    float o[8] = {a0[0] * bf_lo(g.x), a0[1] * bf_hi(g.x), a0[2] * bf_lo(g.y), a0[3] * bf_hi(g.y), a1[0] * bf_lo(g.z), a1[1] * bf_hi(g.z), a1[2] * bf_lo(g.w), a1[3] * bf_hi(g.w)};
                    if (ADD) { const u32x4 p = *(const u32x4*)(rowp + bj * HALF); o[0] += bf_lo(p.x); o[1] += bf_hi(p.x); o[2] += bf_lo(p.y); o[3] += bf_hi(p.y); o[4] += bf_lo(p.z); o[5] += bf_hi(p.z); o[6] += bf_lo(p.w); o[7] += bf_hi(p.w); }
                    u32x4 w; w.x = cvt_pk_bf16(o[0], o[1]); w.y = cvt_pk_bf16(o[2], o[3]); w.z = cvt_pk_bf16(o[4], o[5]); w.w = cvt_pk_bf16(o[6], o[7]);
                    *(u32x4*)(rowp + bj * HALF) = w; } }
    }
};
__device__ __forceinline__ f32x4 h4lo(unsigned a, unsigned b) { typedef _Float16 hh2 __attribute__((ext_vector_type(2))); const hh2 x = __builtin_bit_cast(hh2, a), y = __builtin_bit_cast(hh2, b); return (f32x4){(float)x.x, (float)x.y, (float)y.x, (float)y.y}; }
template <bool RF32> struct EpiResid {
    static constexpr bool PERM = true, AFTER_DRAIN = false;
    const float* R32; bf16_t* XH; const float* gt; int jbase, ppb, jmul;
    __device__ __forceinline__ void operator()(const f32x4 (&acc)[2][2][4][2], const Unit& u, int wr, int wc, int fr, int fq) const {
        const int row0 = u.pm * BM + wr * 64 + fr, col0 = u.pn * BM + wc * 32 + 8 * fq;
        const float* g = gt + (size_t)(jbase + (u.pm / ppb) * jmul) * 24576 + col0;
        f32x4 gv[2][2];
#pragma unroll
        for (int bj = 0; bj < 2; ++bj)
#pragma unroll
            for (int n = 0; n < 2; ++n) gv[bj][n] = *(const f32x4*)(g + bj * HALF + 4 * n);
#pragma unroll
        for (int ai = 0; ai < 2; ++ai)
#pragma unroll
            for (int m = 0; m < 4; ++m) { const size_t row = (size_t)(row0 + ai * HALF + m * 16); bf16_t* xp = XH + row * 8192 + col0;
#pragma unroll
                for (int bj = 0; bj < 2; ++bj) { f32x4 r0, r1;
                    if (RF32) { const float* rp = R32 + row * 4096 + col0 + bj * HALF; r0 = *(const f32x4*)rp; r1 = *(const f32x4*)(rp + 4); }
                    else { const u32x4 h = *(const u32x4*)(xp + bj * HALF); r0 = h4lo(h.x, h.y); r1 = h4lo(h.z, h.w); }
                    const f32x4 y0 = r0 + gv[bj][0] * acc[ai][bj][m][0], y1 = r1 + gv[bj][1] * acc[ai][bj][m][1];
                    u32x4 w; w.x = cvt_pk_f16(y0[0], y0[1]); w.y = cvt_pk_f16(y0[2], y0[3]); w.z = cvt_pk_f16(y1[0], y1[1]); w.w = cvt_pk_f16(y1[2], y1[3]);
                    *(u32x4*)(xp + bj * HALF) = w; } }
    }
};
struct EpiRelu2 {
    static constexpr bool PERM = true, AFTER_DRAIN = false;
    bf16_t* U;
    __device__ __forceinline__ void operator()(const f32x4 (&acc)[2][2][4][2], const Unit& u, int wr, int wc, int fr, int fq) const {
        const int row0 = u.pm * BM + wr * 64 + fr, col0 = u.pn * BM + wc * 32 + 8 * fq;
#pragma unroll
        for (int ai = 0; ai < 2; ++ai)
#pragma unroll
            for (int m = 0; m < 4; ++m) { bf16_t* rowp = U + (size_t)(row0 + ai * HALF + m * 16) * 16384 + col0;
#pragma unroll
                for (int bj = 0; bj < 2; ++bj) { f32x4 v0 = acc[ai][bj][m][0], v1 = acc[ai][bj][m][1];
#pragma unroll
                    for (int e = 0; e < 4; ++e) { const float a = fmaxf(v0[e], 0.f), b = fmaxf(v1[e], 0.f); v0[e] = a * a; v1[e] = b * b; }
                    u32x4 w; w.x = cvt_pk_bf16(v0[0], v0[1]); w.y = cvt_pk_bf16(v0[2], v0[3]); w.z = cvt_pk_bf16(v1[0], v1[1]); w.w = cvt_pk_bf16(v1[2], v1[3]);
                    *(u32x4*)(rowp + bj * HALF) = w; } }
    }
};

template <class Epi, class Sched, bool ALIGN_EPI = false, bool SP2 = false>
__device__ __forceinline__ void gemm_phase(PG8_LAS unsigned char* lds, const Gemm g, const Sched& S, const Epi& E) {
    int tid_ = threadIdx.x; asm volatile("" : "+v"(tid_));
    const int tid = tid_, wid = __builtin_amdgcn_readfirstlane(tid >> 6), lane = tid & 63, wr = wid >> 2, wc = wid & 3, fr = lane & 15, fq = lane >> 4;
    const int K = g.K, nt = K / BK;
    unsigned voffA[2], voffB[2];
#pragma unroll
    for (int i = 0; i < 2; ++i) { int R, C; stage_rc(tid * 16 + i * 8192, R, C); const int Rb = Epi::PERM ? ((R & ~31) + perm32(R & 31)) : R;
        voffA[i] = (unsigned)(R * K + C) * 2u; voffB[i] = (unsigned)(Rb * K + C) * 2u; }
    const size_t kstep = (size_t)(BK * 2);
    const size_t hstep = (size_t)HALF * K * 2;
    const size_t tstep = 2 * hstep;
    const unsigned ldsw = (unsigned)wid * 1024u;
    const int aoff = lds_byte(wr * 64 + fr, fq * 8), boff = lds_byte(wc * 32 + fr, fq * 8);
#define PG8_SA(b, h) (((b) * 2 + (h)) * HTB)
#define PG8_SB(b, h) ((4 + (b) * 2 + (h)) * HTB)
#define PG8_STAGE(bufoff, gbase, voff) do { _Pragma("unroll") for (int _i = 0; _i < 2; ++_i) \
        __builtin_amdgcn_global_load_lds((const unsigned*)((const char*)(gbase) + (voff)[_i]), (PG8_LAS unsigned*)(lds + (bufoff) + ldsw + _i * 8192), 16, 0, 0); } while (0)
#define PG8_LDA(dst, b, h) do { _Pragma("unroll") for (int m = 0; m < 4; ++m) _Pragma("unroll") for (int k = 0; k < 2; ++k) dst[m][k] = *(const PG8_LAS bf16x8*)(lds + PG8_SA(b, h) + aoff + m * 2048 + k * 1024); } while (0)
#define PG8_LDB(dst, b, h) do { _Pragma("unroll") for (int n = 0; n < 2; ++n) _Pragma("unroll") for (int k = 0; k < 2; ++k) dst[n][k] = *(const PG8_LAS bf16x8*)(lds + PG8_SB(b, h) + boff + n * 2048 + k * 1024); } while (0)
#define PG8_MMA(ai, bj, At, Bt) do { __builtin_amdgcn_s_setprio(1); _Pragma("unroll") for (int m = 0; m < 4; ++m) _Pragma("unroll") for (int n = 0; n < 2; ++n) _Pragma("unroll") for (int k = 0; k < 2; ++k) \
        acc[ai][bj][m][n] = __builtin_amdgcn_mfma_f32_16x16x32_bf16(Bt[n][k], At[m][k], acc[ai][bj][m][n], 0, 0, 0); __builtin_amdgcn_s_setprio(0); } while (0)
#define PG8_WAIT_V(n) asm volatile("s_waitcnt vmcnt(" #n ")" ::: "memory")
#define PG8_WAIT_L(n) asm volatile("s_waitcnt lgkmcnt(" #n ")" ::: "memory")
#define PG8_BAR __builtin_amdgcn_s_barrier()
#define PG8_SCHED __builtin_amdgcn_sched_barrier(0)
    Unit cur, nxt; int ui = 0;
    if (!S.next(0, cur)) return;
    f32x4 acc[2][2][4][2];
#pragma unroll
    for (int a = 0; a < 2; ++a)
#pragma unroll
        for (int b = 0; b < 2; ++b)
#pragma unroll
            for (int m = 0; m < 4; ++m)
#pragma unroll
                for (int n = 0; n < 2; ++n) acc[a][b][m][n] = (f32x4){0.f, 0.f, 0.f, 0.f};
    bf16x8 At[4][2], B0[2][2], B1[2][2];
    const char* cA = (const char*)g.A + (size_t)cur.pm * tstep; const char* cB = (const char*)g.Bt + (size_t)cur.pn * tstep;
    S.a_ready(cur);
    if constexpr (SP2) {
        PG8_STAGE(PG8_SB(0, 0), cB, voffB); PG8_STAGE(PG8_SB(0, 1), cB + hstep, voffB); PG8_STAGE(PG8_SA(0, 0), cA, voffA); PG8_STAGE(PG8_SA(0, 1), cA + hstep, voffA);
        if (wr == 1) PG8_BAR;
        PG8_WAIT_V(2); PG8_BAR;
        PG8_STAGE(PG8_SB(1, 0), cB + kstep, voffB); PG8_STAGE(PG8_SA(1, 0), cA + kstep, voffA); PG8_STAGE(PG8_SB(1, 1), cB + hstep + kstep, voffB);
        PG8_WAIT_V(6); PG8_BAR;
    } else {
        PG8_STAGE(PG8_SB(0, 0), cB, voffB); PG8_STAGE(PG8_SA(0, 0), cA, voffA); PG8_STAGE(PG8_SB(0, 1), cB + hstep, voffB); PG8_STAGE(PG8_SA(0, 1), cA + hstep, voffA);
        if (wr == 1) PG8_BAR;
        PG8_WAIT_V(4); PG8_BAR;
        PG8_STAGE(PG8_SB(1, 0), cB + kstep, voffB); PG8_STAGE(PG8_SA(1, 0), cA + kstep, voffA); PG8_STAGE(PG8_SB(1, 1), cB + hstep + kstep, voffB);
        PG8_WAIT_V(6); PG8_BAR;
    }
    for (;;) {
        const bool has_next = S.next(ui + 1, nxt);
        const char* nA = has_next ? (const char*)g.A + (size_t)nxt.pm * tstep : cA; const char* nB = has_next ? (const char*)g.Bt + (size_t)nxt.pn * tstep : cB;
        for (int t = 0; t < nt; t += 2) {
            const bool last = (t == nt - 2);
            const char* a1 = cA + (size_t)(t + 1) * kstep;
            const char* a2 = last ? nA : cA + (size_t)(t + 2) * kstep; const char* b2 = last ? nB : cB + (size_t)(t + 2) * kstep;
            const char* a3 = a2 + kstep; const char* b3 = b2 + kstep;
            if (last && has_next) S.a_ready(nxt);
            if constexpr (SP2) {
            PG8_LDB(B0, 0, 0); PG8_LDB(B1, 0, 1); PG8_SCHED; PG8_LDA(At, 0, 0); PG8_STAGE(PG8_SA(1, 1), a1 + hstep, voffA);
            PG8_WAIT_V(8); PG8_WAIT_L(0); PG8_BAR; PG8_MMA(0, 0, At, B0); PG8_MMA(0, 1, At, B1); PG8_BAR; PG8_SCHED;
            PG8_LDA(At, 0, 1); PG8_STAGE(PG8_SB(0, 0), b2, voffB); PG8_STAGE(PG8_SB(0, 1), b2 + hstep, voffB); PG8_STAGE(PG8_SA(0, 0), a2, voffA);
            PG8_WAIT_V(8); PG8_WAIT_L(0); PG8_BAR; PG8_MMA(1, 0, At, B0); PG8_MMA(1, 1, At, B1); PG8_BAR; PG8_SCHED;
            PG8_LDB(B0, 1, 0); PG8_LDB(B1, 1, 1); PG8_SCHED; PG8_LDA(At, 1, 0); PG8_STAGE(PG8_SA(0, 1), a2 + hstep, voffA);
            PG8_WAIT_V(8); PG8_WAIT_L(0); PG8_BAR; PG8_MMA(0, 0, At, B0); PG8_MMA(0, 1, At, B1); PG8_BAR; PG8_SCHED;
            PG8_LDA(At, 1, 1); PG8_STAGE(PG8_SB(1, 0), b3, voffB); PG8_STAGE(PG8_SB(1, 1), b3 + hstep, voffB); PG8_STAGE(PG8_SA(1, 0), a3, voffA);
            PG8_WAIT_V(8); PG8_WAIT_L(0); PG8_BAR; PG8_MMA(1, 0, At, B0); PG8_MMA(1, 1, At, B1); PG8_BAR; PG8_SCHED;
            } else {
            PG8_LDB(B0, 0, 0); PG8_SCHED; PG8_LDA(At, 0, 0); PG8_STAGE(PG8_SA(1, 1), a1 + hstep, voffA);
            PG8_WAIT_L(8); PG8_BAR; PG8_WAIT_L(0); PG8_MMA(0, 0, At, B0); PG8_BAR; PG8_SCHED;
            PG8_LDB(B1, 0, 1); PG8_STAGE(PG8_SB(0, 0), b2, voffB);
            PG8_BAR; PG8_WAIT_L(0); PG8_MMA(0, 1, At, B1); PG8_BAR;
            PG8_LDA(At, 0, 1); PG8_STAGE(PG8_SA(0, 0), a2, voffA);
            PG8_BAR; PG8_WAIT_L(0); PG8_MMA(1, 0, At, B0); PG8_BAR; PG8_SCHED;
            PG8_STAGE(PG8_SB(0, 1), b2 + hstep, voffB);
            PG8_WAIT_V(6); PG8_BAR; PG8_MMA(1, 1, At, B1); PG8_BAR;
            PG8_LDB(B0, 1, 0); PG8_SCHED; PG8_LDA(At, 1, 0); PG8_STAGE(PG8_SA(0, 1), a2 + hstep, voffA);
            PG8_WAIT_L(8); PG8_BAR; PG8_WAIT_L(0); PG8_MMA(0, 0, At, B0); PG8_BAR; PG8_SCHED;
            PG8_LDB(B1, 1, 1); PG8_STAGE(PG8_SB(1, 0), b3, voffB);
            PG8_BAR; PG8_WAIT_L(0); PG8_MMA(0, 1, At, B1); PG8_BAR;
            PG8_LDA(At, 1, 1); PG8_STAGE(PG8_SA(1, 0), a3, voffA);
            PG8_BAR; PG8_WAIT_L(0); PG8_MMA(1, 0, At, B0); PG8_BAR; PG8_SCHED;
            PG8_STAGE(PG8_SB(1, 1), b3 + hstep, voffB);
            PG8_WAIT_V(6); PG8_BAR; PG8_MMA(1, 1, At, B1); PG8_BAR;
            }
        }
        if constexpr (ALIGN_EPI) { if (wr == 0) PG8_BAR; }
        if constexpr (!Epi::AFTER_DRAIN) { E(acc, cur, wr, wc, fr, fq); S.done(cur); }
        if (!has_next) break;
#pragma unroll
        for (int a = 0; a < 2; ++a)
#pragma unroll
            for (int b = 0; b < 2; ++b)
#pragma unroll
                for (int m = 0; m < 4; ++m)
#pragma unroll
                    for (int n = 0; n < 2; ++n) acc[a][b][m][n] = (f32x4){0.f, 0.f, 0.f, 0.f};
        cur = nxt; cA = nA; cB = nB; ++ui;
        if constexpr (ALIGN_EPI) { if (wr == 1) PG8_BAR; }
    }
    PG8_WAIT_V(0);
    if constexpr (!ALIGN_EPI) { if (wr == 0) PG8_BAR; }
    PG8_BAR;
    if constexpr (Epi::AFTER_DRAIN) { E.fused(acc, cur, wr, wc, fr, fq, lds, wid, lane); S.done(cur); }
#undef PG8_SA
#undef PG8_SB
#undef PG8_STAGE
#undef PG8_LDA
#undef PG8_LDB
#undef PG8_MMA
#undef PG8_WAIT_V
#undef PG8_WAIT_L
#undef PG8_BAR
#undef PG8_SCHED
}
}


constexpr int NWAVES = 8;
constexpr int DM = 4096, T_CTX = 8192, T_LAT = 32768, L_CTX = 256, L_LAT = 4096, B_CTX = 32, B_LAT = 8;
constexpr int NH_A = 16, DH_A = 128, D_ATT = 2048, NH_R = 32, DH_R = 64, D_RW = 2048;
constexpr int C_RWKV = 6592, C_RWKV_P = 6656, D_IN = 20928, N_IN_P = 20992, D_FF = 16384, N_LORA = 10240, K_LORA = 512, NMOD = 24576;
constexpr float RMS_EPS = 1e-6f, LNX_EPS = 64e-5f;
constexpr size_t MiB = 1u << 20;
constexpr size_t WS_CTL = 0, CTL_ZERO_BYTES = 1 * MiB;
constexpr size_t WS_MODP = 1 * MiB;
constexpr size_t WS_MOD = 8 * MiB;
constexpr size_t WS_WIN = 9 * MiB;
constexpr size_t WS_WOA = 173 * MiB, WS_WOR = 189 * MiB, WS_WOUT = 205 * MiB;
constexpr size_t WS_WM1 = 237 * MiB, WS_WM2 = 365 * MiB;
constexpr size_t WS_WLORA = 493 * MiB;
constexpr size_t WS_CK = 503 * MiB, WS_CV = 511 * MiB;
constexpr size_t WS_H = 520 * MiB;
constexpr size_t WS_Q = 776 * MiB, WS_K = 904 * MiB, WS_V = 1032 * MiB;
constexpr size_t WS_PR = 1160 * MiB;
constexpr size_t WS_ORW = 1832 * MiB;
constexpr size_t WS_HLAT = 1576 * MiB;
constexpr size_t WS_MID = 1160 * MiB;
constexpr size_t WS_H2L = 512 * MiB, WS_UL = 768 * MiB;
constexpr size_t WS_H2C = 1416 * MiB, WS_UC = 1792 * MiB;
constexpr size_t WS_END = 2048 * MiB;
constexpr size_t WS_RS = 520 * MiB, WS_KS = 648 * MiB, WS_VS = 1576 * MiB, WS_KK = 1704 * MiB;
constexpr size_t WS_DF = 1160 * MiB, WS_DB = 1288 * MiB, WS_AF = 1416 * MiB, WS_YF = WS_ORW, WS_AB = WS_K, WS_LG = WS_V;
constexpr size_t WS_YB_CTX = 1960 * MiB, WS_YB_LAT = WS_WIN, WS_LA = 2016 * MiB;
static_assert(WS_UL + (size_t)T_LAT * D_FF * 2 <= WS_UC && WS_UC + (size_t)T_CTX * D_FF * 2 <= WS_END && WS_H2L + (size_t)T_LAT * DM * 2 <= WS_UL && WS_LA + (size_t)T_LAT * K_LORA * 2 <= WS_END && WS_YB_CTX + (size_t)T_CTX * D_RW * 2 <= WS_LA && WS_YF + (size_t)T_LAT * D_RW * 2 <= WS_YB_CTX && WS_MID + (size_t)T_LAT * DM * 2 <= WS_AF, "d_ws map");
constexpr int CW_BAR = 4096;
constexpr int RING_OFF = 0, RING_BYTES = 131072;
constexpr int LDSCTL_OFF = RING_BYTES, MISC_OFF = LDSCTL_OFF + 320;
constexpr int LDS_BYTES = 147456;

#define GAS __attribute__((address_space(1)))
#define LAS __attribute__((address_space(3)))
typedef unsigned short bf16;
typedef unsigned v4u __attribute__((ext_vector_type(4)));
typedef float f32x4 __attribute__((ext_vector_type(4)));
typedef short bf16x8 __attribute__((ext_vector_type(8)));
typedef GAS unsigned gu32;
typedef GAS unsigned long long gu64;
#define RLX_AGENT __ATOMIC_RELAXED, __HIP_MEMORY_SCOPE_AGENT
#define LDS_WAIT() asm volatile("s_waitcnt lgkmcnt(0)" ::: "memory")
#define VM_WAIT() asm volatile("s_waitcnt vmcnt(0)" ::: "memory")
__device__ __forceinline__ unsigned long long rt() { return __builtin_amdgcn_s_memrealtime(); }
__device__ __forceinline__ unsigned f2bf(float f) { unsigned u = __builtin_bit_cast(unsigned, f); return (u + 0x7fffu + ((u >> 16) & 1u)) >> 16; }
__device__ __forceinline__ unsigned pk2(float lo, float hi) { return f2bf(lo) | (f2bf(hi) << 16); }

#define XB_TMO      128
#define XB_XCNT(j)  (256  + 64 * (j))
#define XB_XSUB(j)  (1280 + 64 * (j))
#define XB_XGEN(j)  (2304 + 64 * (j))
#define XB_TOP      3328
#define XB_TOPGEN   3392
#define XCD_BAR_WORDS 3456
#define XB_SPIN_CAP (1u << 18)

__device__ __forceinline__ unsigned xb_ld(unsigned* p)              { return __hip_atomic_load(p, __ATOMIC_RELAXED, __HIP_MEMORY_SCOPE_AGENT); }
__device__ __forceinline__ unsigned xb_add(unsigned* p, unsigned v) { return __hip_atomic_fetch_add(p, v, __ATOMIC_RELAXED, __HIP_MEMORY_SCOPE_AGENT); }
__device__ __forceinline__ unsigned xb_xcc_id() { return (unsigned)__builtin_amdgcn_s_getreg((3 << 11) | 20) & 0xFu; }
#define XB_SPIN(cond, bar) do { unsigned _sp = 0; while (cond) { __builtin_amdgcn_s_sleep(1); \
    if ((++_sp & 255u) == 0u) { if (xb_ld(&(bar)[XB_TMO])) break; if (_sp > XB_SPIN_CAP) { atomicAdd(&(bar)[XB_TMO], 1u); break; } } } } while (0)

struct XcdBarrier {
    unsigned* bar; unsigned x;
    volatile LAS unsigned* st;
};

__device__ __forceinline__ XcdBarrier xcd_barrier_post(unsigned* bar, volatile LAS unsigned* st) {
    XcdBarrier b; b.bar = bar; b.x = xb_xcc_id(); b.st = st;
    if (threadIdx.x == 0) (void)xb_add(&bar[XB_XCNT(b.x)], 1u);
    return b;
}
__device__ __forceinline__ void xcd_barrier_complete(unsigned* bar, unsigned x, unsigned& nloc, unsigned& nx) {
    const unsigned G = gridDim.x * gridDim.y * gridDim.z;
    unsigned sum, cnt, mine, sp = 0u;
    for (;;) {
        sum = 0u; cnt = 0u; mine = 0u;
#pragma unroll
        for (unsigned j = 0; j < 16; ++j) { const unsigned c = xb_ld(&bar[XB_XCNT(j)]); sum += c; cnt += (c > 0u) ? 1u : 0u; mine = (j == x) ? c : mine; }
        if (sum == G) break;
        __builtin_amdgcn_s_sleep(1);
        if ((++sp & 255u) == 0u) { if (xb_ld(&bar[XB_TMO])) break; if (sp > XB_SPIN_CAP) { atomicAdd(&bar[XB_TMO], 1u); break; } }
    }
    nloc = mine > 0u ? mine : 1u; nx = cnt > 0u ? cnt : 1u;
}

__device__ __forceinline__ void xcd_barrier(const XcdBarrier& b) {
    asm volatile("s_waitcnt vmcnt(0)" ::: "memory");
    __syncthreads();
    if (threadIdx.x == 0) {
        unsigned* bar = b.bar;
        __builtin_amdgcn_s_waitcnt(0);
        unsigned nloc = b.st[0], nx = b.st[1];
        if (nloc == 0u) { xcd_barrier_complete(bar, b.x, nloc, nx); b.st[0] = nloc; b.st[1] = nx; }
        const unsigned old = xb_add(&bar[XB_XSUB(b.x)], 1u);
        const unsigned gen = old / nloc;
        if (old + 1u == (gen + 1u) * nloc) {
            __builtin_amdgcn_fence(__ATOMIC_RELEASE, "agent");
            asm volatile("s_waitcnt vmcnt(0)" ::: "memory");
            const unsigned og = xb_add(&bar[XB_TOP], 1u);
            const unsigned tg = og / nx;
            if (og + 1u == (tg + 1u) * nx) xb_add(&bar[XB_TOPGEN], 1u);
            else XB_SPIN(xb_ld(&bar[XB_TOPGEN]) == tg, bar);
            __builtin_amdgcn_fence(__ATOMIC_ACQUIRE, "agent");
            xb_add(&bar[XB_XGEN(b.x)], 1u);
            asm volatile("s_waitcnt vmcnt(0)" ::: "memory");
        } else {
            XB_SPIN(xb_ld(&bar[XB_XGEN(b.x)]) == gen, bar);
            __builtin_amdgcn_fence(__ATOMIC_ACQUIRE, "agent");
            asm volatile("s_waitcnt vmcnt(0)" ::: "memory");
        }
    }
    __syncthreads();
}

typedef unsigned short h16s;
typedef _Float16 h16x8 __attribute__((ext_vector_type(8)));
typedef float f32x16 __attribute__((ext_vector_type(16)));
typedef short s16x4 __attribute__((ext_vector_type(4)));
struct Frame {
    LAS unsigned char* lds;
    volatile LAS unsigned* MISC;
    gu32* ctl;
    int tid, lane, wave;
    int vcu, G;
    unsigned char* ws;
    float* out;
};
struct Args { const float* in[31]; float* out; unsigned char* ws; };
enum { I_XP = 0, I_XS, I_CK, I_CV, I_SF, I_SB, I_C, I_CCTX, I_WMOD, I_BMOD, I_N1, I_N2, I_NF, I_WIN, I_MU, I_RPB, I_W0, I_W2, I_A0, I_A2, I_G2, I_KK, I_KA, I_RK, I_LNW, I_LNB, I_WOA, I_WOR, I_WOUT, I_WM1, I_WM2 };
constexpr size_t O_Y = 0, O_NK = (size_t)(T_CTX + T_LAT) * DM, O_NV = O_NK + (size_t)T_CTX * D_ATT, O_SF = O_NV + (size_t)T_CTX * D_ATT, O_SB = O_SF + (size_t)B_CTX * NH_R * 64 * 64;

__device__ __forceinline__ float wave_sum(float v) {
#pragma unroll
    for (int o = 1; o < 64; o <<= 1) v += __shfl_xor(v, o);
    return v;
}
__device__ __forceinline__ unsigned pkbf(float lo, float hi) { return pg8::cvt_pk_bf16(lo, hi); }
__device__ __forceinline__ unsigned pkh(float lo, float hi) { return pg8::cvt_pk_f16(lo, hi); }
__device__ __forceinline__ float sigm(float x) { return pg8::sigmoidf_(x); }
__device__ __forceinline__ void unpack_h8(const v4u w, float (&f)[8]) { const h16x8 h = __builtin_bit_cast(h16x8, w);
#pragma unroll
    for (int e = 0; e < 8; ++e) f[e] = (float)h[e]; }

__device__ __forceinline__ void p0_transpose_item(const float* W, int ldw, int col_off, int nblk, bf16* WT, int ldt, int row_off, LAS float* scr, int item, int lane) {
    const int kb = item / nblk, nb = item % nblk, k0 = 64 * kb, n0 = 32 * nb;
    { f32x4 t[8]; const int kr = lane >> 3, nq = (lane & 7) * 4;
#pragma unroll
      for (int i = 0; i < 8; ++i) t[i] = *(const GAS f32x4*)(W + (size_t)(k0 + 8 * i + kr) * ldw + col_off + n0 + nq);
#pragma unroll
      for (int i = 0; i < 8; ++i) { LAS float* d = scr + (8 * i + kr) * 33 + nq; d[0] = t[i].x; d[1] = t[i].y; d[2] = t[i].z; d[3] = t[i].w; } }
    LDS_WAIT(); asm volatile("" ::: "memory");
    const int c = lane & 7;
#pragma unroll
    for (int j = 0; j < 4; ++j) { const int n = (lane >> 3) + 8 * j; const LAS float* s = scr + (8 * c) * 33 + n;
        v4u o; o.x = pkbf(s[0 * 33], s[1 * 33]); o.y = pkbf(s[2 * 33], s[3 * 33]); o.z = pkbf(s[4 * 33], s[5 * 33]); o.w = pkbf(s[6 * 33], s[7 * 33]);
        *(GAS v4u*)(WT + (size_t)(row_off + n0 + n) * ldt + k0 + 8 * c) = o; }
    LDS_WAIT(); asm volatile("" ::: "memory");
}
struct TDesc { const float* W; bf16* WT; int ldw, lgn, ldt, item; };
__device__ __forceinline__ TDesc late_desc(const Args& A, unsigned char* ws, int r) {
    constexpr int E0 = 32 * 128, E1 = E0 + 32 * 128, E2 = E1 + 64 * 128, E3 = E2 + 64 * 512;
    const int sel = (r >= E0) + (r >= E1) + (r >= E2) + (r >= E3);
    const int base = sel == 0 ? 0 : sel == 1 ? E0 : sel == 2 ? E1 : sel == 3 ? E2 : E3;
    const int widx = sel == 0 ? I_WOA : sel == 1 ? I_WOR : sel == 2 ? I_WOUT : sel == 3 ? I_WM1 : I_WM2;
    const size_t woff = sel == 0 ? WS_WOA : sel == 1 ? WS_WOR : sel == 2 ? WS_WOUT : sel == 3 ? WS_WM1 : WS_WM2;
    const int ldw = sel == 3 ? D_FF : DM, lgn = sel == 3 ? 9 : 7, ldt = sel == 0 ? D_ATT : sel == 1 ? D_RW : sel == 4 ? D_FF : DM;
    typedef const float* fptr; const __attribute__((address_space(4))) fptr* kin = (const __attribute__((address_space(4))) fptr*)__builtin_amdgcn_kernarg_segment_ptr();
    return TDesc{kin[widx], (bf16*)(ws + woff), ldw, lgn, ldt, r - base};
}
constexpr int LATE_ITEMS = 32 * 128 + 32 * 128 + 64 * 128 + 64 * 512 + 256 * 128;
__device__ __forceinline__ void late_load(f32x4 (&t)[8], const TDesc& d, int lane) {
    const int kb = d.item >> d.lgn, nb = d.item & ((1 << d.lgn) - 1), k0 = 64 * kb, n0 = 32 * nb, kr = lane >> 3, nq = (lane & 7) * 4;
#pragma unroll
    for (int i = 0; i < 8; ++i) t[i] = *(const GAS f32x4*)(d.W + (size_t)(k0 + 8 * i + kr) * d.ldw + n0 + nq);
}
__device__ __forceinline__ void late_finish(const f32x4 (&t)[8], const TDesc& d, LAS float* scr, int lane) {
    const int kb = d.item >> d.lgn, nb = d.item & ((1 << d.lgn) - 1), k0 = 64 * kb, n0 = 32 * nb, kr = lane >> 3, nq = (lane & 7) * 4;
#pragma unroll
    for (int i = 0; i < 8; ++i) { LAS float* q = scr + (8 * i + kr) * 33 + nq; q[0] = t[i].x; q[1] = t[i].y; q[2] = t[i].z; q[3] = t[i].w; }
    LDS_WAIT(); asm volatile("" ::: "memory");
    const int c = lane & 7;
#pragma unroll
    for (int j = 0; j < 4; ++j) { const int n = (lane >> 3) + 8 * j; const LAS float* sp = scr + (8 * c) * 33 + n;
        v4u o; o.x = pkbf(sp[0 * 33], sp[1 * 33]); o.y = pkbf(sp[2 * 33], sp[3 * 33]); o.z = pkbf(sp[4 * 33], sp[5 * 33]); o.w = pkbf(sp[6 * 33], sp[7 * 33]);
        *(GAS v4u*)(d.WT + (size_t)(n0 + n) * d.ldt + k0 + 8 * c) = o; }
    LDS_WAIT(); asm volatile("" ::: "memory");
}
__device__ __forceinline__ void late_weight_copies(Frame& F, const Args& A, int part, int nparts) {
    LAS float* scr = (LAS float*)(F.lds + RING_OFF + F.wave * 16384);
    int w0 = part * NWAVES + F.wave; const int st = nparts * NWAVES;
    asm volatile("" : "+v"(w0));
    if (w0 >= LATE_ITEMS) return;
    f32x4 ta[8], tb[8], tc[8];
#define LATE_LD(T, IT) late_load(T, late_desc(A, F.ws, min((IT), LATE_ITEMS - 1)), F.lane)
#define LATE_FN(T, IT) late_finish(T, late_desc(A, F.ws, (IT)), scr, F.lane)
    LATE_LD(ta, w0); LATE_LD(tb, w0 + st);
    for (int it = w0;;) {
        LATE_LD(tc, it + 2 * st); LATE_FN(ta, it); if (it + st >= LATE_ITEMS) break;
        LATE_LD(ta, it + 3 * st); LATE_FN(tb, it + st); if (it + 2 * st >= LATE_ITEMS) break;
        LATE_LD(tb, it + 4 * st); LATE_FN(tc, it + 2 * st); if (it + 3 * st >= LATE_ITEMS) break;
        it += 3 * st;
    }
#undef LATE_LD
#undef LATE_FN
}
__device__ __forceinline__ void p0_prologue(Frame& F, const Args& A) {
    const int gw = F.vcu * NWAVES + F.wave, NGW = F.G * NWAVES, gt = gw * 64 + F.lane, NGT = NGW * 64;
    unsigned char* ws = F.ws;
    { LAS float* scr = (LAS float*)(F.lds + RING_OFF + F.wave * 16384);
      constexpr int I_A = 64 * 398, I_B = 64 * 256, NITEMS = I_A + I_B;
      for (int it = gw; it < NITEMS; it += NGW) { int r = it;
          if (r < I_A) { p0_transpose_item(A.in[I_WIN], D_IN, 0, 398, (bf16*)(ws + WS_WIN), DM, 0, scr, r, F.lane); continue; } r -= I_A;
          p0_transpose_item(A.in[I_WIN], D_IN, 12736, 256, (bf16*)(ws + WS_WIN), DM, 12800, scr, r, F.lane);
      } }
    { GAS v4u* p = (GAS v4u*)((bf16*)(ws + WS_WIN) + (size_t)12736 * DM); const int n = 64 * DM / 8; for (int i = gt; i < n; i += NGT) p[i] = (v4u){0u, 0u, 0u, 0u}; }
    { bf16* WL = (bf16*)(ws + WS_WLORA); const float *w2 = A.in[I_W2], *a2 = A.in[I_A2], *g2 = A.in[I_G2];
      for (int i = gt; i < N_LORA * 256 / 2; i += NGT) { const int n = i >> 7, k = (i & 127) * 2; const int sel = n >> 11, col = n & 2047; float v[2];
#pragma unroll
          for (int e = 0; e < 2; ++e) { const int kk = k + e; float x = 0.f;
              if (sel < 2) { if (kk < 96) x = w2[((size_t)sel * 96 + kk) * 2048 + col]; }
              else if (sel < 4) { if (kk >= 96 && kk < 192) x = a2[((size_t)(sel - 2) * 96 + (kk - 96)) * 2048 + col]; }
              else x = g2[(size_t)kk * 2048 + col];
              v[e] = x; }
          ((GAS unsigned*)WL)[i] = pkbf(v[0], v[1]); } }
    { const int n8 = B_LAT * 256 * 2048 / 8;
      for (int i = gt; i < 2 * n8; i += NGT) { const bool isk = i < n8; const int j = isk ? i : i - n8; const float* src = (isk ? A.in[I_CK] : A.in[I_CV]) + (size_t)j * 8;
          const f32x4 a = *(const GAS f32x4*)src, b = *(const GAS f32x4*)(src + 4); v4u o; o.x = pkbf(a.x, a.y); o.y = pkbf(a.z, a.w); o.z = pkbf(b.x, b.y); o.w = pkbf(b.z, b.w);
          *((GAS v4u*)(ws + (isk ? WS_CK : WS_CV)) + j) = o; } }
    { LAS float* sc = (LAS float*)(F.lds + RING_OFF); LAS float* red = sc + 9 * 512; const float* wm = A.in[I_WMOD]; float* MODP = (float*)(ws + WS_MODP);
      for (int it = F.vcu; it < 96 * 8; it += F.G) { const int cb = it % 96, ks = it / 96;
          for (int idx = F.tid; idx < 9 * 512; idx += NWAVES * 64) { const int j = idx >> 9, kk = idx & 511, k = ks * 512 + kk; const float c = j == 0 ? A.in[I_CCTX][k] : A.in[I_C][(size_t)(j - 1) * DM + k]; sc[idx] = c * sigm(c); }
          __syncthreads();
          f32x4 acc[9];
#pragma unroll
          for (int j = 0; j < 9; ++j) acc[j] = (f32x4){0.f, 0.f, 0.f, 0.f};
          const float* wp = wm + (size_t)(ks * 512 + F.wave * 64) * NMOD + cb * 256 + F.lane * 4;
#pragma unroll 8
          for (int r = 0; r < 64; ++r) { const f32x4 w4 = *(const GAS f32x4*)(wp + (size_t)r * NMOD); const int kk = F.wave * 64 + r;
#pragma unroll
              for (int j = 0; j < 9; ++j) acc[j] += w4 * sc[j * 512 + kk]; }
#pragma unroll
          for (int j = 0; j < 9; ++j) *(LAS f32x4*)(red + (F.wave * 9 + j) * 256 + F.lane * 4) = acc[j];
          __syncthreads();
          for (int idx = F.tid; idx < 9 * 256; idx += NWAVES * 64) { const int j = idx >> 8, c = idx & 255; float s = 0.f;
#pragma unroll
              for (int w = 0; w < 8; ++w) s += red[(w * 9 + j) * 256 + c];
              MODP[((size_t)ks * 9 + j) * NMOD + cb * 256 + c] = s; }
          __syncthreads(); } }
}
__device__ __forceinline__ void p0b_mod_finalize(Frame& F, const Args& A) {
    const int gt = (F.vcu * NWAVES + F.wave) * 64 + F.lane, NGT = F.G * NWAVES * 64; const float* MODP = (const float*)(F.ws + WS_MODP); float* MOD = (float*)(F.ws + WS_MOD);
    for (int i = gt; i < 9 * NMOD; i += NGT) { const int n = i % NMOD; float s = A.in[I_BMOD][n];
#pragma unroll
        for (int ks = 0; ks < 8; ++ks) s += MODP[(size_t)ks * 9 * NMOD + i];
        MOD[i] = s; }
}
template <bool XF16> __device__ __forceinline__ void modnorm_rows(Frame& F, const void* Xv, int M, const float* nw, int sh_off, int sc_off, int jbase, int rps, int jmul, bf16* H) {
    static_assert(!XF16, "fp16 rows: modnorm16_rows");
    const int gw = F.vcu * NWAVES + F.wave, NGW = F.G * NWAVES; const float* MOD = (const float*)(F.ws + WS_MOD);
    for (int row0 = 2 * gw; row0 < M; row0 += 2 * NGW) {
        f32x4 v[2][8][2]; float ss[2] = {0.f, 0.f};
#pragma unroll
        for (int q = 0; q < 2; ++q) { const float* xr = (const float*)Xv + (size_t)(row0 + q) * DM + F.lane * 8;
#pragma unroll
            for (int c = 0; c < 8; ++c) { v[q][c][0] = *(const GAS f32x4*)(xr + c * 512); v[q][c][1] = *(const GAS f32x4*)(xr + c * 512 + 4); } }
#pragma unroll
        for (int q = 0; q < 2; ++q)
#pragma unroll
            for (int c = 0; c < 8; ++c)
                ss[q] += (v[q][c][0].x * v[q][c][0].x + v[q][c][0].y * v[q][c][0].y) + (v[q][c][0].z * v[q][c][0].z + v[q][c][0].w * v[q][c][0].w) + (v[q][c][1].x * v[q][c][1].x + v[q][c][1].y * v[q][c][1].y) + (v[q][c][1].z * v[q][c][1].z + v[q][c][1].w * v[q][c][1].w);
        const float rstd[2] = {1.0f / sqrtf(wave_sum(ss[0]) * (1.0f / DM) + RMS_EPS), 1.0f / sqrtf(wave_sum(ss[1]) * (1.0f / DM) + RMS_EPS)};
        const float* mj = MOD + (size_t)(jbase + (row0 / rps) * jmul) * NMOD + F.lane * 8; bf16* hr = H + (size_t)row0 * DM + F.lane * 8;
#pragma unroll
        for (int c = 0; c < 8; ++c) { unsigned ow[2][4];
#pragma unroll
            for (int h = 0; h < 2; ++h) { const f32x4 w4 = *(const GAS f32x4*)(nw + F.lane * 8 + c * 512 + 4 * h), s4 = *(const GAS f32x4*)(mj + sc_off + c * 512 + 4 * h), b4 = *(const GAS f32x4*)(mj + sh_off + c * 512 + 4 * h);
                const f32x4 cf = w4 * (s4 + 1.0f);
#pragma unroll
                for (int q = 0; q < 2; ++q) { const f32x4 y = v[q][c][h] * rstd[q] * cf + b4; ow[q][2 * h] = pkbf(y.x, y.y); ow[q][2 * h + 1] = pkbf(y.z, y.w); } }
#pragma unroll
            for (int q = 0; q < 2; ++q) { v4u o; o.x = ow[q][0]; o.y = ow[q][1]; o.z = ow[q][2]; o.w = ow[q][3]; *(GAS v4u*)(hr + (size_t)q * DM + c * 512) = o; } }
    }
}
__device__ __forceinline__ void final_norm_rows(Frame& F, float* Y, int M, const float* nw) {
    const int gw = F.vcu * NWAVES + F.wave, NGW = F.G * NWAVES;
    for (int row0 = gw; row0 < M; row0 += 2 * NGW) {
        f32x4 v[2][8][2]; float ss[2] = {0.f, 0.f}; const bool two = row0 + NGW < M;
#pragma unroll
        for (int q = 0; q < 2; ++q) { const int row = q ? (two ? row0 + NGW : row0) : row0;
#pragma unroll
            for (int c = 0; c < 8; ++c) { const v4u h = *(const GAS v4u*)((const h16s*)(Y + (size_t)row * DM) + F.lane * 8 + c * 512); v[q][c][0] = pg8::h4lo(h.x, h.y); v[q][c][1] = pg8::h4lo(h.z, h.w); } }
#pragma unroll
        for (int q = 0; q < 2; ++q)
#pragma unroll
            for (int c = 0; c < 8; ++c)
                ss[q] += (v[q][c][0].x * v[q][c][0].x + v[q][c][0].y * v[q][c][0].y) + (v[q][c][0].z * v[q][c][0].z + v[q][c][0].w * v[q][c][0].w) + (v[q][c][1].x * v[q][c][1].x + v[q][c][1].y * v[q][c][1].y) + (v[q][c][1].z * v[q][c][1].z + v[q][c][1].w * v[q][c][1].w);
        const float rstd0 = 1.0f / sqrtf(wave_sum(ss[0]) * (1.0f / DM) + RMS_EPS), rstd1 = 1.0f / sqrtf(wave_sum(ss[1]) * (1.0f / DM) + RMS_EPS);
        asm volatile("s_waitcnt vmcnt(0)" ::: "memory");
#pragma unroll
        for (int q = 0; q < 2; ++q) { if (q == 1 && !two) break; float* xr = Y + (size_t)(row0 + q * NGW) * DM + F.lane * 8; const float rstd = q ? rstd1 : rstd0;
#pragma unroll
            for (int c = 0; c < 8; ++c)
#pragma unroll
                for (int h = 0; h < 2; ++h) { const f32x4 w4 = *(const GAS f32x4*)(nw + F.lane * 8 + c * 512 + 4 * h); *(GAS f32x4*)(xr + c * 512 + 4 * h) = v[q][c][h] * rstd * w4; } }
    }
}
#define SSQ4(V) (((V).x * (V).x + (V).y * (V).y) + ((V).z * (V).z + (V).w * (V).w))
__device__ __forceinline__ void rows2_load(v4u (&B)[2][8], const h16s* X, int r0, int NGW, int M, int lane) {
#pragma unroll
    for (int q = 0; q < 2; ++q) { const int row = min(r0 + q * NGW, M - 1);
#pragma unroll
        for (int c = 0; c < 8; ++c) B[q][c] = *(const GAS v4u*)(X + (size_t)row * 8192 + lane * 8 + c * 512); }
}
__device__ __forceinline__ void rows2_rstd(const v4u (&B)[2][8], float (&rstd)[2]) {
    float ss[2] = {0.f, 0.f};
#pragma unroll
    for (int q = 0; q < 2; ++q)
#pragma unroll
        for (int c = 0; c < 8; ++c) { const f32x4 a = pg8::h4lo(B[q][c].x, B[q][c].y), b = pg8::h4lo(B[q][c].z, B[q][c].w); ss[q] += SSQ4(a) + SSQ4(b); }
#pragma unroll
    for (int q = 0; q < 2; ++q) rstd[q] = 1.0f / sqrtf(wave_sum(ss[q]) * (1.0f / DM) + RMS_EPS);
}
__device__ __forceinline__ void modnorm16_store(Frame& F, const v4u (&B)[2][8], int r0, int M, const float* nw, int sh_off, int sc_off, int jbase, int rps, int jmul, bf16* H) {
    const float* MOD = (const float*)(F.ws + WS_MOD); float rstd[2]; rows2_rstd(B, rstd);
    if (r0 >= M) return;
    const float* mj = MOD + (size_t)(jbase + (r0 / rps) * jmul) * NMOD + F.lane * 8; bf16* hr = H + (size_t)r0 * DM + F.lane * 8;
#pragma unroll
    for (int c = 0; c < 8; ++c) { unsigned ow[2][4];
#pragma unroll
        for (int h = 0; h < 2; ++h) { const f32x4 w4 = *(const GAS f32x4*)(nw + F.lane * 8 + c * 512 + 4 * h), s4 = *(const GAS f32x4*)(mj + sc_off + c * 512 + 4 * h), b4 = *(const GAS f32x4*)(mj + sh_off + c * 512 + 4 * h);
            const f32x4 cf = w4 * (s4 + 1.0f);
#pragma unroll
            for (int q = 0; q < 2; ++q) { unsigned u0 = h ? B[q][c].z : B[q][c].x, u1 = h ? B[q][c].w : B[q][c].y; asm volatile("" : "+v"(u0), "+v"(u1));
                const f32x4 x = pg8::h4lo(u0, u1);
                const f32x4 y = x * rstd[q] * cf + b4; ow[q][2 * h] = pkbf(y.x, y.y); ow[q][2 * h + 1] = pkbf(y.z, y.w); } }
#pragma unroll
        for (int q = 0; q < 2; ++q) { v4u o; o.x = ow[q][0]; o.y = ow[q][1]; o.z = ow[q][2]; o.w = ow[q][3]; *(GAS v4u*)(hr + (size_t)q * DM + c * 512) = o; }
        if (c & 1) asm volatile("" ::: "memory"); }
}
__device__ __forceinline__ void modnorm16_rows(Frame& F, const h16s* X, int M, const float* nw, int sh_off, int sc_off, int jbase, int rps, int jmul, bf16* H) {
    const int gw = F.vcu * NWAVES + F.wave, NGW = F.G * NWAVES;
    if (2 * gw >= M) return;
    v4u A_[2][8], B_[2][8]; rows2_load(A_, X, 2 * gw, 1, M, F.lane);
    for (int r0 = 2 * gw; r0 < M; r0 += 4 * NGW) {
        rows2_load(B_, X, r0 + 2 * NGW, 1, M, F.lane);
        modnorm16_store(F, A_, r0, M, nw, sh_off, sc_off, jbase, rps, jmul, H);
        if (r0 + 2 * NGW >= M) break;
        rows2_load(A_, X, r0 + 4 * NGW, 1, M, F.lane);
        modnorm16_store(F, B_, r0 + 2 * NGW, M, nw, sh_off, sc_off, jbase, rps, jmul, H);
    }
}
__device__ __forceinline__ void final16_store(Frame& F, const v4u (&B)[2][8], int r0, int M, float* Y, const float* nw) {
    float rstd[2]; rows2_rstd(B, rstd);
    if (r0 >= M) return;
    float* xr = Y + (size_t)r0 * DM + F.lane * 8;
#pragma unroll
    for (int c = 0; c < 8; ++c)
#pragma unroll
        for (int h = 0; h < 2; ++h) { const f32x4 w4 = *(const GAS f32x4*)(nw + F.lane * 8 + c * 512 + 4 * h);
#pragma unroll
            for (int q = 0; q < 2; ++q) { unsigned u0 = h ? B[q][c].z : B[q][c].x, u1 = h ? B[q][c].w : B[q][c].y; asm volatile("" : "+v"(u0), "+v"(u1));
                *(GAS f32x4*)(xr + (size_t)q * DM + c * 512 + 4 * h) = pg8::h4lo(u0, u1) * rstd[q] * w4; } }
}
__device__ __forceinline__ void final16_rows(Frame& F, float* Y, int M, const float* nw) {
    const int gw = F.vcu * NWAVES + F.wave, NGW = F.G * NWAVES; const h16s* X = (const h16s*)Y;
    if (2 * gw >= M) return;
    v4u A_[2][8], B_[2][8]; rows2_load(A_, X, 2 * gw, 1, M, F.lane);
    for (int r0 = 2 * gw; r0 < M; r0 += 4 * NGW) {
        rows2_load(B_, X, r0 + 2 * NGW, 1, M, F.lane);
        final16_store(F, A_, r0, M, Y, nw);
        if (r0 + 2 * NGW >= M) break;
        rows2_load(A_, X, r0 + 4 * NGW, 1, M, F.lane);
        final16_store(F, B_, r0 + 2 * NGW, M, Y, nw);
    }
}
namespace att {
constexpr float SCALE = 0.088388347648318440f, C = SCALE * 1.4426950408889634f;
constexpr int SHM_T = 16384;
constexpr int OFF_V = 0, OFF_K = 2 * SHM_T, OFF_WS = 4 * SHM_T, OFF_TAB = OFF_WS + 4096, OFF_ROW = OFF_TAB + 4096;
#define KSWZ(row, colB) ((row) * 256 + ((colB) ^ (((row) & 7) << 4)))
#define SBAR() __builtin_amdgcn_sched_barrier(0)
__device__ __forceinline__ int crow(int r, int hi) { return (r & 3) + 8 * (r >> 2) + 4 * hi; }
constexpr bool L0(int LV, int r) { return LV != 2 || r >= 12; }
constexpr bool L1(int LV, int r) { return LV != 1 || r < 4; }
template <int LV> __device__ __forceinline__ void partialSM(f32x16& p0, f32x16& p1, float& m_reg, float& mn, float& alpha) {
  float pmax = -3.0e38f;
#pragma unroll
  for (int r = 0; r < 16; ++r) if (L0(LV, r)) pmax = fmaxf(pmax, p0[r]);
#pragma unroll
  for (int r = 0; r < 16; ++r) if (L1(LV, r)) pmax = fmaxf(pmax, p1[r]);
  { auto rr = __builtin_amdgcn_permlane32_swap(__float_as_uint(pmax), __float_as_uint(pmax), false, false);
    pmax = fmaxf(__uint_as_float(rr[0]), __uint_as_float(rr[1])); }
  if (__all(pmax <= m_reg)) { mn = m_reg; alpha = 1.f; }
  else { mn = fmaxf(m_reg, pmax); alpha = __builtin_amdgcn_exp2f((m_reg - mn) * C); m_reg = mn; }
  const float mnC = -mn * C; typedef float f2_ __attribute__((ext_vector_type(2))); const f2_ C2 = {C, C}, M2 = {mnC, mnC};
#pragma unroll
  for (int r = 0; r < 16; r += 2) { if (L0(LV, r)) { const f2_ t = __builtin_elementwise_fma((f2_){p0[r], p0[r + 1]}, C2, M2); p0[r] = __builtin_amdgcn_exp2f(t.x); p0[r + 1] = __builtin_amdgcn_exp2f(t.y); } else { p0[r] = 0.f; p0[r + 1] = 0.f; } }
#pragma unroll
  for (int r = 0; r < 16; r += 2) { if (L1(LV, r)) { const f2_ t = __builtin_elementwise_fma((f2_){p1[r], p1[r + 1]}, C2, M2); p1[r] = __builtin_amdgcn_exp2f(t.x); p1[r + 1] = __builtin_amdgcn_exp2f(t.y); } else { p1[r] = 0.f; p1[r + 1] = 0.f; } }
}
template <int LV> __device__ __forceinline__ void finishSM(f32x16& p0, f32x16& p1, float alpha, float& l_reg, bf16x8& pa0, bf16x8& pa1, bf16x8& pa2, bf16x8& pa3) {
  typedef float f2_ __attribute__((ext_vector_type(2))); f2_ s2 = {0.f, 0.f};
#pragma unroll
  for (int r = 0; r < 16; r += 2) if (L0(LV, r)) s2 += (f2_){p0[r], p0[r + 1]};
#pragma unroll
  for (int r = 0; r < 16; r += 2) if (L1(LV, r)) s2 += (f2_){p1[r], p1[r + 1]};
  float ps = s2.x + s2.y;
  { auto rr = __builtin_amdgcn_permlane32_swap(__float_as_uint(ps), __float_as_uint(ps), false, false);
    ps = __uint_as_float(rr[0]) + __uint_as_float(rr[1]); }
  l_reg = l_reg * alpha + ps;
#define PK4(P, BASE, OUT) do { unsigned a0 = pkbf(P[BASE + 0], P[BASE + 1]), a1 = pkbf(P[BASE + 2], P[BASE + 3]);   \
    unsigned b0 = pkbf(P[BASE + 4], P[BASE + 5]), b1 = pkbf(P[BASE + 6], P[BASE + 7]);                              \
    auto r0 = __builtin_amdgcn_permlane32_swap(a0, b0, false, false); auto r1 = __builtin_amdgcn_permlane32_swap(a1, b1, false, false); \
    v4u w = {r0[0], r1[0], r0[1], r1[1]}; OUT = __builtin_bit_cast(bf16x8, w); } while (0)
  if (LV != 2) PK4(p0, 0, pa0); else pa0 = bf16x8{};
  PK4(p0, 8, pa1); PK4(p1, 0, pa2);
  if (LV != 1) PK4(p1, 8, pa3); else pa3 = bf16x8{};
#undef PK4
}
__device__ __forceinline__ void qkt(f32x16& p0, f32x16& p1, const LAS unsigned char* Ks, const bf16x8* qr, int r32, int hi) {
  p0 = f32x16{}; p1 = f32x16{};
#pragma unroll
  for (int d0 = 0; d0 < 8; ++d0) { const int cb = (d0 * 16 + hi * 8) * 2;
    const bf16x8 b0 = *(const LAS bf16x8*)(Ks + KSWZ(r32, cb));
    const bf16x8 b1 = *(const LAS bf16x8*)(Ks + KSWZ(32 + r32, cb));
    p0 = __builtin_amdgcn_mfma_f32_32x32x16_bf16(b0, qr[d0], p0, 0, 0, 0);
    p1 = __builtin_amdgcn_mfma_f32_32x32x16_bf16(b1, qr[d0], p1, 0, 0, 0); }
}
__device__ __forceinline__ int v_st(int k, int c) { const int kk = (k & ~0xC) | ((k & 4) << 1) | ((k & 8) >> 1); return ((kk >> 3) * 4 + (c >> 5)) * 512 + ((kk & 7) * 32 + (c & 31)) * 2; }
__device__ __forceinline__ int v_rd_base(int lane) { return ((lane & 3) << 3) | (((lane >> 2) & 3) << 6) | (((lane >> 4) & 1) << 5) | (((lane >> 5) & 1) << 8); }
constexpr int v_rd_off(int d0, int ks, int half) { return d0 * 512 + ks * 4096 + half * 2048; }
template <int OFF> __device__ __forceinline__ s16x4 tr_read(int vb) {
  s16x4 r; asm volatile("ds_read_b64_tr_b16 %0, %1 offset:%2" : "=&v"(r) : "v"(vb), "i"(OFF) : "memory"); return r;
}
template <int D0, int LV> __device__ __forceinline__ void pv_one(f32x16& od, int vb, bf16x8 pa0, bf16x8 pa1, bf16x8 pa2, bf16x8 pa3) {
  s16x4 l0 = {}, h0 = {}, l3 = {}, h3 = {};
  if (LV != 2) { l0 = tr_read<v_rd_off(D0, 0, 0)>(vb); h0 = tr_read<v_rd_off(D0, 0, 1)>(vb); }
  const s16x4 l1 = tr_read<v_rd_off(D0, 1, 0)>(vb), h1 = tr_read<v_rd_off(D0, 1, 1)>(vb), l2 = tr_read<v_rd_off(D0, 2, 0)>(vb), h2 = tr_read<v_rd_off(D0, 2, 1)>(vb);
  if (LV != 1) { l3 = tr_read<v_rd_off(D0, 3, 0)>(vb); h3 = tr_read<v_rd_off(D0, 3, 1)>(vb); }
  asm volatile("s_waitcnt lgkmcnt(0)" ::: "memory"); SBAR();
#define PK(L, H) (bf16x8){L[0], L[1], L[2], L[3], H[0], H[1], H[2], H[3]}
  if (LV != 2) od = __builtin_amdgcn_mfma_f32_32x32x16_bf16(pa0, PK(l0, h0), od, 0, 0, 0);
  od = __builtin_amdgcn_mfma_f32_32x32x16_bf16(pa1, PK(l1, h1), od, 0, 0, 0);
  od = __builtin_amdgcn_mfma_f32_32x32x16_bf16(pa2, PK(l2, h2), od, 0, 0, 0);
  if (LV != 1) od = __builtin_amdgcn_mfma_f32_32x32x16_bf16(pa3, PK(l3, h3), od, 0, 0, 0);
#undef PK
}
template <int LV> __device__ __forceinline__ void pv_d0(f32x16* o, int vb, bf16x8 pa0, bf16x8 pa1, bf16x8 pa2, bf16x8 pa3) {
  pv_one<0, LV>(o[0], vb, pa0, pa1, pa2, pa3); pv_one<1, LV>(o[1], vb, pa0, pa1, pa2, pa3); pv_one<2, LV>(o[2], vb, pa0, pa1, pa2, pa3); pv_one<3, LV>(o[3], vb, pa0, pa1, pa2, pa3);
}
template <int LV> __device__ __forceinline__ void attn_tile(const LAS unsigned char* Kt, int vb, const bf16x8* qr, f32x16* o, float& m_reg, float& l_reg, LAS float* al_l, int r32, int hi, const LAS unsigned char* rowb, const int (&off0)[16], const int (&off1)[16]) {
  f32x16 p0, p1; float mn, alpha; bf16x8 pa0, pa1, pa2, pa3;
  qkt(p0, p1, Kt, qr, r32, hi);
  if (LV != 0) {
#pragma unroll
    for (int r = 0; r < 16; ++r) { if (L0(LV, r)) p0[r] += *(const LAS float*)(rowb + off0[r]); if (L1(LV, r)) p1[r] += *(const LAS float*)(rowb + off1[r]); } }
  partialSM<LV>(p0, p1, m_reg, mn, alpha);
  if (__any(alpha < 1.f)) { if (hi == 0) al_l[r32] = alpha; asm volatile("s_waitcnt lgkmcnt(0)" ::: "memory");
#pragma unroll
    for (int d = 0; d < 4; ++d)
#pragma unroll
      for (int r = 0; r < 16; ++r) o[d][r] *= al_l[crow(r, hi)]; }
  finishSM<LV>(p0, p1, alpha, l_reg, pa0, pa1, pa2, pa3); SBAR();
  pv_d0<LV>(o, vb, pa0, pa1, pa2, pa3);
}
__device__ __forceinline__ void attn_unit(LAS unsigned char* lds, const bf16* Qb, bf16* Ob, const bf16* Kl, const bf16* Vl, int ntl, int rho0, int r0, const bf16* Kc, const bf16* Vc, const float* rpb) {
  int tid_ = threadIdx.x; asm volatile("" : "+v"(tid_));
  const int tid = tid_, wid = __builtin_amdgcn_readfirstlane(tid >> 6), lane = tid & 63, r32 = lane & 31, hi = lane >> 5;
  LAS unsigned char* V_lds = lds + OFF_V; LAS unsigned char* K_lds = lds + OFF_K;
  LAS float* wsf = (LAS float*)(lds + OFF_WS) + wid * 64; LAS float* li_l = wsf; LAS float* al_l = wsf + 32;
  LAS float* tab = (LAS float*)(lds + OFF_TAB);
  if (ntl > 0) { for (int i = tid; i < 15 * 31; i += NWAVES * 64) tab[i] = rpb[i] * (1.0f / SCALE); }
  float m_reg = -1e30f, l_reg = 0.f; f32x16 o[4] = {}; bf16x8 qr[8];
  { const bf16* Qw = Qb + (size_t)(wid * 32 + r32) * 2048 + hi * 8;
#pragma unroll
    for (int d0 = 0; d0 < 8; ++d0) qr[d0] = *(const GAS bf16x8*)(Qw + d0 * 16); }
  const int rq = r0 + (wid >> 1), cq = 32 * (wid & 1) + r32;
  const int rs = min(max(rq - 4, 0), 56), cs = min(max(cq - 8, 0), 48);
  LAS unsigned char* rowb = lds + OFF_ROW + wid * 128;
  int off0[16], off1[16];
#pragma unroll
  for (int r = 0; r < 16; ++r) { const int kap = (r & 3) + 8 * (r >> 2) + 4 * hi; off0[r] = ((unsigned)(kap - cs) < 16u) ? (kap - cq + 15) * 4 : 124; off1[r] = ((unsigned)(kap + 32 - cs) < 16u) ? (kap + 32 - cq + 15) * 4 : 124; }
  const int sr = tid >> 4, sc = (tid & 15) * 8, vst0 = v_st(sr, sc), vst1 = v_st(32 + sr, sc), kst0 = KSWZ(sr, sc * 2), kst1 = KSWZ(32 + sr, sc * 2);
  const int vb0 = (int)(unsigned)(uintptr_t)V_lds + v_rd_base(lane);
  const int NT = ntl + 4;
  bf16x8 sv0, sv1, sk0, sk1;
#define SLOAD(t) do { const bf16* kp = ((t) < ntl) ? Kl + (size_t)(t) * 64 * 2048 : Kc + (size_t)((t) - ntl) * 64 * 2048; const bf16* vp = ((t) < ntl) ? Vl + (size_t)(t) * 64 * 2048 : Vc + (size_t)((t) - ntl) * 64 * 2048; \
    sv0 = *(const GAS bf16x8*)(vp + (size_t)sr * 2048 + sc); sv1 = *(const GAS bf16x8*)(vp + (size_t)(32 + sr) * 2048 + sc); sk0 = *(const GAS bf16x8*)(kp + (size_t)sr * 2048 + sc); sk1 = *(const GAS bf16x8*)(kp + (size_t)(32 + sr) * 2048 + sc); } while (0)
#define SWRITE(b) do { *(LAS bf16x8*)(V_lds + (b) * SHM_T + vst0) = sv0; *(LAS bf16x8*)(V_lds + (b) * SHM_T + vst1) = sv1; *(LAS bf16x8*)(K_lds + (b) * SHM_T + kst0) = sk0; *(LAS bf16x8*)(K_lds + (b) * SHM_T + kst1) = sk1; } while (0)
  SLOAD(0); SWRITE(0); __syncthreads();
#define TILE_STEP(LV_, t) do { const int b = (t) & 1; if ((t) + 1 < NT) SLOAD((t) + 1); \
    const int rho = rho0 + (t); const bool need = (LV_ == 0) || (rho >= rs && rho < rs + 8); \
    if (need) { if (LV_ != 0) { if (lane < 32) ((LAS float*)rowb)[lane] = lane < 31 ? tab[(rho - rq + 7) * 31 + lane] : -1e30f; } attn_tile<LV_>(K_lds + b * SHM_T, vb0 + b * SHM_T, qr, o, m_reg, l_reg, al_l, r32, hi, rowb, off0, off1); } \
    if ((t) + 1 < NT) SWRITE(b ^ 1); __syncthreads(); } while (0)
  if (wid & 1) { for (int t = 0; t < ntl; ++t) TILE_STEP(2, t); }
  else { for (int t = 0; t < ntl; ++t) TILE_STEP(1, t); }
  for (int t = ntl; t < NT; ++t) TILE_STEP(0, t);
#undef TILE_STEP
#undef SLOAD
#undef SWRITE
  if (hi == 0) li_l[r32] = l_reg; asm volatile("s_waitcnt lgkmcnt(0)" ::: "memory");
  float rli[16];
#pragma unroll
  for (int r = 0; r < 16; ++r) rli[r] = __builtin_amdgcn_rcpf(li_l[crow(r, hi)]);
  bf16* Ow = Ob + (size_t)(wid * 32) * 2048;
#pragma unroll
  for (int r = 0; r < 16; ++r) { const int orow = crow(r, hi);
#pragma unroll
    for (int d0 = 0; d0 < 4; ++d0) { const unsigned w = pkbf(o[d0][r] * rli[r], 0.f); Ow[(size_t)orow * 2048 + d0 * 32 + r32] = (bf16)(w & 0xffffu); } }
}
#undef KSWZ
#undef SBAR
}
__device__ __forceinline__ float sum8(float v) { v += __shfl_xor(v, 1); v += __shfl_xor(v, 2); v += __shfl_xor(v, 4); return v; }
__device__ __forceinline__ void rwkv_prep(Frame& F, const Args& A, const h16s* PR, int prow0, int Ms, int L, h16s* RS, h16s* KS, h16s* VS, h16s* KK, bf16* LA) {
    const int gw = F.vcu * NWAVES + F.wave, NGW = F.G * NWAVES; const float* mu = A.in[I_MU]; const float* k_k = A.in[I_KK];
    for (int s0 = 2 * gw; s0 < Ms; s0 += 2 * NGW) {
        const int t = s0 % L; const bool hp = t > 0, hn = t + 2 < L;
        const h16s* pc = PR + (size_t)(prow0 + s0) * C_RWKV_P + F.lane * 8;
#pragma unroll 4
        for (int c = 0; c < 13; ++c) {
            const int col = c * 512 + F.lane * 8; const v4u z4 = {0u, 0u, 0u, 0u};
            const v4u w0 = hp ? *(const GAS v4u*)(pc + c * 512 - C_RWKV_P) : z4, w1 = *(const GAS v4u*)(pc + c * 512), w2 = *(const GAS v4u*)(pc + c * 512 + C_RWKV_P), w3 = hn ? *(const GAS v4u*)(pc + c * 512 + 2 * C_RWKV_P) : z4;
            float x0[8], x1[8], x2[8], x3[8], m[8]; unpack_h8(w0, x0); unpack_h8(w1, x1); unpack_h8(w2, x2); unpack_h8(w3, x3);
            if (col < C_RWKV) { const f32x4 m0 = *(const GAS f32x4*)(mu + col), m1 = *(const GAS f32x4*)(mu + col + 4); m[0] = m0.x; m[1] = m0.y; m[2] = m0.z; m[3] = m0.w; m[4] = m1.x; m[5] = m1.y; m[6] = m1.z; m[7] = m1.w; }
            else {
#pragma unroll
                for (int e = 0; e < 8; ++e) m[e] = 0.f; }
#pragma unroll
            for (int q = 0; q < 2; ++q) { const int s = s0 + q;
                float x[8];
#pragma unroll
                for (int e = 0; e < 8; ++e) { const float xc = q ? x2[e] : x1[e], xp = q ? x1[e] : x0[e], xn = q ? x3[e] : x2[e]; x[e] = xc + m[e] * (0.5f * (xp + xn) - xc); }
                if (c < 12) {
                    v4u o; o.x = pkh(x[0], x[1]); o.y = pkh(x[2], x[3]); o.z = pkh(x[4], x[5]); o.w = pkh(x[6], x[7]);
                    h16s* dst = (c < 4 ? RS : c < 8 ? KS : VS) + (size_t)s * D_RW + (c & 3) * 512 + F.lane * 8;
                    *(GAS v4u*)dst = o;
                    if (c >= 4 && c < 8) { const int kc = (c - 4) * 512 + F.lane * 8; const f32x4 q0 = *(const GAS f32x4*)(k_k + kc), q1 = *(const GAS f32x4*)(k_k + kc + 4);
                        float y[8] = {x[0] * q0.x, x[1] * q0.y, x[2] * q0.z, x[3] * q0.w, x[4] * q1.x, x[5] * q1.y, x[6] * q1.z, x[7] * q1.w}; float ss = 0.f;
    #pragma unroll
                        for (int e = 0; e < 8; ++e) ss += y[e] * y[e];
                        ss = sum8(ss); const float inv = 1.0f / fmaxf(sqrtf(ss), 1e-12f);
                        v4u ko; ko.x = pkh(y[0] * inv, y[1] * inv); ko.y = pkh(y[2] * inv, y[3] * inv); ko.z = pkh(y[4] * inv, y[5] * inv); ko.w = pkh(y[6] * inv, y[7] * inv);
                        *(GAS v4u*)(KK + (size_t)s * D_RW + kc) = ko; }
                } else {
                    float y[8];
    #pragma unroll
                    for (int e = 0; e < 8; ++e) { const int j = F.lane * 8 + e; const float v = x[e];
                        const float th = 1.0f - 2.0f * __builtin_amdgcn_rcpf(1.0f + __builtin_amdgcn_exp2f(2.8853900817779268f * v));
                        y[e] = j < 96 ? th : j < 192 ? v : j < 448 ? sigm(v) : 0.f; }
                    v4u o; o.x = pkbf(y[0], y[1]); o.y = pkbf(y[2], y[3]); o.z = pkbf(y[4], y[5]); o.w = pkbf(y[6], y[7]);
                    if (F.lane < 24) *(GAS v4u*)(LA + (size_t)s * 256 + F.lane * 8) = o;
                    else if (F.lane < 56) *(GAS v4u*)(LA + (size_t)Ms * 256 + (size_t)s * 256 + (F.lane - 24) * 8) = o;
                    else *(GAS v4u*)(LA + (size_t)s * 256 + 192 + (F.lane - 56) * 8) = (v4u){0u, 0u, 0u, 0u};
                }
            }
        }
    }
}
typedef float f32x2 __attribute__((ext_vector_type(2)));
__device__ __forceinline__ float dpp_xor1(float x) { return __builtin_bit_cast(float, __builtin_amdgcn_update_dpp(0, __builtin_bit_cast(int, x), 0xB1, 0xf, 0xf, true)); }
__device__ __forceinline__ float dpp_xor2(float x) { return __builtin_bit_cast(float, __builtin_amdgcn_update_dpp(0, __builtin_bit_cast(int, x), 0x4E, 0xf, 0xf, true)); }
__device__ __forceinline__ float dpp_hmir(float x) { return __builtin_bit_cast(float, __builtin_amdgcn_update_dpp(0, __builtin_bit_cast(int, x), 0x141, 0xf, 0xf, true)); }
__device__ __forceinline__ float red8(float x) { x += dpp_xor1(x); x += dpp_xor2(x); x += dpp_hmir(x); return x; }
__device__ __forceinline__ float dpp_shr1(float x) { return __builtin_bit_cast(float, __builtin_amdgcn_update_dpp(__builtin_bit_cast(int, x), __builtin_bit_cast(int, x), 0x111, 0xf, 0xf, false)); }
__device__ __forceinline__ float dpp_shr2(float x) { return __builtin_bit_cast(float, __builtin_amdgcn_update_dpp(__builtin_bit_cast(int, x), __builtin_bit_cast(int, x), 0x112, 0xf, 0xf, false)); }
__device__ __forceinline__ float dpp_shr4(float x) { return __builtin_bit_cast(float, __builtin_amdgcn_update_dpp(__builtin_bit_cast(int, x), __builtin_bit_cast(int, x), 0x114, 0xf, 0xf, false)); }
constexpr int SC_U = 8, SC_STEP = 5 * 64, SC_OPS_F = SC_U * SC_STEP, SC_GAM_F = 64, SC_Y_F = SC_U * 512, SC_SLOT_F = 2 * SC_OPS_F + 2 * SC_GAM_F + 2 * SC_Y_F;
static_assert(2 * SC_SLOT_F * 4 <= RING_BYTES, "scan LDS");
struct ScanOps { f32x4 kk[2], bb[2], kd[2], r[2]; f32x2 v; };
__device__ __forceinline__ void scan_ld(ScanOps& o, const LAS float* ob, int kq, int v0) {
#pragma unroll
    for (int j = 0; j < 2; ++j) { o.kk[j] = *(const LAS f32x4*)(ob + 0 * 64 + kq * 8 + 4 * j); o.bb[j] = *(const LAS f32x4*)(ob + 1 * 64 + kq * 8 + 4 * j);
        o.kd[j] = *(const LAS f32x4*)(ob + 2 * 64 + kq * 8 + 4 * j); o.r[j] = *(const LAS f32x4*)(ob + 3 * 64 + kq * 8 + 4 * j); }
    o.v = *(const LAS f32x2*)(ob + 4 * 64 + v0);
}
__device__ __forceinline__ f32x2 lo2(f32x4 a) { return (f32x2){a.x, a.y}; }
__device__ __forceinline__ f32x2 hi2(f32x4 a) { return (f32x2){a.z, a.w}; }
__device__ __forceinline__ f32x2 h2x2(unsigned u) { typedef _Float16 hh2 __attribute__((ext_vector_type(2))); const hh2 h = __builtin_bit_cast(hh2, u); return (f32x2){(float)h.x, (float)h.y}; }
__device__ __forceinline__ f32x2 fma2(f32x2 a, f32x2 b, f32x2 c) { return __builtin_elementwise_fma(a, b, c); }
__device__ __forceinline__ f32x2 dot8(const f32x2 (&S)[4], const f32x4 (&x)[2]) { f32x2 p = S[0] * lo2(x[0]); p = fma2(S[1], hi2(x[0]), p); p = fma2(S[2], lo2(x[1]), p); p = fma2(S[3], hi2(x[1]), p); return p; }
__device__ __forceinline__ void rwkv_scan(Frame& F, const Args& A, int nseq, int L, int seq0_global, bool has_state, const h16s* RS, const h16s* KS, const h16s* VS, const h16s* KK,
                                          const h16s* DF, const h16s* DB, const h16s* AF, const h16s* AB, h16s* YF, h16s* YB, float* out_sf, float* out_sb) {
    const int nchains = nseq * NH_R * 2, nslots = nchains >= 2 * F.G ? 2 : 1; const int lane = F.lane, cs = F.wave >> 2, wq = F.wave & 3, kq = lane & 7, v0 = 16 * wq + 2 * (lane >> 3);
    const int ft = F.tid & 255, su = ft & 7, kp = ft >> 3;
    LAS float* const sl = (LAS float*)(F.lds + RING_OFF) + cs * SC_SLOT_F;
    const float* k_a = A.in[I_KA]; const int NC = L / SC_U;
    for (int it = 0; (it * F.G + F.vcu) * nslots < nchains; ++it) {
        const int chain = (it * F.G + F.vcu) * nslots + cs; const bool active = cs < nslots && chain < nchains;
        const int dir = chain & 1, head = (chain >> 1) & 31, seq = chain >> 6;
        const h16s* Dd = dir ? DB : DF; const h16s* Ad = dir ? AB : AF; h16s* Yd = dir ? YB : YF;
        const int colp = head * 64 + 2 * kp;
        f32x2 ka2 = (f32x2){0.f, 0.f}; if (active) ka2 = *(const GAS f32x2*)(k_a + colp); const f32x2 oka2 = (f32x2){1.0f - ka2.x, 1.0f - ka2.y};
        f32x2 Sa[4], Sb[4];
#pragma unroll
        for (int j = 0; j < 4; ++j) { Sa[j] = (f32x2){0.f, 0.f}; Sb[j] = (f32x2){0.f, 0.f}; }
        const size_t soff = (((size_t)(seq0_global + seq) * NH_R + head) * 64 + v0) * 64 + 8 * kq;
        if (active && has_state) { const float* sp = (dir ? A.in[I_SB] : A.in[I_SF]) + soff; const f32x4 a = *(const GAS f32x4*)sp, b = *(const GAS f32x4*)(sp + 4), c = *(const GAS f32x4*)(sp + 64), d = *(const GAS f32x4*)(sp + 68);
            Sa[0] = lo2(a); Sa[1] = hi2(a); Sa[2] = lo2(b); Sa[3] = hi2(b); Sb[0] = lo2(c); Sb[1] = hi2(c); Sb[2] = lo2(d); Sb[3] = hi2(d); }
        const int row0 = seq * L; const int tstart = dir ? L - 1 : 0, tstep = dir ? -1 : 1;
        struct Raw { unsigned r, k, kk, w, a, v; };
        Raw gA = {0, 0, 0, 0, 0, 0}, gB = {0, 0, 0, 0, 0, 0};
#define SC_GLOAD(g, c) do { const size_t ro = (size_t)(row0 + tstart + ((c) * SC_U + su) * tstep) * D_RW + colp; g.r = *(const GAS unsigned*)(RS + ro); g.k = *(const GAS unsigned*)(KS + ro); g.kk = *(const GAS unsigned*)(KK + ro); \
            g.w = *(const GAS unsigned*)(Dd + ro); g.a = *(const GAS unsigned*)(Ad + ro); g.v = *(const GAS unsigned*)(VS + ro); } while (0)
        f32x2 f_r, f_kk, f_v, f_kd, f_bb, f_gi, f_t, f_inv;
#define SC_F0(g) do { const f32x2 k2 = h2x2(g.k), a2 = h2x2(g.a); f_r = h2x2(g.r); f_kk = h2x2(g.kk); f_v = h2x2(g.v); f_gi = h2x2(g.w); f_kd = k2 * (a2 * ka2 + oka2); f_bb = f_kk * a2; \
            f_t.x = dpp_shr1(f_gi.x); f_t.y = dpp_shr1(f_gi.y); } while (0)
#define SC_F1() do { if (su >= 1) f_gi *= f_t; f_t.x = dpp_shr2(f_gi.x); f_t.y = dpp_shr2(f_gi.y); } while (0)
#define SC_F2() do { if (su >= 2) f_gi *= f_t; f_t.x = dpp_shr4(f_gi.x); f_t.y = dpp_shr4(f_gi.y); } while (0)
#define SC_F3() do { if (su >= 4) f_gi *= f_t; f_t.x = dpp_shr1(f_gi.x); f_t.y = dpp_shr1(f_gi.y); f_inv = (f32x2){__builtin_amdgcn_rcpf(f_gi.x), __builtin_amdgcn_rcpf(f_gi.y)}; } while (0)
#define SC_F4(b) do { const f32x2 ge = su >= 1 ? f_t : (f32x2){1.0f, 1.0f}; \
            LAS float* ob = sl + (b) * SC_OPS_F + su * SC_STEP + 2 * kp; *(LAS f32x2*)(ob) = ge * f_kk; *(LAS f32x2*)(ob + 64) = f_bb * f_inv; *(LAS f32x2*)(ob + 128) = f_kd * f_inv; *(LAS f32x2*)(ob + 192) = f_gi * f_r; *(LAS f32x2*)(ob + 256) = f_v; \
            if (su == SC_U - 1) *(LAS f32x2*)(sl + 2 * SC_OPS_F + (b) * SC_GAM_F + 2 * kp) = f_gi; } while (0)
#define SC_YSTORE(bb_, c_) do { const LAS f32x4* yp = (const LAS f32x4*)(sl + 2 * SC_OPS_F + 2 * SC_GAM_F + (bb_) * SC_Y_F + (su * 64 + 2 * kp) * 8); const f32x4 a0 = yp[0], a1 = yp[1], b0 = yp[2], b1 = yp[3]; \
            const float y0 = ((a0.x + a0.z) + (a1.x + a1.z)) + ((b0.x + b0.z) + (b1.x + b1.z)), y1 = ((a0.y + a0.w) + (a1.y + a1.w)) + ((b0.y + b0.w) + (b1.y + b1.w)); \
            *(GAS unsigned*)(Yd + (size_t)(row0 + tstart + ((c_) * SC_U + su) * tstep) * D_RW + colp) = pkh(y0, y1); } while (0)
        __syncthreads();
        if (active) { SC_GLOAD(gA, 0); SC_F0(gA); SC_F1(); SC_F2(); SC_F3(); SC_F4(0); if (NC > 1) SC_GLOAD(gA, 1); }
        __syncthreads();
        for (int c = 0; c < NC; ++c) {
            const int b = c & 1;
            LAS float* yst = sl + 2 * SC_OPS_F + 2 * SC_GAM_F + b * SC_Y_F;
            if (active) {
                const bool fill = c + 1 < NC;
                if (c + 2 < NC) SC_GLOAD(gB, c + 2);
                const LAS float* ops = sl + b * SC_OPS_F;
                ScanOps cur, nxt; scan_ld(cur, ops, kq, v0);
                f32x2 pa = dot8(Sa, cur.kk), pb = dot8(Sb, cur.kk);
#define SC_STEP_(s) do { \
                    if ((s) + 1 < SC_U) scan_ld(nxt, ops + ((s) + 1) * SC_STEP, kq, v0); \
                    const f32x2 vA = (f32x2){cur.v.x, cur.v.x}, vB = (f32x2){cur.v.y, cur.v.y}; \
                    float ra = pa.x + pa.y, rb = pb.x + pb.y; \
                    ra += dpp_xor1(ra); rb += dpp_xor1(rb); \
                    Sa[0] = fma2(vA, lo2(cur.kd[0]), Sa[0]); Sb[0] = fma2(vB, lo2(cur.kd[0]), Sb[0]); Sa[1] = fma2(vA, hi2(cur.kd[0]), Sa[1]); Sb[1] = fma2(vB, hi2(cur.kd[0]), Sb[1]); \
                    ra += dpp_xor2(ra); rb += dpp_xor2(rb); \
                    Sa[2] = fma2(vA, lo2(cur.kd[1]), Sa[2]); Sb[2] = fma2(vB, lo2(cur.kd[1]), Sb[2]); Sa[3] = fma2(vA, hi2(cur.kd[1]), Sa[3]); Sb[3] = fma2(vB, hi2(cur.kd[1]), Sb[3]); \
                    ra += dpp_hmir(ra); rb += dpp_hmir(rb); \
                    const f32x2 sA = (f32x2){-ra, -ra}, sB = (f32x2){-rb, -rb}; \
                    Sa[0] = fma2(sA, lo2(cur.bb[0]), Sa[0]); Sb[0] = fma2(sB, lo2(cur.bb[0]), Sb[0]); Sa[1] = fma2(sA, hi2(cur.bb[0]), Sa[1]); Sb[1] = fma2(sB, hi2(cur.bb[0]), Sb[1]); \
                    Sa[2] = fma2(sA, lo2(cur.bb[1]), Sa[2]); Sb[2] = fma2(sB, lo2(cur.bb[1]), Sb[2]); Sa[3] = fma2(sA, hi2(cur.bb[1]), Sa[3]); Sb[3] = fma2(sB, hi2(cur.bb[1]), Sb[3]); \
                    f32x2 ya = Sa[0] * lo2(cur.r[0]), yb = Sb[0] * lo2(cur.r[0]); \
                    if ((s) + 1 < SC_U) { pa = Sa[0] * lo2(nxt.kk[0]); pb = Sb[0] * lo2(nxt.kk[0]); } \
                    ya = fma2(Sa[1], hi2(cur.r[0]), ya); yb = fma2(Sb[1], hi2(cur.r[0]), yb); \
                    if ((s) + 1 < SC_U) { pa = fma2(Sa[1], hi2(nxt.kk[0]), pa); pb = fma2(Sb[1], hi2(nxt.kk[0]), pb); } \
                    ya = fma2(Sa[2], lo2(cur.r[1]), ya); yb = fma2(Sb[2], lo2(cur.r[1]), yb); \
                    if ((s) + 1 < SC_U) { pa = fma2(Sa[2], lo2(nxt.kk[1]), pa); pb = fma2(Sb[2], lo2(nxt.kk[1]), pb); } \
                    ya = fma2(Sa[3], hi2(cur.r[1]), ya); yb = fma2(Sb[3], hi2(cur.r[1]), yb); \
                    if ((s) + 1 < SC_U) { pa = fma2(Sa[3], hi2(nxt.kk[1]), pa); pb = fma2(Sb[3], hi2(nxt.kk[1]), pb); } \
                    *(LAS f32x2*)(yst + ((s) * 64 + v0) * 8 + 2 * kq) = (f32x2){ya.x + ya.y, yb.x + yb.y}; \
                    if ((s) + 1 < SC_U) cur = nxt; } while (0)
                SC_STEP_(0); SC_STEP_(1);
                if (c > 0) SC_YSTORE(b ^ 1, c - 1);
                if (fill) SC_F0(gA);
                SC_STEP_(2);
                if (fill) SC_F1();
                SC_STEP_(3);
                if (fill) SC_F2();
                SC_STEP_(4);
                if (fill) SC_F3();
                SC_STEP_(5);
                if (fill) SC_F4(b ^ 1);
                SC_STEP_(6); SC_STEP_(7);
#undef SC_STEP_
                { const LAS float* gp = sl + 2 * SC_OPS_F + b * SC_GAM_F + kq * 8; const f32x4 g0 = *(const LAS f32x4*)gp, g1 = *(const LAS f32x4*)(gp + 4);
                  Sa[0] *= lo2(g0); Sa[1] *= hi2(g0); Sa[2] *= lo2(g1); Sa[3] *= hi2(g1); Sb[0] *= lo2(g0); Sb[1] *= hi2(g0); Sb[2] *= lo2(g1); Sb[3] *= hi2(g1); }
                gA = gB;
            }
            __syncthreads();
        }
        if (active) SC_YSTORE((NC - 1) & 1, NC - 1);
#undef SC_GLOAD
#undef SC_F0
#undef SC_F1
#undef SC_F2
#undef SC_F3
#undef SC_F4
#undef SC_YSTORE
        if (active && out_sf) { float* dp = (dir ? out_sb : out_sf) + soff; *(GAS f32x4*)dp = (f32x4){Sa[0].x, Sa[0].y, Sa[1].x, Sa[1].y}; *(GAS f32x4*)(dp + 4) = (f32x4){Sa[2].x, Sa[2].y, Sa[3].x, Sa[3].y};
            *(GAS f32x4*)(dp + 64) = (f32x4){Sb[0].x, Sb[0].y, Sb[1].x, Sb[1].y}; *(GAS f32x4*)(dp + 68) = (f32x4){Sb[2].x, Sb[2].y, Sb[3].x, Sb[3].y}; }
    }
}
__device__ __forceinline__ void rwkv_post(Frame& F, const Args& A, int Ms, const h16s* RS, const h16s* KS, const h16s* VS, const h16s* AF, const h16s* AB, const h16s* LG, const h16s* YF, const h16s* YB, bf16* ORW  ) {
    const int gw = F.vcu * NWAVES + F.wave, NGW = F.G * NWAVES; const float *lnw = A.in[I_LNW], *lnb = A.in[I_LNB], *k_a = A.in[I_KA], *r_k = A.in[I_RK];
    for (int s = gw; s < Ms; s += NGW) {
#pragma unroll
        for (int c = 0; c < 4; ++c) { const int col = c * 512 + F.lane * 8; const size_t off = (size_t)s * D_RW + col;
            float yf[8], yb[8], r[8], k[8], v[8], af[8], ab[8], g[8], w[8], b[8], ka[8], rk[8];
            unpack_h8(*(const GAS v4u*)(YF + off), yf); unpack_h8(*(const GAS v4u*)(YB + off), yb); unpack_h8(*(const GAS v4u*)(RS + off), r); unpack_h8(*(const GAS v4u*)(KS + off), k);
            unpack_h8(*(const GAS v4u*)(VS + off), v); unpack_h8(*(const GAS v4u*)(AF + off), af); unpack_h8(*(const GAS v4u*)(AB + off), ab); unpack_h8(*(const GAS v4u*)(LG + off), g);
#pragma unroll
            for (int h = 0; h < 2; ++h) { const f32x4 a = *(const GAS f32x4*)(lnw + col + 4 * h), bb = *(const GAS f32x4*)(lnb + col + 4 * h), cc = *(const GAS f32x4*)(k_a + col + 4 * h), dd = *(const GAS f32x4*)(r_k + col + 4 * h);
                w[4 * h] = a.x; w[4 * h + 1] = a.y; w[4 * h + 2] = a.z; w[4 * h + 3] = a.w; b[4 * h] = bb.x; b[4 * h + 1] = bb.y; b[4 * h + 2] = bb.z; b[4 * h + 3] = bb.w;
                ka[4 * h] = cc.x; ka[4 * h + 1] = cc.y; ka[4 * h + 2] = cc.z; ka[4 * h + 3] = cc.w; rk[4 * h] = dd.x; rk[4 * h + 1] = dd.y; rk[4 * h + 2] = dd.z; rk[4 * h + 3] = dd.w; }
            float sf = 0.f, sb = 0.f, bf_ = 0.f, bb_ = 0.f;
#pragma unroll
            for (int e = 0; e < 8; ++e) { sf += yf[e]; sb += yb[e]; const float t = r[e] * k[e] * rk[e]; bf_ += t * (1.0f + (af[e] - 1.0f) * ka[e]); bb_ += t * (1.0f + (ab[e] - 1.0f) * ka[e]); }
            sf = sum8(sf) * (1.0f / 64.0f); sb = sum8(sb) * (1.0f / 64.0f); bf_ = sum8(bf_); bb_ = sum8(bb_);
            float qf = 0.f, qb = 0.f;
#pragma unroll
            for (int e = 0; e < 8; ++e) { yf[e] -= sf; yb[e] -= sb; qf += yf[e] * yf[e]; qb += yb[e] * yb[e]; }
            const float rf = 1.0f / sqrtf(sum8(qf) * (1.0f / 64.0f) + LNX_EPS), rb = 1.0f / sqrtf(sum8(qb) * (1.0f / 64.0f) + LNX_EPS);
            float o[8];
#pragma unroll
            for (int e = 0; e < 8; ++e) o[e] = ((yf[e] * rf + yb[e] * rb) * w[e] + 2.0f * b[e] + (bf_ + bb_) * v[e]) * g[e];
            v4u ow; ow.x = pkbf(o[0], o[1]); ow.y = pkbf(o[2], o[3]); ow.z = pkbf(o[4], o[5]); ow.w = pkbf(o[6], o[7]);
            *(GAS v4u*)(ORW + off) = ow; }
    }
}
__global__ void __launch_bounds__(NWAVES * 64, 2) fwd_kernel(Args args) {
    const Args& A = args;
    extern __shared__ __attribute__((aligned(16))) unsigned char lds[];
    Frame F;
    F.lds = (LAS unsigned char*)lds;
    F.MISC = (volatile LAS unsigned*)(F.lds + MISC_OFF);
    F.tid = threadIdx.x; F.lane = F.tid & 63; F.wave = __builtin_amdgcn_readfirstlane(F.tid >> 6);
    F.G = gridDim.x; { const int bx = blockIdx.x; F.vcu = (F.G % 8 == 0) ? (bx % 8) * (F.G / 8) + bx / 8 : bx; }
    F.ws = args.ws; F.out = args.out; F.ctl = (gu32*)(args.ws + WS_CTL);
    for (int u = F.tid; u < (LDS_BYTES - LDSCTL_OFF) / 4; u += NWAVES * 64) ((LAS unsigned*)(F.lds + LDSCTL_OFF))[u] = 0u;
    __syncthreads();
    XcdBarrier bar = xcd_barrier_post((unsigned*)(F.ctl + CW_BAR), F.MISC + 8);
#define GRID_BAR() xcd_barrier(bar)
    unsigned char* ws = args.ws;
    bf16* const H = (bf16*)(ws + WS_H); bf16* const Qb = (bf16*)(ws + WS_Q); bf16* const Kb = (bf16*)(ws + WS_K); bf16* const Vb = (bf16*)(ws + WS_V);
    h16s* const PR = (h16s*)(ws + WS_PR); bf16* const ORW = (bf16*)(ws + WS_ORW); bf16* const MID = (bf16*)(ws + WS_MID);
    const float* const MOD = (const float*)(ws + WS_MOD);

#ifndef PHMASK
#define PHMASK 0xffffffffu
#endif
#define PH(n) RELANE(); if constexpr ((PHMASK >> (n)) & 1u)
#define RELANE() do { int t_ = threadIdx.x; asm volatile("" : "+v"(t_)); F.tid = t_; F.lane = t_ & 63; } while (0)
    PH(0) p0_prologue(F, A); GRID_BAR();
    PH(1) p0b_mod_finalize(F, A); GRID_BAR();

    const bool flip = ((int)blockIdx.x & 1) != 0;
    int two = 2; asm volatile("" : "+s"(two));
    bf16* const HLAT = (bf16*)(ws + WS_HLAT);
    PH(2) modnorm_rows<false>(F, A.in[I_XP], T_CTX, A.in[I_N1], 0, DM, 0, L_CTX, 0, H); GRID_BAR();
    for (int g = 0; g < 2; ++g) {
        const int M = g ? T_LAT : T_CTX, L = g ? L_LAT : L_CTX, jbase = g, jmul = g, ppb = L / 256;
        const float* X = g ? A.in[I_XS] : A.in[I_XP]; float* Y = F.out + O_Y + (g ? (size_t)T_CTX * DM : 0); bf16* PG = (bf16*)Y;
        PH(3) { pg8::Gemm gm{g ? HLAT : H, (const bf16*)(ws + WS_WIN), M, N_IN_P, DM}; pg8::StaticOrder S; S.init(M, N_IN_P, F.G, (int)blockIdx.x);
          pg8::EpiProj E{Qb, Kb, Vb, PR, PG, g ? nullptr : F.out + O_NK, g ? nullptr : F.out + O_NV};
          pg8::gemm_phase<pg8::EpiProj, pg8::StaticOrder, true, true>(F.lds + RING_OFF, gm, S, E); }
        if (g == 0) { __syncthreads(); PH(16) { const int nextra = ((T_CTX / 256) * (N_IN_P / 256)) % F.G, bx = (int)blockIdx.x;
              if (nextra == 0) late_weight_copies(F, A, bx, F.G); else if (bx >= nextra) late_weight_copies(F, A, bx - nextra, F.G - nextra); } }
        GRID_BAR();
        bf16* const Ob = Qb;
        const int nseq = g ? B_LAT : B_CTX;
        h16s *RS = (h16s*)(ws + WS_RS), *KS = (h16s*)(ws + WS_KS), *VS = (h16s*)(ws + WS_VS), *KKb = (h16s*)(ws + WS_KK), *DF = (h16s*)(ws + WS_DF), *DB = (h16s*)(ws + WS_DB), *AF = (h16s*)(ws + WS_AF), *AB = (h16s*)(ws + WS_AB);
        h16s *LG = (h16s*)(ws + WS_LG), *YF = (h16s*)(ws + WS_YF), *YB = (h16s*)(ws + (g ? WS_YB_LAT : WS_YB_CTX)); bf16* LA = (bf16*)(ws + WS_LA);
        for (int ph = 0; ph < two; ++ph) {
          if ((ph == 0) != flip) {
            PH(4) { if (g == 0) { for (int u = F.vcu; u < B_CTX * NH_A; u += F.G) { const int b = u >> 4, h = u & 15; const size_t base = (size_t)b * L_CTX * 2048 + h * 128;
                    att::attn_unit(F.lds + RING_OFF, Qb + base, Ob + base, Kb, Vb, 0, 0, 0, Kb + base, Vb + base, nullptr); } }
            else { const bf16* CK = (const bf16*)(ws + WS_CK); const bf16* CV = (const bf16*)(ws + WS_CV);
                for (int u = F.vcu; u < B_LAT * NH_A * 16; u += F.G) { const int rg = u & 15, h = (u >> 4) & 15, b = u >> 8; const int r0 = 4 * rg, rho0 = min(max(r0 - 4, 0), 56), rho1 = min(max(r0 - 1, 0), 56) + 8;
                    const size_t qbase = ((size_t)b * L_LAT + (size_t)rg * 256) * 2048 + h * 128, lbase = ((size_t)b * L_LAT + (size_t)rho0 * 64) * 2048 + h * 128, cbase = (size_t)b * 256 * 2048 + h * 128;
                    att::attn_unit(F.lds + RING_OFF, Qb + qbase, Ob + qbase, Kb + lbase, Vb + lbase, rho1 - rho0, rho0, r0, CK + cbase, CV + cbase, A.in[I_RPB] + h * 15 * 31); } } }
          } else { PH(5) rwkv_prep(F, A, PR, 0, M, L, RS, KS, VS, KKb, LA); }
        }
        GRID_BAR();
        {   int klora = 256; asm volatile("" : "+s"(klora));
            PH(6) { pg8::Gemm gm{LA, (const bf16*)(ws + WS_WLORA), M, 8192, klora}; pg8::StaticOrder S; S.init(M, 8192, F.G, (int)blockIdx.x);
              pg8::EpiLora E{{DF, DB, AF, AB, LG}, A.in[I_W0], A.in[I_A0], 0};
              pg8::gemm_phase<pg8::EpiLora, pg8::StaticOrder, true, true>(F.lds + RING_OFF, gm, S, E); }
            PH(6) { pg8::Gemm gm{LA + (size_t)M * 256, (const bf16*)(ws + WS_WLORA) + (size_t)8192 * 256, M, 2048, klora}; pg8::StaticOrder S; S.init(M, 2048, F.G, (int)blockIdx.x);
              pg8::EpiLora E{{DF, DB, AF, AB, LG}, A.in[I_W0], A.in[I_A0], 4};
              pg8::gemm_phase<pg8::EpiLora, pg8::StaticOrder, true, true>(F.lds + RING_OFF, gm, S, E); }
            GRID_BAR();
            PH(7) rwkv_scan(F, A, nseq, L, 0, g != 0, RS, KS, VS, KKb, DF, DB, AF, AB, YF, YB, g ? nullptr : F.out + O_SF, g ? nullptr : F.out + O_SB);
            GRID_BAR();
        }
        for (int ph = 0; ph < two; ++ph) {
          if ((ph == 0) != flip) {
            PH(9) { pg8::Gemm gm{Qb, (const bf16*)(ws + WS_WOA), M, DM, D_ATT}; pg8::StaticOrder S; S.init(M, DM, F.G, (int)blockIdx.x);
              pg8::EpiGate<false> E{MID, PG, 0};
              pg8::gemm_phase<pg8::EpiGate<false>, pg8::StaticOrder, true, true>(F.lds + RING_OFF, gm, S, E); }
          } else { PH(8) rwkv_post(F, A, M, RS, KS, VS, AF, AB, LG, YF, YB, ORW); }
        }
        GRID_BAR();
        PH(10) { pg8::Gemm gm{ORW, (const bf16*)(ws + WS_WOR), M, DM, D_RW}; pg8::StaticOrder S; S.init(M, DM, F.G, (int)blockIdx.x);
          pg8::EpiGate<true> E{MID, PG, DM};
          pg8::gemm_phase<pg8::EpiGate<true>, pg8::StaticOrder, true, true>(F.lds + RING_OFF, gm, S, E); }
        GRID_BAR();
        for (int ph = 0; ph < two; ++ph) {
          if ((ph == 0) != flip) {
            PH(11) { pg8::Gemm gm{MID, (const bf16*)(ws + WS_WOUT), M, DM, DM}; pg8::StaticOrder S; S.init(M, DM, F.G, (int)blockIdx.x);
              pg8::EpiResid<true> E{X, (bf16*)Y, MOD + 2 * DM, jbase, ppb, jmul};
              pg8::gemm_phase<pg8::EpiResid<true>, pg8::StaticOrder, true, true>(F.lds + RING_OFF, gm, S, E); }
          } else if (g == 0) { PH(2) modnorm_rows<false>(F, A.in[I_XS], T_LAT, A.in[I_N1], 0, DM, 1, L_LAT, 1, HLAT); }
        }
        GRID_BAR();
    }
    { int six = 6; asm volatile("" : "+s"(six));
      for (int st = 0; st < six; ++st) {
        for (int ph = 0; ph < two; ++ph) {
          if ((ph == 0) != flip) {
            const int gg = (st == 2 || st == 3) ? 1 : 0, Mg = gg ? T_LAT : T_CTX;
            if (st == 1 || st == 2) {
              PH(13) { pg8::Gemm gm{(const bf16*)(F.ws + (gg ? WS_H2L : WS_H2C)), (const bf16*)(F.ws + WS_WM1), Mg, D_FF, DM}; pg8::StaticOrder S; S.init(Mg, D_FF, F.G, (int)blockIdx.x);
                pg8::EpiRelu2 E{(bf16*)(F.ws + (gg ? WS_UL : WS_UC))};
                pg8::gemm_phase<pg8::EpiRelu2, pg8::StaticOrder, true, true>(F.lds + RING_OFF, gm, S, E); }
            } else if (st == 3 || st == 4) {
              PH(14) { pg8::Gemm gm{(const bf16*)(F.ws + (gg ? WS_UL : WS_UC)), (const bf16*)(F.ws + WS_WM2), Mg, DM, D_FF}; pg8::StaticOrder S; S.init(Mg, DM, F.G, (int)blockIdx.x);
                pg8::EpiResid<false> E{nullptr, (bf16*)(F.out + O_Y + (gg ? (size_t)T_CTX * DM : 0)), (const float*)(F.ws + WS_MOD) + 5 * DM, gg, (gg ? L_LAT : L_CTX) / 256, gg};
                pg8::gemm_phase<pg8::EpiResid<false>, pg8::StaticOrder, true, true>(F.lds + RING_OFF, gm, S, E); }
            }
          } else {
            const int gm_ = (st == 1 || st == 4) ? 1 : 0, Mm = gm_ ? T_LAT : T_CTX; float* const Ym = F.out + O_Y + (gm_ ? (size_t)T_CTX * DM : 0);
            if (st < 2) { PH(12) modnorm16_rows(F, (const h16s*)Ym, Mm, A.in[I_N2], 3 * DM, 4 * DM, gm_, gm_ ? L_LAT : L_CTX, gm_, (bf16*)(F.ws + (gm_ ? WS_H2L : WS_H2C))); }
            else if (st >= 4) { PH(15) final16_rows(F, Ym, Mm, A.in[I_NF]); }
          }
        }
        if (st < 5) GRID_BAR();
      }
    }
#undef GRID_BAR
}

extern "C" void kernel_launch(void* const* d_in, const int* in_sizes, int n_in, void* d_out, int out_size, void* d_ws, size_t ws_size, hipStream_t stream) {
    static int grid = 0;
    if (grid == 0) {
        if (n_in != 31 || ws_size < WS_END) { fprintf(stderr, "kernel_launch: need 31 inputs and >= %zu bytes of workspace; got %d, %zu\n", (size_t)WS_END, n_in, ws_size); grid = -1; return; }
        int dev = 0, cus = 0, per_cu = 0;
        if (hipGetDevice(&dev) != hipSuccess || hipDeviceGetAttribute(&cus, hipDeviceAttributeMultiprocessorCount, dev) != hipSuccess) { grid = -1; return; }
        if (hipFuncSetAttribute((const void*)fwd_kernel, hipFuncAttributeMaxDynamicSharedMemorySize, LDS_BYTES) != hipSuccess) { fprintf(stderr, "kernel_launch: hipFuncSetAttribute failed\n"); grid = -1; return; }
        if (hipOccupancyMaxActiveBlocksPerMultiprocessor(&per_cu, (const void*)fwd_kernel, NWAVES * 64, LDS_BYTES) != hipSuccess || per_cu < 1) fprintf(stderr, "kernel_launch: occupancy query reports %d\n", per_cu);
        (void)hipGetLastError();
        grid = cus;
    }
    if (grid < 0) return;
    if (hipMemsetAsync((char*)d_ws + WS_CTL, 0, CTL_ZERO_BYTES, stream) != hipSuccess) return;
    Args a{};
    for (int i = 0; i < 31; ++i) a.in[i] = (const float*)d_in[i];
    a.out = (float*)d_out; a.ws = (unsigned char*)d_ws;
    hipLaunchKernelGGL(fwd_kernel, dim3(grid), dim3(NWAVES * 64), LDS_BYTES, stream, a);
    const hipError_t le = hipPeekAtLastError();
    if (le != hipSuccess) fprintf(stderr, "kernel_launch: launch failed: %s\n", hipGetErrorName(le));
}
```

```cpp
#include <hip/hip_runtime.h>
#include <cstdio>
#include <cstdint>
namespace pg8 {
#define PG8_LAS __attribute__((address_space(3)))
typedef unsigned short bf16_t;
typedef short bf16x8 __attribute__((ext_vector_type(8)));
typedef float f32x4 __attribute__((ext_vector_type(4)));
typedef unsigned u32x4 __attribute__((ext_vector_type(4)));
constexpr int BM = 256, BK = 64, HALF = 128, HTB = HALF * BK * 2  , STAGE_BYTES = 8 * HTB, NXCD = 8, WGM = 8;

__host__ __device__ __forceinline__ int lds_byte(int r, int c) { const int st = (r >> 4) * 2 + (c >> 5), rr = r & 15, cc = c & 31, ob = rr * 64 + cc * 2; return st * 1024 + (ob ^ (((ob >> 9) & 1) << 5)); }
__host__ __device__ __forceinline__ void stage_rc(int b, int& R, int& C) { const int st = b / 1024, sb = b % 1024, swz = sb ^ (((sb >> 9) & 1) << 5); R = (st >> 1) * 16 + swz / 64; C = (st & 1) * 32 + (swz % 64) / 2; }
__host__ __device__ __forceinline__ int perm32(int rho) { const int n = rho >> 4, i = rho & 15; return 8 * (i >> 2) + 4 * n + (i & 3); }

struct Unit { int pm, pn; };
struct Gemm { const bf16_t* A; const bf16_t* Bt; int M, N, K; };

struct StaticOrder {
    int nM, nN, nwg, G, c;
    __host__ __device__ void init(int M, int N, int G_, int c_) { nM = M / BM; nN = N / BM; nwg = nM * nN; G = G_; c = c_; }
    __host__ __device__ bool next(int i, Unit& u) const {
        const long L = (long)i * G + c; if (L >= nwg) return false;
        int wgid = (int)L; { const int q = nwg / NXCD, r = nwg % NXCD, xcd = wgid % NXCD, off = wgid / NXCD; wgid = (xcd < r ? xcd * (q + 1) : r * (q + 1) + (xcd - r) * q) + off; }
        const int nig = WGM * nN, gid = wgid / nig, fm = gid * WGM, gsz = (nM - fm) < WGM ? (nM - fm) : WGM;
        u.pm = fm + ((wgid % nig) % gsz); u.pn = (wgid % nig) / gsz; return true;
    }
    __device__ __forceinline__ void a_ready(const Unit&) const {}
    __device__ __forceinline__ void done(const Unit&) const {}
};

__device__ __forceinline__ unsigned cvt_pk_bf16(float lo, float hi) { unsigned r; asm volatile("v_cvt_pk_bf16_f32 %0, %1, %2" : "=v"(r) : "v"(lo), "v"(hi)); return r; }
typedef _Float16 h16x2 __attribute__((ext_vector_type(2)));
__device__ __forceinline__ unsigned cvt_pk_f16(float lo, float hi) { h16x2 v = {(_Float16)lo, (_Float16)hi}; return __builtin_bit_cast(unsigned, v); }
__device__ __forceinline__ float sigmoidf_(float x) { return __builtin_amdgcn_rcpf(1.0f + __builtin_amdgcn_exp2f(-1.4426950408889634f * x)); }
__device__ __forceinline__ float bf_lo(unsigned u) { return __builtin_bit_cast(float, u << 16); }
__device__ __forceinline__ float bf_hi(unsigned u) { return __builtin_bit_cast(float, u & 0xffff0000u); }

struct EpiProj {
    static constexpr bool PERM = true, AFTER_DRAIN = false;
    bf16_t *Q, *K, *V, *PR, *PG; float *NK, *NV;
    __device__ __forceinline__ void operator()(const f32x4 (&acc)[2][2][4][2], const Unit& u, int wr, int wc, int fr, int fq) const {
        const int row0 = u.pm * BM + wr * 64 + fr, pn = u.pn;
        bf16_t* base; int ld, colt, mode = 0; float* fb = nullptr;
        if (pn < 8) { base = Q; ld = 2048; colt = pn * 256; }
        else if (pn < 16) { base = K; ld = 2048; colt = (pn - 8) * 256; fb = NK; }
        else if (pn < 24) { base = V; ld = 2048; colt = (pn - 16) * 256; fb = NV; }
        else if (pn < 50) { base = PR; ld = 6656; colt = (pn - 24) * 256; mode = 1; }
        else { base = PG; ld = 8192; colt = (pn - 50) * 256; mode = 2; }
        const int col0 = colt + wc * 32 + 8 * fq;
#pragma unroll
        for (int ai = 0; ai < 2; ++ai)
#pragma unroll
            for (int m = 0; m < 4; ++m) { const size_t r = (size_t)(row0 + ai * HALF + m * 16); bf16_t* rowp = base + r * ld + col0;
#pragma unroll
                for (int bj = 0; bj < 2; ++bj) { f32x4 v0 = acc[ai][bj][m][0], v1 = acc[ai][bj][m][1]; u32x4 w;
                    if (mode == 2) { v0 = (f32x4){sigmoidf_(v0[0]), sigmoidf_(v0[1]), sigmoidf_(v0[2]), sigmoidf_(v0[3])}; v1 = (f32x4){sigmoidf_(v1[0]), sigmoidf_(v1[1]), sigmoidf_(v1[2]), sigmoidf_(v1[3])}; }
                    if (mode == 1) { w.x = cvt_pk_f16(v0[0], v0[1]); w.y = cvt_pk_f16(v0[2], v0[3]); w.z = cvt_pk_f16(v1[0], v1[1]); w.w = cvt_pk_f16(v1[2], v1[3]); }
                    else { w.x = cvt_pk_bf16(v0[0], v0[1]); w.y = cvt_pk_bf16(v0[2], v0[3]); w.z = cvt_pk_bf16(v1[0], v1[1]); w.w = cvt_pk_bf16(v1[2], v1[3]); }
                    *(u32x4*)(rowp + bj * HALF) = w;
                    if (fb) { float* fp = fb + r * 2048 + col0 + bj * HALF; *(f32x4*)fp = v0; *(f32x4*)(fp + 4) = v1; } } }
    }
};
struct EpiLora {
    static constexpr bool PERM = true, AFTER_DRAIN = false;
    bf16_t* OUT[5]; const float *w0, *a0; int selb;
    __device__ __forceinline__ void operator()(const f32x4 (&acc)[2][2][4][2], const Unit& u, int wr, int wc, int fr, int fq) const {
        const int row0 = u.pm * BM + wr * 64 + fr, sel = selb + (u.pn >> 3), colt = (u.pn & 7) * 256, col0 = colt + wc * 32 + 8 * fq;
        bf16_t* base = sel == 0 ? OUT[0] : sel == 1 ? OUT[1] : sel == 2 ? OUT[2] : sel == 3 ? OUT[3] : OUT[4];
        const float* bias = sel < 2 ? w0 + sel * 2048 : a0 + (sel - 2) * 2048;
        f32x4 bv[2][2];
#pragma unroll
        for (int bj = 0; bj < 2; ++bj)
#pragma unroll
            for (int n = 0; n < 2; ++n) bv[bj][n] = sel < 4 ? *(const f32x4*)(bias + col0 + bj * HALF + 4 * n) : (f32x4){0.f, 0.f, 0.f, 0.f};
#pragma unroll
        for (int ai = 0; ai < 2; ++ai)
#pragma unroll
            for (int m = 0; m < 4; ++m) { bf16_t* rowp = base + (size_t)(row0 + ai * HALF + m * 16) * 2048 + col0;
#pragma unroll
                for (int bj = 0; bj < 2; ++bj) { f32x4 v0 = acc[ai][bj][m][0] + bv[bj][0], v1 = acc[ai][bj][m][1] + bv[bj][1];
                    if (sel < 4) {
#pragma unroll
                        for (int e = 0; e < 4; ++e) { v0[e] = sigmoidf_(v0[e]); v1[e] = sigmoidf_(v1[e]); }
                        if (sel < 2) {
#pragma unroll
                            for (int e = 0; e < 4; ++e) { v0[e] = __builtin_amdgcn_exp2f(-0.87503716f * v0[e]); v1[e] = __builtin_amdgcn_exp2f(-0.87503716f * v1[e]); } } }
                    u32x4 w; w.x = cvt_pk_f16(v0[0], v0[1]); w.y = cvt_pk_f16(v0[2], v0[3]); w.z = cvt_pk_f16(v1[0], v1[1]); w.w = cvt_pk_f16(v1[2], v1[3]);
                    *(u32x4*)(rowp + bj * HALF) = w; } }
    }
};
template <bool ADD> struct EpiGate {
    static constexpr bool PERM = true, AFTER_DRAIN = false;
    bf16_t* O; const bf16_t* G; int goff;
    __device__ __forceinline__ void operator()(const f32x4 (&acc)[2][2][4][2], const Unit& u, int wr, int wc, int fr, int fq) const {
        const int row0 = u.pm * BM + wr * 64 + fr, col0 = u.pn * BM + wc * 32 + 8 * fq;
#pragma unroll
        for (int ai = 0; ai < 2; ++ai)
#pragma unroll
            for (int m = 0; m < 4; ++m) { const size_t r = (size_t)(row0 + ai * HALF + m * 16); bf16_t* rowp = O + r * 4096 + col0; const bf16_t* gp = G + r * 8192 + goff + col0;
#pragma unroll
                for (int bj = 0; bj < 2; ++bj) { const u32x4 g = *(const u32x4*)(gp + bj * HALF); const f32x4 a0 = acc[ai][bj][m][0], a1 = acc[ai][bj][m][1];
                    float o[8] = {a0[0] * bf_lo(g.x), a0[1] * bf_hi(g.x), a0[2] * bf_lo(g.y), a0[3] * bf_hi(g.y), a1[0] * bf_lo(g.z), a1[1] * bf_hi(g.z), a1[2] * bf_lo(g.w), a1[3] * bf_hi(g.w)};
                    if (ADD) { const u32x4 p = *(const u32x4*)(rowp + bj * HALF); o[0] += bf_lo(p.x); o[1] += bf_hi(p.x); o[2] += bf_lo(p.y); o[3] += bf_hi(p.y); o[4] += bf_lo(p.z); o[5] += bf_hi(p.z); o[6] += bf_lo(p.w); o[7] += bf_hi(p.w); }
                    u32x4 w; w.x = cvt_pk_bf16(o[0], o[1]); w.y = cvt_pk_bf16(o[2], o[3]); w.z = cvt_pk_bf16(o[4], o[5]); w.w = cvt_pk_bf16(o[6], o[7]);
                    *(u32x4*)(rowp + bj * HALF) = w; } }
    }
};
__device__ __forceinline__ f32x4 h4lo(unsigned a, unsigned b) { typedef _Float16 hh2 __attribute__((ext_vector_type(2))); const hh2 x = __builtin_bit_cast(hh2, a), y = __builtin_bit_cast(hh2, b); return (f32x4){(float)x.x, (float)x.y, (float)y.x, (float)y.y}; }
template <bool RF32> struct EpiResid {
    static constexpr bool PERM = true, AFTER_DRAIN = false;
    const float* R32; bf16_t* XH; const float* gt; int jbase, ppb, jmul;
    __device__ __forceinline__ void operator()(const f32x4 (&acc)[2][2][4][2], const Unit& u, int wr, int wc, int fr, int fq) const {
        const int row0 = u.pm * BM + wr * 64 + fr, col0 = u.pn * BM + wc * 32 + 8 * fq;
        const float* g = gt + (size_t)(jbase + (u.pm / ppb) * jmul) * 24576 + col0;
        f32x4 gv[2][2];
#pragma unroll
        for (int bj = 0; bj < 2; ++bj)
#pragma unroll
            for (int n = 0; n < 2; ++n) gv[bj][n] = *(const f32x4*)(g + bj * HALF + 4 * n);
#pragma unroll
        for (int ai = 0; ai < 2; ++ai)
#pragma unroll
            for (int m = 0; m < 4; ++m) { const size_t row = (size_t)(row0 + ai * HALF + m * 16); bf16_t* xp = XH + row * 8192 + col0;
#pragma unroll
                for (int bj = 0; bj < 2; ++bj) { f32x4 r0, r1;
                    if (RF32) { const float* rp = R32 + row * 4096 + col0 + bj * HALF; r0 = *(const f32x4*)rp; r1 = *(const f32x4*)(rp + 4); }
                    else { const u32x4 h = *(const u32x4*)(xp + bj * HALF); r0 = h4lo(h.x, h.y); r1 = h4lo(h.z, h.w); }
                    const f32x4 y0 = r0 + gv[bj][0] * acc[ai][bj][m][0], y1 = r1 + gv[bj][1] * acc[ai][bj][m][1];
                    u32x4 w; w.x = cvt_pk_f16(y0[0], y0[1]); w.y = cvt_pk_f16(y0[2], y0[3]); w.z = cvt_pk_f16(y1[0], y1[1]); w.w = cvt_pk_f16(y1[2], y1[3]);
                    *(u32x4*)(xp + bj * HALF) = w; } }
    }
};
struct EpiRelu2 {
    static constexpr bool PERM = true, AFTER_DRAIN = false;
    bf16_t* U;
    __device__ __forceinline__ void operator()(const f32x4 (&acc)[2][2][4][2], const Unit& u, int wr, int wc, int fr, int fq) const {
        const int row0 = u.pm * BM + wr * 64 + fr, col0 = u.pn * BM + wc * 32 + 8 * fq;
#pragma unroll
        for (int ai = 0; ai < 2; ++ai)
#pragma unroll
            for (int m = 0; m < 4; ++m) { bf16_t* rowp = U + (size_t)(row0 + ai * HALF + m * 16) * 16384 + col0;
#pragma unroll
                for (int bj = 0; bj < 2; ++bj) { f32x4 v0 = acc[ai][bj][m][0], v1 = acc[ai][bj][m][1];
#pragma unroll
                    for (int e = 0; e < 4; ++e) { const float a = fmaxf(v0[e], 0.f), b = fmaxf(v1[e], 0.f); v0[e] = a * a; v1[e] = b * b; }
                    u32x4 w; w.x = cvt_pk_bf16(v0[0], v0[1]); w.y = cvt_pk_bf16(v0[2], v0[3]); w.z = cvt_pk_bf16(v1[0], v1[1]); w.w = cvt_pk_bf16(v1[2], v1[3]);
                    *(u32x4*)(rowp + bj * HALF) = w; } }
    }
};

template <class Epi, class Sched, bool ALIGN_EPI = false, bool SP2 = false>
__device__ __forceinline__ void gemm_phase(PG8_LAS unsigned char* lds, const Gemm g, const Sched& S, const Epi& E) {
    int tid_ = threadIdx.x; asm volatile("" : "+v"(tid_));
    const int tid = tid_, wid = __builtin_amdgcn_readfirstlane(tid >> 6), lane = tid & 63, wr = wid >> 2, wc = wid & 3, fr = lane & 15, fq = lane >> 4;
    const int K = g.K, nt = K / BK;
    unsigned voffA[2], voffB[2];
#pragma unroll
    for (int i = 0; i < 2; ++i) { int R, C; stage_rc(tid * 16 + i * 8192, R, C); const int Rb = Epi::PERM ? ((R & ~31) + perm32(R & 31)) : R;
        voffA[i] = (unsigned)(R * K + C) * 2u; voffB[i] = (unsigned)(Rb * K + C) * 2u; }
    const size_t kstep = (size_t)(BK * 2);
    const size_t hstep = (size_t)HALF * K * 2;
    const size_t tstep = 2 * hstep;
    const unsigned ldsw = (unsigned)wid * 1024u;
    const int aoff = lds_byte(wr * 64 + fr, fq * 8), boff = lds_byte(wc * 32 + fr, fq * 8);
#define PG8_SA(b, h) (((b) * 2 + (h)) * HTB)
#define PG8_SB(b, h) ((4 + (b) * 2 + (h)) * HTB)
#define PG8_STAGE(bufoff, gbase, voff) do { _Pragma("unroll") for (int _i = 0; _i < 2; ++_i) \
        __builtin_amdgcn_global_load_lds((const unsigned*)((const char*)(gbase) + (voff)[_i]), (PG8_LAS unsigned*)(lds + (bufoff) + ldsw + _i * 8192), 16, 0, 0); } while (0)
#define PG8_LDA(dst, b, h) do { _Pragma("unroll") for (int m = 0; m < 4; ++m) _Pragma("unroll") for (int k = 0; k < 2; ++k) dst[m][k] = *(const PG8_LAS bf16x8*)(lds + PG8_SA(b, h) + aoff + m * 2048 + k * 1024); } while (0)
#define PG8_LDB(dst, b, h) do { _Pragma("unroll") for (int n = 0; n < 2; ++n) _Pragma("unroll") for (int k = 0; k < 2; ++k) dst[n][k] = *(const PG8_LAS bf16x8*)(lds + PG8_SB(b, h) + boff + n * 2048 + k * 1024); } while (0)
#define PG8_MMA(ai, bj, At, Bt) do { __builtin_amdgcn_s_setprio(1); _Pragma("unroll") for (int m = 0; m < 4; ++m) _Pragma("unroll") for (int n = 0; n < 2; ++n) _Pragma("unroll") for (int k = 0; k < 2; ++k) \
        acc[ai][bj][m][n] = __builtin_amdgcn_mfma_f32_16x16x32_bf16(Bt[n][k], At[m][k], acc[ai][bj][m][n], 0, 0, 0); __builtin_amdgcn_s_setprio(0); } while (0)
#define PG8_WAIT_V(n) asm volatile("s_waitcnt vmcnt(" #n ")" ::: "memory")
#define PG8_WAIT_L(n) asm volatile("s_waitcnt lgkmcnt(" #n ")" ::: "memory")
#define PG8_BAR __builtin_amdgcn_s_barrier()
#define PG8_SCHED __builtin_amdgcn_sched_barrier(0)
    Unit cur, nxt; int ui = 0;
    if (!S.next(0, cur)) return;
    f32x4 acc[2][2][4][2];
#pragma unroll
    for (int a = 0; a < 2; ++a)
#pragma unroll
        for (int b = 0; b < 2; ++b)
#pragma unroll
            for (int m = 0; m < 4; ++m)
#pragma unroll
                for (int n = 0; n < 2; ++n) acc[a][b][m][n] = (f32x4){0.f, 0.f, 0.f, 0.f};
    bf16x8 At[4][2], B0[2][2], B1[2][2];
    const char* cA = (const char*)g.A + (size_t)cur.pm * tstep; const char* cB = (const char*)g.Bt + (size_t)cur.pn * tstep;
    S.a_ready(cur);
    if constexpr (SP2) {
        PG8_STAGE(PG8_SB(0, 0), cB, voffB); PG8_STAGE(PG8_SB(0, 1), cB + hstep, voffB); PG8_STAGE(PG8_SA(0, 0), cA, voffA); PG8_STAGE(PG8_SA(0, 1), cA + hstep, voffA);
        if (wr == 1) PG8_BAR;
        PG8_WAIT_V(2); PG8_BAR;
        PG8_STAGE(PG8_SB(1, 0), cB + kstep, voffB); PG8_STAGE(PG8_SA(1, 0), cA + kstep, voffA); PG8_STAGE(PG8_SB(1, 1), cB + hstep + kstep, voffB);
        PG8_WAIT_V(6); PG8_BAR;
    } else {
        PG8_STAGE(PG8_SB(0, 0), cB, voffB); PG8_STAGE(PG8_SA(0, 0), cA, voffA); PG8_STAGE(PG8_SB(0, 1), cB + hstep, voffB); PG8_STAGE(PG8_SA(0, 1), cA + hstep, voffA);
        if (wr == 1) PG8_BAR;
        PG8_WAIT_V(4); PG8_BAR;
        PG8_STAGE(PG8_SB(1, 0), cB + kstep, voffB); PG8_STAGE(PG8_SA(1, 0), cA + kstep, voffA); PG8_STAGE(PG8_SB(1, 1), cB + hstep + kstep, voffB);
        PG8_WAIT_V(6); PG8_BAR;
    }
    for (;;) {
        const bool has_next = S.next(ui + 1, nxt);
        const char* nA = has_next ? (const char*)g.A + (size_t)nxt.pm * tstep : cA; const char* nB = has_next ? (const char*)g.Bt + (size_t)nxt.pn * tstep : cB;
        for (int t = 0; t < nt; t += 2) {
            const bool last = (t == nt - 2);
            const char* a1 = cA + (size_t)(t + 1) * kstep;
            const char* a2 = last ? nA : cA + (size_t)(t + 2) * kstep; const char* b2 = last ? nB : cB + (size_t)(t + 2) * kstep;
            const char* a3 = a2 + kstep; const char* b3 = b2 + kstep;
            if (last && has_next) S.a_ready(nxt);
            if constexpr (SP2) {
            PG8_LDB(B0, 0, 0); PG8_LDB(B1, 0, 1); PG8_SCHED; PG8_LDA(At, 0, 0); PG8_STAGE(PG8_SA(1, 1), a1 + hstep, voffA);
            PG8_WAIT_V(8); PG8_WAIT_L(0); PG8_BAR; PG8_MMA(0, 0, At, B0); PG8_MMA(0, 1, At, B1); PG8_BAR; PG8_SCHED;
            PG8_LDA(At, 0, 1); PG8_STAGE(PG8_SB(0, 0), b2, voffB); PG8_STAGE(PG8_SB(0, 1), b2 + hstep, voffB); PG8_STAGE(PG8_SA(0, 0), a2, voffA);
            PG8_WAIT_V(8); PG8_WAIT_L(0); PG8_BAR; PG8_MMA(1, 0, At, B0); PG8_MMA(1, 1, At, B1); PG8_BAR; PG8_SCHED;
            PG8_LDB(B0, 1, 0); PG8_LDB(B1, 1, 1); PG8_SCHED; PG8_LDA(At, 1, 0); PG8_STAGE(PG8_SA(0, 1), a2 + hstep, voffA);
            PG8_WAIT_V(8); PG8_WAIT_L(0); PG8_BAR; PG8_MMA(0, 0, At, B0); PG8_MMA(0, 1, At, B1); PG8_BAR; PG8_SCHED;
            PG8_LDA(At, 1, 1); PG8_STAGE(PG8_SB(1, 0), b3, voffB); PG8_STAGE(PG8_SB(1, 1), b3 + hstep, voffB); PG8_STAGE(PG8_SA(1, 0), a3, voffA);
            PG8_WAIT_V(8); PG8_WAIT_L(0); PG8_BAR; PG8_MMA(1, 0, At, B0); PG8_MMA(1, 1, At, B1); PG8_BAR; PG8_SCHED;
            } else {
            PG8_LDB(B0, 0, 0); PG8_SCHED; PG8_LDA(At, 0, 0); PG8_STAGE(PG8_SA(1, 1), a1 + hstep, voffA);
            PG8_WAIT_L(8); PG8_BAR; PG8_WAIT_L(0); PG8_MMA(0, 0, At, B0); PG8_BAR; PG8_SCHED;
            PG8_LDB(B1, 0, 1); PG8_STAGE(PG8_SB(0, 0), b2, voffB);
            PG8_BAR; PG8_WAIT_L(0); PG8_MMA(0, 1, At, B1); PG8_BAR;
            PG8_LDA(At, 0, 1); PG8_STAGE(PG8_SA(0, 0), a2, voffA);
            PG8_BAR; PG8_WAIT_L(0); PG8_MMA(1, 0, At, B0); PG8_BAR; PG8_SCHED;
            PG8_STAGE(PG8_SB(0, 1), b2 + hstep, voffB);
            PG8_WAIT_V(6); PG8_BAR; PG8_MMA(1, 1, At, B1); PG8_BAR;
            PG8_LDB(B0, 1, 0); PG8_SCHED; PG8_LDA(At, 1, 0); PG8_STAGE(PG8_SA(0, 1), a2 + hstep, voffA);
            PG8_WAIT_L(8); PG8_BAR; PG8_WAIT_L(0); PG8_MMA(0, 0, At, B0); PG8_BAR; PG8_SCHED;
            PG8_LDB(B1, 1, 1); PG8_STAGE(PG8_SB(1, 0), b3, voffB);
            PG8_BAR; PG8_WAIT_L(0); PG8_MMA(0, 1, At, B1); PG8_BAR;
            PG8_LDA(At, 1, 1); PG8_STAGE(PG8_SA(1, 0), a3, voffA);
            PG8_BAR; PG8_WAIT_L(0); PG8_MMA(1, 0, At, B0); PG8_BAR; PG8_SCHED;
            PG8_STAGE(PG8_SB(1, 1), b3 + hstep, voffB);
            PG8_WAIT_V(6); PG8_BAR; PG8_MMA(1, 1, At, B1); PG8_BAR;
            }
        }
        if constexpr (ALIGN_EPI) { if (wr == 0) PG8_BAR; }
        if constexpr (!Epi::AFTER_DRAIN) { E(acc, cur, wr, wc, fr, fq); S.done(cur); }
        if (!has_next) break;
#pragma unroll
        for (int a = 0; a < 2; ++a)
#pragma unroll
            for (int b = 0; b < 2; ++b)
#pragma unroll
                for (int m = 0; m < 4; ++m)
#pragma unroll
                    for (int n = 0; n < 2; ++n) acc[a][b][m][n] = (f32x4){0.f, 0.f, 0.f, 0.f};
        cur = nxt; cA = nA; cB = nB; ++ui;
        if constexpr (ALIGN_EPI) { if (wr == 1) PG8_BAR; }
    }
    PG8_WAIT_V(0);
    if constexpr (!ALIGN_EPI) { if (wr == 0) PG8_BAR; }
    PG8_BAR;
    if constexpr (Epi::AFTER_DRAIN) { E.fused(acc, cur, wr, wc, fr, fq, lds, wid, lane); S.done(cur); }
#undef PG8_SA
#undef PG8_SB
#undef PG8_STAGE
#undef PG8_LDA
#undef PG8_LDB
#undef PG8_MMA
#undef PG8_WAIT_V
#undef PG8_WAIT_L
#undef PG8_BAR
#undef PG8_SCHED
}
}


constexpr int NWAVES = 8;
constexpr int DM = 4096, T_CTX = 8192, T_LAT = 32768, L_CTX = 256, L_LAT = 4096, B_CTX = 32, B_LAT = 8;
constexpr int NH_A = 16, DH_A = 128, D_ATT = 2048, NH_R = 32, DH_R = 64, D_RW = 2048;
constexpr int C_RWKV = 6592, C_RWKV_P = 6656, D_IN = 20928, N_IN_P = 20992, D_FF = 16384, N_LORA = 10240, K_LORA = 512, NMOD = 24576;
constexpr float RMS_EPS = 1e-6f, LNX_EPS = 64e-5f;
constexpr size_t MiB = 1u << 20;
constexpr size_t WS_CTL = 0, CTL_ZERO_BYTES = 1 * MiB;
constexpr size_t WS_MODP = 1 * MiB;
constexpr size_t WS_MOD = 8 * MiB;
constexpr size_t WS_WIN = 9 * MiB;
constexpr size_t WS_WOA = 173 * MiB, WS_WOR = 189 * MiB, WS_WOUT = 205 * MiB;
constexpr size_t WS_WM1 = 237 * MiB, WS_WM2 = 365 * MiB;
constexpr size_t WS_WLORA = 493 * MiB;
constexpr size_t WS_CK = 503 * MiB, WS_CV = 511 * MiB;
constexpr size_t WS_H = 520 * MiB;
constexpr size_t WS_Q = 776 * MiB, WS_K = 904 * MiB, WS_V = 1032 * MiB;
constexpr size_t WS_PR = 1160 * MiB;
constexpr size_t WS_ORW = 1832 * MiB;
constexpr size_t WS_HLAT = 1576 * MiB;
constexpr size_t WS_MID = 1160 * MiB;
constexpr size_t WS_H2L = 512 * MiB, WS_UL = 768 * MiB;
constexpr size_t WS_H2C = 1416 * MiB, WS_UC = 1792 * MiB;
constexpr size_t WS_END = 2048 * MiB;
constexpr size_t WS_RS = 520 * MiB, WS_KS = 648 * MiB, WS_VS = 1576 * MiB, WS_KK = 1704 * MiB;
constexpr size_t WS_DF = 1160 * MiB, WS_DB = 1288 * MiB, WS_AF = 1416 * MiB, WS_YF = WS_ORW, WS_AB = WS_K, WS_LG = WS_V;
constexpr size_t WS_YB_CTX = 1960 * MiB, WS_YB_LAT = WS_WIN, WS_LA = 2016 * MiB;
static_assert(WS_UL + (size_t)T_LAT * D_FF * 2 <= WS_UC && WS_UC + (size_t)T_CTX * D_FF * 2 <= WS_END && WS_H2L + (size_t)T_LAT * DM * 2 <= WS_UL && WS_LA + (size_t)T_LAT * K_LORA * 2 <= WS_END && WS_YB_CTX + (size_t)T_CTX * D_RW * 2 <= WS_LA && WS_YF + (size_t)T_LAT * D_RW * 2 <= WS_YB_CTX && WS_MID + (size_t)T_LAT * DM * 2 <= WS_AF, "d_ws map");
constexpr int CW_BAR = 4096;
constexpr int RING_OFF = 0, RING_BYTES = 131072;
constexpr int LDSCTL_OFF = RING_BYTES, MISC_OFF = LDSCTL_OFF + 320;
constexpr int LDS_BYTES = 147456;

#define GAS __attribute__((address_space(1)))
#define LAS __attribute__((address_space(3)))
typedef unsigned short bf16;
typedef unsigned v4u __attribute__((ext_vector_type(4)));
typedef float f32x4 __attribute__((ext_vector_type(4)));
typedef short bf16x8 __attribute__((ext_vector_type(8)));
typedef GAS unsigned gu32;
typedef GAS unsigned long long gu64;
#define RLX_AGENT __ATOMIC_RELAXED, __HIP_MEMORY_SCOPE_AGENT
#define LDS_WAIT() asm volatile("s_waitcnt lgkmcnt(0)" ::: "memory")
#define VM_WAIT() asm volatile("s_waitcnt vmcnt(0)" ::: "memory")
__device__ __forceinline__ unsigned long long rt() { return __builtin_amdgcn_s_memrealtime(); }
__device__ __forceinline__ unsigned f2bf(float f) { unsigned u = __builtin_bit_cast(unsigned, f); return (u + 0x7fffu + ((u >> 16) & 1u)) >> 16; }
__device__ __forceinline__ unsigned pk2(float lo, float hi) { return f2bf(lo) | (f2bf(hi) << 16); }

#define XB_TMO      128
#define XB_XCNT(j)  (256  + 64 * (j))
#define XB_XSUB(j)  (1280 + 64 * (j))
#define XB_XGEN(j)  (2304 + 64 * (j))
#define XB_TOP      3328
#define XB_TOPGEN   3392
#define XCD_BAR_WORDS 3456
#define XB_SPIN_CAP (1u << 18)

__device__ __forceinline__ unsigned xb_ld(unsigned* p)              { return __hip_atomic_load(p, __ATOMIC_RELAXED, __HIP_MEMORY_SCOPE_AGENT); }
__device__ __forceinline__ unsigned xb_add(unsigned* p, unsigned v) { return __hip_atomic_fetch_add(p, v, __ATOMIC_RELAXED, __HIP_MEMORY_SCOPE_AGENT); }
__device__ __forceinline__ unsigned xb_xcc_id() { return (unsigned)__builtin_amdgcn_s_getreg((3 << 11) | 20) & 0xFu; }
#define XB_SPIN(cond, bar) do { unsigned _sp = 0; while (cond) { __builtin_amdgcn_s_sleep(1); \
    if ((++_sp & 255u) == 0u) { if (xb_ld(&(bar)[XB_TMO])) break; if (_sp > XB_SPIN_CAP) { atomicAdd(&(bar)[XB_TMO], 1u); break; } } } } while (0)

struct XcdBarrier {
    unsigned* bar; unsigned x;
    volatile LAS unsigned* st;
};

__device__ __forceinline__ XcdBarrier xcd_barrier_post(unsigned* bar, volatile LAS unsigned* st) {
    XcdBarrier b; b.bar = bar; b.x = xb_xcc_id(); b.st = st;
    if (threadIdx.x == 0) (void)xb_add(&bar[XB_XCNT(b.x)], 1u);
    return b;
}
__device__ __forceinline__ void xcd_barrier_complete(unsigned* bar, unsigned x, unsigned& nloc, unsigned& nx) {
    const unsigned G = gridDim.x * gridDim.y * gridDim.z;
    unsigned sum, cnt, mine, sp = 0u;
    for (;;) {
        sum = 0u; cnt = 0u; mine = 0u;
#pragma unroll
        for (unsigned j = 0; j < 16; ++j) { const unsigned c = xb_ld(&bar[XB_XCNT(j)]); sum += c; cnt += (c > 0u) ? 1u : 0u; mine = (j == x) ? c : mine; }
        if (sum == G) break;
        __builtin_amdgcn_s_sleep(1);
        if ((++sp & 255u) == 0u) { if (xb_ld(&bar[XB_TMO])) break; if (sp > XB_SPIN_CAP) { atomicAdd(&bar[XB_TMO], 1u); break; } }
    }
    nloc = mine > 0u ? mine : 1u; nx = cnt > 0u ? cnt : 1u;
}

__device__ __forceinline__ void xcd_barrier(const XcdBarrier& b) {
    asm volatile("s_waitcnt vmcnt(0)" ::: "memory");
    __syncthreads();
    if (threadIdx.x == 0) {
        unsigned* bar = b.bar;
        __builtin_amdgcn_s_waitcnt(0);
        unsigned nloc = b.st[0], nx = b.st[1];
        if (nloc == 0u) { xcd_barrier_complete(bar, b.x, nloc, nx); b.st[0] = nloc; b.st[1] = nx; }
        const unsigned old = xb_add(&bar[XB_XSUB(b.x)], 1u);
        const unsigned gen = old / nloc;
        if (old + 1u == (gen + 1u) * nloc) {
            __builtin_amdgcn_fence(__ATOMIC_RELEASE, "agent");
            asm volatile("s_waitcnt vmcnt(0)" ::: "memory");
            const unsigned og = xb_add(&bar[XB_TOP], 1u);
            const unsigned tg = og / nx;
            if (og + 1u == (tg + 1u) * nx) xb_add(&bar[XB_TOPGEN], 1u);
            else XB_SPIN(xb_ld(&bar[XB_TOPGEN]) == tg, bar);
            __builtin_amdgcn_fence(__ATOMIC_ACQUIRE, "agent");
            xb_add(&bar[XB_XGEN(b.x)], 1u);
            asm volatile("s_waitcnt vmcnt(0)" ::: "memory");
        } else {
            XB_SPIN(xb_ld(&bar[XB_XGEN(b.x)]) == gen, bar);
            __builtin_amdgcn_fence(__ATOMIC_ACQUIRE, "agent");
            asm volatile("s_waitcnt vmcnt(0)" ::: "memory");
        }
    }
    __syncthreads();
}

typedef unsigned short h16s;
typedef _Float16 h16x8 __attribute__((ext_vector_type(8)));
typedef float f32x16 __attribute__((ext_vector_type(16)));
typedef short s16x4 __attribute__((ext_vector_type(4)));
struct Frame {
    LAS unsigned char* lds;
    volatile LAS unsigned* MISC;
    gu32* ctl;
    int tid, lane, wave;
    int vcu, G;
    unsigned char* ws;
    float* out;
};
struct Args { const float* in[31]; float* out; unsigned char* ws; };
enum { I_XP = 0, I_XS, I_CK, I_CV, I_SF, I_SB, I_C, I_CCTX, I_WMOD, I_BMOD, I_N1, I_N2, I_NF, I_WIN, I_MU, I_RPB, I_W0, I_W2, I_A0, I_A2, I_G2, I_KK, I_KA, I_RK, I_LNW, I_LNB, I_WOA, I_WOR, I_WOUT, I_WM1, I_WM2 };
constexpr size_t O_Y = 0, O_NK = (size_t)(T_CTX + T_LAT) * DM, O_NV = O_NK + (size_t)T_CTX * D_ATT, O_SF = O_NV + (size_t)T_CTX * D_ATT, O_SB = O_SF + (size_t)B_CTX * NH_R * 64 * 64;

__device__ __forceinline__ float wave_sum(float v) {
#pragma unroll
    for (int o = 1; o < 64; o <<= 1) v += __shfl_xor(v, o);
    return v;
}
__device__ __forceinline__ unsigned pkbf(float lo, float hi) { return pg8::cvt_pk_bf16(lo, hi); }
__device__ __forceinline__ unsigned pkh(float lo, float hi) { return pg8::cvt_pk_f16(lo, hi); }
__device__ __forceinline__ float sigm(float x) { return pg8::sigmoidf_(x); }
__device__ __forceinline__ void unpack_h8(const v4u w, float (&f)[8]) { const h16x8 h = __builtin_bit_cast(h16x8, w);
#pragma unroll
    for (int e = 0; e < 8; ++e) f[e] = (float)h[e]; }

__device__ __forceinline__ void p0_transpose_item(const float* W, int ldw, int col_off, int nblk, bf16* WT, int ldt, int row_off, LAS float* scr, int item, int lane) {
    const int kb = item / nblk, nb = item % nblk, k0 = 64 * kb, n0 = 32 * nb;
    { f32x4 t[8]; const int kr = lane >> 3, nq = (lane & 7) * 4;
#pragma unroll
      for (int i = 0; i < 8; ++i) t[i] = *(const GAS f32x4*)(W + (size_t)(k0 + 8 * i + kr) * ldw + col_off + n0 + nq);
#pragma unroll
      for (int i = 0; i < 8; ++i) { LAS float* d = scr + (8 * i + kr) * 33 + nq; d[0] = t[i].x; d[1] = t[i].y; d[2] = t[i].z; d[3] = t[i].w; } }
    LDS_WAIT(); asm volatile("" ::: "memory");
    const int c = lane & 7;
#pragma unroll
    for (int j = 0; j < 4; ++j) { const int n = (lane >> 3) + 8 * j; const LAS float* s = scr + (8 * c) * 33 + n;
        v4u o; o.x = pkbf(s[0 * 33], s[1 * 33]); o.y = pkbf(s[2 * 33], s[3 * 33]); o.z = pkbf(s[4 * 33], s[5 * 33]); o.w = pkbf(s[6 * 33], s[7 * 33]);
        *(GAS v4u*)(WT + (size_t)(row_off + n0 + n) * ldt + k0 + 8 * c) = o; }
    LDS_WAIT(); asm volatile("" ::: "memory");
}
struct TDesc { const float* W; bf16* WT; int ldw, lgn, ldt, item; };
__device__ __forceinline__ TDesc late_desc(const Args& A, unsigned char* ws, int r) {
    constexpr int E0 = 32 * 128, E1 = E0 + 32 * 128, E2 = E1 + 64 * 128, E3 = E2 + 64 * 512;
    const int sel = (r >= E0) + (r >= E1) + (r >= E2) + (r >= E3);
    const int base = sel == 0 ? 0 : sel == 1 ? E0 : sel == 2 ? E1 : sel == 3 ? E2 : E3;
    const int widx = sel == 0 ? I_WOA : sel == 1 ? I_WOR : sel == 2 ? I_WOUT : sel == 3 ? I_WM1 : I_WM2;
    const size_t woff = sel == 0 ? WS_WOA : sel == 1 ? WS_WOR : sel == 2 ? WS_WOUT : sel == 3 ? WS_WM1 : WS_WM2;
    const int ldw = sel == 3 ? D_FF : DM, lgn = sel == 3 ? 9 : 7, ldt = sel == 0 ? D_ATT : sel == 1 ? D_RW : sel == 4 ? D_FF : DM;
    typedef const float* fptr; const __attribute__((address_space(4))) fptr* kin = (const __attribute__((address_space(4))) fptr*)__builtin_amdgcn_kernarg_segment_ptr();
    return TDesc{kin[widx], (bf16*)(ws + woff), ldw, lgn, ldt, r - base};
}
constexpr int LATE_ITEMS = 32 * 128 + 32 * 128 + 64 * 128 + 64 * 512 + 256 * 128;
__device__ __forceinline__ void late_load(f32x4 (&t)[8], const TDesc& d, int lane) {
    const int kb = d.item >> d.lgn, nb = d.item & ((1 << d.lgn) - 1), k0 = 64 * kb, n0 = 32 * nb, kr = lane >> 3, nq = (lane & 7) * 4;
#pragma unroll
    for (int i = 0; i < 8; ++i) t[i] = *(const GAS f32x4*)(d.W + (size_t)(k0 + 8 * i + kr) * d.ldw + n0 + nq);
}
__device__ __forceinline__ void late_finish(const f32x4 (&t)[8], const TDesc& d, LAS float* scr, int lane) {
    const int kb = d.item >> d.lgn, nb = d.item & ((1 << d.lgn) - 1), k0 = 64 * kb, n0 = 32 * nb, kr = lane >> 3, nq = (lane & 7) * 4;
#pragma unroll
    for (int i = 0; i < 8; ++i) { LAS float* q = scr + (8 * i + kr) * 33 + nq; q[0] = t[i].x; q[1] = t[i].y; q[2] = t[i].z; q[3] = t[i].w; }
    LDS_WAIT(); asm volatile("" ::: "memory");
    const int c = lane & 7;
#pragma unroll
    for (int j = 0; j < 4; ++j) { const int n = (lane >> 3) + 8 * j; const LAS float* sp = scr + (8 * c) * 33 + n;
        v4u o; o.x = pkbf(sp[0 * 33], sp[1 * 33]); o.y = pkbf(sp[2 * 33], sp[3 * 33]); o.z = pkbf(sp[4 * 33], sp[5 * 33]); o.w = pkbf(sp[6 * 33], sp[7 * 33]);
        *(GAS v4u*)(d.WT + (size_t)(n0 + n) * d.ldt + k0 + 8 * c) = o; }
    LDS_WAIT(); asm volatile("" ::: "memory");
}
__device__ __forceinline__ void late_weight_copies(Frame& F, const Args& A, int part, int nparts) {
    LAS float* scr = (LAS float*)(F.lds + RING_OFF + F.wave * 16384);
    int w0 = part * NWAVES + F.wave; const int st = nparts * NWAVES;
    asm volatile("" : "+v"(w0));
    if (w0 >= LATE_ITEMS) return;
    f32x4 ta[8], tb[8], tc[8];
#define LATE_LD(T, IT) late_load(T, late_desc(A, F.ws, min((IT), LATE_ITEMS - 1)), F.lane)
#define LATE_FN(T, IT) late_finish(T, late_desc(A, F.ws, (IT)), scr, F.lane)
    LATE_LD(ta, w0); LATE_LD(tb, w0 + st);
    for (int it = w0;;) {
        LATE_LD(tc, it + 2 * st); LATE_FN(ta, it); if (it + st >= LATE_ITEMS) break;
        LATE_LD(ta, it + 3 * st); LATE_FN(tb, it + st); if (it + 2 * st >= LATE_ITEMS) break;
        LATE_LD(tb, it + 4 * st); LATE_FN(tc, it + 2 * st); if (it + 3 * st >= LATE_ITEMS) break;
        it += 3 * st;
    }
#undef LATE_LD
#undef LATE_FN
}
__device__ __forceinline__ void p0_prologue(Frame& F, const Args& A) {
    const int gw = F.vcu * NWAVES + F.wave, NGW = F.G * NWAVES, gt = gw * 64 + F.lane, NGT = NGW * 64;
    unsigned char* ws = F.ws;
    { LAS float* scr = (LAS float*)(F.lds + RING_OFF + F.wave * 16384);
      constexpr int I_A = 64 * 398, I_B = 64 * 256, NITEMS = I_A + I_B;
      for (int it = gw; it < NITEMS; it += NGW) { int r = it;
          if (r < I_A) { p0_transpose_item(A.in[I_WIN], D_IN, 0, 398, (bf16*)(ws + WS_WIN), DM, 0, scr, r, F.lane); continue; } r -= I_A;
          p0_transpose_item(A.in[I_WIN], D_IN, 12736, 256, (bf16*)(ws + WS_WIN), DM, 12800, scr, r, F.lane);
      } }
    { GAS v4u* p = (GAS v4u*)((bf16*)(ws + WS_WIN) + (size_t)12736 * DM); const int n = 64 * DM / 8; for (int i = gt; i < n; i += NGT) p[i] = (v4u){0u, 0u, 0u, 0u}; }
    { bf16* WL = (bf16*)(ws + WS_WLORA); const float *w2 = A.in[I_W2], *a2 = A.in[I_A2], *g2 = A.in[I_G2];
      for (int i = gt; i < N_LORA * 256 / 2; i += NGT) { const int n = i >> 7, k = (i & 127) * 2; const int sel = n >> 11, col = n & 2047; float v[2];
#pragma unroll
          for (int e = 0; e < 2; ++e) { const int kk = k + e; float x = 0.f;
              if (sel < 2) { if (kk < 96) x = w2[((size_t)sel * 96 + kk) * 2048 + col]; }
              else if (sel < 4) { if (kk >= 96 && kk < 192) x = a2[((size_t)(sel - 2) * 96 + (kk - 96)) * 2048 + col]; }
              else x = g2[(size_t)kk * 2048 + col];
              v[e] = x; }
          ((GAS unsigned*)WL)[i] = pkbf(v[0], v[1]); } }
    { const int n8 = B_LAT * 256 * 2048 / 8;
      for (int i = gt; i < 2 * n8; i += NGT) { const bool isk = i < n8; const int j = isk ? i : i - n8; const float* src = (isk ? A.in[I_CK] : A.in[I_CV]) + (size_t)j * 8;
          const f32x4 a = *(const GAS f32x4*)src, b = *(const GAS f32x4*)(src + 4); v4u o; o.x = pkbf(a.x, a.y); o.y = pkbf(a.z, a.w); o.z = pkbf(b.x, b.y); o.w = pkbf(b.z, b.w);
          *((GAS v4u*)(ws + (isk ? WS_CK : WS_CV)) + j) = o; } }
    { LAS float* sc = (LAS float*)(F.lds + RING_OFF); LAS float* red = sc + 9 * 512; const float* wm = A.in[I_WMOD]; float* MODP = (float*)(ws + WS_MODP);
      for (int it = F.vcu; it < 96 * 8; it += F.G) { const int cb = it % 96, ks = it / 96;
          for (int idx = F.tid; idx < 9 * 512; idx += NWAVES * 64) { const int j = idx >> 9, kk = idx & 511, k = ks * 512 + kk; const float c = j == 0 ? A.in[I_CCTX][k] : A.in[I_C][(size_t)(j - 1) * DM + k]; sc[idx] = c * sigm(c); }
          __syncthreads();
          f32x4 acc[9];
#pragma unroll
          for (int j = 0; j < 9; ++j) acc[j] = (f32x4){0.f, 0.f, 0.f, 0.f};
          const float* wp = wm + (size_t)(ks * 512 + F.wave * 64) * NMOD + cb * 256 + F.lane * 4;
#pragma unroll 8
          for (int r = 0; r < 64; ++r) { const f32x4 w4 = *(const GAS f32x4*)(wp + (size_t)r * NMOD); const int kk = F.wave * 64 + r;
#pragma unroll
              for (int j = 0; j < 9; ++j) acc[j] += w4 * sc[j * 512 + kk]; }
#pragma unroll
          for (int j = 0; j < 9; ++j) *(LAS f32x4*)(red + (F.wave * 9 + j) * 256 + F.lane * 4) = acc[j];
          __syncthreads();
          for (int idx = F.tid; idx < 9 * 256; idx += NWAVES * 64) { const int j = idx >> 8, c = idx & 255; float s = 0.f;
#pragma unroll
              for (int w = 0; w < 8; ++w) s += red[(w * 9 + j) * 256 + c];
              MODP[((size_t)ks * 9 + j) * NMOD + cb * 256 + c] = s; }
          __syncthreads(); } }
}
__device__ __forceinline__ void p0b_mod_finalize(Frame& F, const Args& A) {
    const int gt = (F.vcu * NWAVES + F.wave) * 64 + F.lane, NGT = F.G * NWAVES * 64; const float* MODP = (const float*)(F.ws + WS_MODP); float* MOD = (float*)(F.ws + WS_MOD);
    for (int i = gt; i < 9 * NMOD; i += NGT) { const int n = i % NMOD; float s = A.in[I_BMOD][n];
#pragma unroll
        for (int ks = 0; ks < 8; ++ks) s += MODP[(size_t)ks * 9 * NMOD + i];
        MOD[i] = s; }
}
template <bool XF16> __device__ __forceinline__ void modnorm_rows(Frame& F, const void* Xv, int M, const float* nw, int sh_off, int sc_off, int jbase, int rps, int jmul, bf16* H) {
    static_assert(!XF16, "fp16 rows: modnorm16_rows");
    const int gw = F.vcu * NWAVES + F.wave, NGW = F.G * NWAVES; const float* MOD = (const float*)(F.ws + WS_MOD);
    for (int row0 = 2 * gw; row0 < M; row0 += 2 * NGW) {
        f32x4 v[2][8][2]; float ss[2] = {0.f, 0.f};
#pragma unroll
        for (int q = 0; q < 2; ++q) { const float* xr = (const float*)Xv + (size_t)(row0 + q) * DM + F.lane * 8;
#pragma unroll
            for (int c = 0; c < 8; ++c) { v[q][c][0] = *(const GAS f32x4*)(xr + c * 512); v[q][c][1] = *(const GAS f32x4*)(xr + c * 512 + 4); } }
#pragma unroll
        for (int q = 0; q < 2; ++q)
#pragma unroll
            for (int c = 0; c < 8; ++c)
                ss[q] += (v[q][c][0].x * v[q][c][0].x + v[q][c][0].y * v[q][c][0].y) + (v[q][c][0].z * v[q][c][0].z + v[q][c][0].w * v[q][c][0].w) + (v[q][c][1].x * v[q][c][1].x + v[q][c][1].y * v[q][c][1].y) + (v[q][c][1].z * v[q][c][1].z + v[q][c][1].w * v[q][c][1].w);
        const float rstd[2] = {1.0f / sqrtf(wave_sum(ss[0]) * (1.0f / DM) + RMS_EPS), 1.0f / sqrtf(wave_sum(ss[1]) * (1.0f / DM) + RMS_EPS)};
        const float* mj = MOD + (size_t)(jbase + (row0 / rps) * jmul) * NMOD + F.lane * 8; bf16* hr = H + (size_t)row0 * DM + F.lane * 8;
#pragma unroll
        for (int c = 0; c < 8; ++c) { unsigned ow[2][4];
#pragma unroll
            for (int h = 0; h < 2; ++h) { const f32x4 w4 = *(const GAS f32x4*)(nw + F.lane * 8 + c * 512 + 4 * h), s4 = *(const GAS f32x4*)(mj + sc_off + c * 512 + 4 * h), b4 = *(const GAS f32x4*)(mj + sh_off + c * 512 + 4 * h);
                const f32x4 cf = w4 * (s4 + 1.0f);
#pragma unroll
                for (int q = 0; q < 2; ++q) { const f32x4 y = v[q][c][h] * rstd[q] * cf + b4; ow[q][2 * h] = pkbf(y.x, y.y); ow[q][2 * h + 1] = pkbf(y.z, y.w); } }
#pragma unroll
            for (int q = 0; q < 2; ++q) { v4u o; o.x = ow[q][0]; o.y = ow[q][1]; o.z = ow[q][2]; o.w = ow[q][3]; *(GAS v4u*)(hr + (size_t)q * DM + c * 512) = o; } }
    }
}
__device__ __forceinline__ void final_norm_rows(Frame& F, float* Y, int M, const float* nw) {
    const int gw = F.vcu * NWAVES + F.wave, NGW = F.G * NWAVES;
    for (int row0 = gw; row0 < M; row0 += 2 * NGW) {
        f32x4 v[2][8][2]; float ss[2] = {0.f, 0.f}; const bool two = row0 + NGW < M;
#pragma unroll
        for (int q = 0; q < 2; ++q) { const int row = q ? (two ? row0 + NGW : row0) : row0;
#pragma unroll
            for (int c = 0; c < 8; ++c) { const v4u h = *(const GAS v4u*)((const h16s*)(Y + (size_t)row * DM) + F.lane * 8 + c * 512); v[q][c][0] = pg8::h4lo(h.x, h.y); v[q][c][1] = pg8::h4lo(h.z, h.w); } }
#pragma unroll
        for (int q = 0; q < 2; ++q)
#pragma unroll
            for (int c = 0; c < 8; ++c)
                ss[q] += (v[q][c][0].x * v[q][c][0].x + v[q][c][0].y * v[q][c][0].y) + (v[q][c][0].z * v[q][c][0].z + v[q][c][0].w * v[q][c][0].w) + (v[q][c][1].x * v[q][c][1].x + v[q][c][1].y * v[q][c][1].y) + (v[q][c][1].z * v[q][c][1].z + v[q][c][1].w * v[q][c][1].w);
        const float rstd0 = 1.0f / sqrtf(wave_sum(ss[0]) * (1.0f / DM) + RMS_EPS), rstd1 = 1.0f / sqrtf(wave_sum(ss[1]) * (1.0f / DM) + RMS_EPS);
        asm volatile("s_waitcnt vmcnt(0)" ::: "memory");
#pragma unroll
        for (int q = 0; q < 2; ++q) { if (q == 1 && !two) break; float* xr = Y + (size_t)(row0 + q * NGW) * DM + F.lane * 8; const float rstd = q ? rstd1 : rstd0;
#pragma unroll
            for (int c = 0; c < 8; ++c)
#pragma unroll
                for (int h = 0; h < 2; ++h) { const f32x4 w4 = *(const GAS f32x4*)(nw + F.lane * 8 + c * 512 + 4 * h); *(GAS f32x4*)(xr + c * 512 + 4 * h) = v[q][c][h] * rstd * w4; } }
    }
}
#define SSQ4(V) (((V).x * (V).x + (V).y * (V).y) + ((V).z * (V).z + (V).w * (V).w))
__device__ __forceinline__ void rows2_load(v4u (&B)[2][8], const h16s* X, int r0, int NGW, int M, int lane) {
#pragma unroll
    for (int q = 0; q < 2; ++q) { const int row = min(r0 + q * NGW, M - 1);
#pragma unroll
        for (int c = 0; c < 8; ++c) B[q][c] = *(const GAS v4u*)(X + (size_t)row * 8192 + lane * 8 + c * 512); }
}
__device__ __forceinline__ void rows2_rstd(const v4u (&B)[2][8], float (&rstd)[2]) {
    float ss[2] = {0.f, 0.f};
#pragma unroll
    for (int q = 0; q < 2; ++q)
#pragma unroll
        for (int c = 0; c < 8; ++c) { const f32x4 a = pg8::h4lo(B[q][c].x, B[q][c].y), b = pg8::h4lo(B[q][c].z, B[q][c].w); ss[q] += SSQ4(a) + SSQ4(b); }
#pragma unroll
    for (int q = 0; q < 2; ++q) rstd[q] = 1.0f / sqrtf(wave_sum(ss[q]) * (1.0f / DM) + RMS_EPS);
}
__device__ __forceinline__ void modnorm16_store(Frame& F, const v4u (&B)[2][8], int r0, int M, const float* nw, int sh_off, int sc_off, int jbase, int rps, int jmul, bf16* H) {
    const float* MOD = (const float*)(F.ws + WS_MOD); float rstd[2]; rows2_rstd(B, rstd);
    if (r0 >= M) return;
    const float* mj = MOD + (size_t)(jbase + (r0 / rps) * jmul) * NMOD + F.lane * 8; bf16* hr = H + (size_t)r0 * DM + F.lane * 8;
#pragma unroll
    for (int c = 0; c < 8; ++c) { unsigned ow[2][4];
#pragma unroll
        for (int h = 0; h < 2; ++h) { const f32x4 w4 = *(const GAS f32x4*)(nw + F.lane * 8 + c * 512 + 4 * h), s4 = *(const GAS f32x4*)(mj + sc_off + c * 512 + 4 * h), b4 = *(const GAS f32x4*)(mj + sh_off + c * 512 + 4 * h);
            const f32x4 cf = w4 * (s4 + 1.0f);
#pragma unroll
            for (int q = 0; q < 2; ++q) { unsigned u0 = h ? B[q][c].z : B[q][c].x, u1 = h ? B[q][c].w : B[q][c].y; asm volatile("" : "+v"(u0), "+v"(u1));
                const f32x4 x = pg8::h4lo(u0, u1);
                const f32x4 y = x * rstd[q] * cf + b4; ow[q][2 * h] = pkbf(y.x, y.y); ow[q][2 * h + 1] = pkbf(y.z, y.w); } }
#pragma unroll
        for (int q = 0; q < 2; ++q) { v4u o; o.x = ow[q][0]; o.y = ow[q][1]; o.z = ow[q][2]; o.w = ow[q][3]; *(GAS v4u*)(hr + (size_t)q * DM + c * 512) = o; }
        if (c & 1) asm volatile("" ::: "memory"); }
}
__device__ __forceinline__ void modnorm16_rows(Frame& F, const h16s* X, int M, const float* nw, int sh_off, int sc_off, int jbase, int rps, int jmul, bf16* H) {
    const int gw = F.vcu * NWAVES + F.wave, NGW = F.G * NWAVES;
    if (2 * gw >= M) return;
    v4u A_[2][8], B_[2][8]; rows2_load(A_, X, 2 * gw, 1, M, F.lane);
    for (int r0 = 2 * gw; r0 < M; r0 += 4 * NGW) {
        rows2_load(B_, X, r0 + 2 * NGW, 1, M, F.lane);
        modnorm16_store(F, A_, r0, M, nw, sh_off, sc_off, jbase, rps, jmul, H);
        if (r0 + 2 * NGW >= M) break;
        rows2_load(A_, X, r0 + 4 * NGW, 1, M, F.lane);
        modnorm16_store(F, B_, r0 + 2 * NGW, M, nw, sh_off, sc_off, jbase, rps, jmul, H);
    }
}
__device__ __forceinline__ void final16_store(Frame& F, const v4u (&B)[2][8], int r0, int M, float* Y, const float* nw) {
    float rstd[2]; rows2_rstd(B, rstd);
    if (r0 >= M) return;
    float* xr = Y + (size_t)r0 * DM + F.lane * 8;
#pragma unroll
    for (int c = 0; c < 8; ++c)
#pragma unroll
        for (int h = 0; h < 2; ++h) { const f32x4 w4 = *(const GAS f32x4*)(nw + F.lane * 8 + c * 512 + 4 * h);
#pragma unroll
            for (int q = 0; q < 2; ++q) { unsigned u0 = h ? B[q][c].z : B[q][c].x, u1 = h ? B[q][c].w : B[q][c].y; asm volatile("" : "+v"(u0), "+v"(u1));
                *(GAS f32x4*)(xr + (size_t)q * DM + c * 512 + 4 * h) = pg8::h4lo(u0, u1) * rstd[q] * w4; } }
}
__device__ __forceinline__ void final16_rows(Frame& F, float* Y, int M, const float* nw) {
    const int gw = F.vcu * NWAVES + F.wave, NGW = F.G * NWAVES; const h16s* X = (const h16s*)Y;
    if (2 * gw >= M) return;
    v4u A_[2][8], B_[2][8]; rows2_load(A_, X, 2 * gw, 1, M, F.lane);
    for (int r0 = 2 * gw; r0 < M; r0 += 4 * NGW) {
        rows2_load(B_, X, r0 + 2 * NGW, 1, M, F.lane);
        final16_store(F, A_, r0, M, Y, nw);
        if (r0 + 2 * NGW >= M) break;
        rows2_load(A_, X, r0 + 4 * NGW, 1, M, F.lane);
        final16_store(F, B_, r0 + 2 * NGW, M, Y, nw);
    }
}
namespace att {
constexpr float SCALE = 0.088388347648318440f, C = SCALE * 1.4426950408889634f;
constexpr int SHM_T = 16384;
constexpr int OFF_V = 0, OFF_K = 2 * SHM_T, OFF_WS = 4 * SHM_T, OFF_TAB = OFF_WS + 4096, OFF_ROW = OFF_TAB + 4096;
#define KSWZ(row, colB) ((row) * 256 + ((colB) ^ (((row) & 7) << 4)))
#define SBAR() __builtin_amdgcn_sched_barrier(0)
__device__ __forceinline__ int crow(int r, int hi) { return (r & 3) + 8 * (r >> 2) + 4 * hi; }
constexpr bool L0(int LV, int r) { return LV != 2 || r >= 12; }
constexpr bool L1(int LV, int r) { return LV != 1 || r < 4; }
template <int LV> __device__ __forceinline__ void partialSM(f32x16& p0, f32x16& p1, float& m_reg, float& mn, float& alpha) {
  float pmax = -3.0e38f;
#pragma unroll
  for (int r = 0; r < 16; ++r) if (L0(LV, r)) pmax = fmaxf(pmax, p0[r]);
#pragma unroll
  for (int r = 0; r < 16; ++r) if (L1(LV, r)) pmax = fmaxf(pmax, p1[r]);
  { auto rr = __builtin_amdgcn_permlane32_swap(__float_as_uint(pmax), __float_as_uint(pmax), false, false);
    pmax = fmaxf(__uint_as_float(rr[0]), __uint_as_float(rr[1])); }
  if (__all(pmax <= m_reg)) { mn = m_reg; alpha = 1.f; }
  else { mn = fmaxf(m_reg, pmax); alpha = __builtin_amdgcn_exp2f((m_reg - mn) * C); m_reg = mn; }
  const float mnC = -mn * C; typedef float f2_ __attribute__((ext_vector_type(2))); const f2_ C2 = {C, C}, M2 = {mnC, mnC};
#pragma unroll
  for (int r = 0; r < 16; r += 2) { if (L0(LV, r)) { const f2_ t = __builtin_elementwise_fma((f2_){p0[r], p0[r + 1]}, C2, M2); p0[r] = __builtin_amdgcn_exp2f(t.x); p0[r + 1] = __builtin_amdgcn_exp2f(t.y); } else { p0[r] = 0.f; p0[r + 1] = 0.f; } }
#pragma unroll
  for (int r = 0; r < 16; r += 2) { if (L1(LV, r)) { const f2_ t = __builtin_elementwise_fma((f2_){p1[r], p1[r + 1]}, C2, M2); p1[r] = __builtin_amdgcn_exp2f(t.x); p1[r + 1] = __builtin_amdgcn_exp2f(t.y); } else { p1[r] = 0.f; p1[r + 1] = 0.f; } }
}
template <int LV> __device__ __forceinline__ void finishSM(f32x16& p0, f32x16& p1, float alpha, float& l_reg, bf16x8& pa0, bf16x8& pa1, bf16x8& pa2, bf16x8& pa3) {
  typedef float f2_ __attribute__((ext_vector_type(2))); f2_ s2 = {0.f, 0.f};
#pragma unroll
  for (int r = 0; r < 16; r += 2) if (L0(LV, r)) s2 += (f2_){p0[r], p0[r + 1]};
#pragma unroll
  for (int r = 0; r < 16; r += 2) if (L1(LV, r)) s2 += (f2_){p1[r], p1[r + 1]};
  float ps = s2.x + s2.y;
  { auto rr = __builtin_amdgcn_permlane32_swap(__float_as_uint(ps), __float_as_uint(ps), false, false);
    ps = __uint_as_float(rr[0]) + __uint_as_float(rr[1]); }
  l_reg = l_reg * alpha + ps;
#define PK4(P, BASE, OUT) do { unsigned a0 = pkbf(P[BASE + 0], P[BASE + 1]), a1 = pkbf(P[BASE + 2], P[BASE + 3]);   \
    unsigned b0 = pkbf(P[BASE + 4], P[BASE + 5]), b1 = pkbf(P[BASE + 6], P[BASE + 7]);                              \
    auto r0 = __builtin_amdgcn_permlane32_swap(a0, b0, false, false); auto r1 = __builtin_amdgcn_permlane32_swap(a1, b1, false, false); \
    v4u w = {r0[0], r1[0], r0[1], r1[1]}; OUT = __builtin_bit_cast(bf16x8, w); } while (0)
  if (LV != 2) PK4(p0, 0, pa0); else pa0 = bf16x8{};
  PK4(p0, 8, pa1); PK4(p1, 0, pa2);
  if (LV != 1) PK4(p1, 8, pa3); else pa3 = bf16x8{};
#undef PK4
}
__device__ __forceinline__ void qkt(f32x16& p0, f32x16& p1, const LAS unsigned char* Ks, const bf16x8* qr, int r32, int hi) {
  p0 = f32x16{}; p1 = f32x16{};
#pragma unroll
  for (int d0 = 0; d0 < 8; ++d0) { const int cb = (d0 * 16 + hi * 8) * 2;
    const bf16x8 b0 = *(const LAS bf16x8*)(Ks + KSWZ(r32, cb));
    const bf16x8 b1 = *(const LAS bf16x8*)(Ks + KSWZ(32 + r32, cb));
    p0 = __builtin_amdgcn_mfma_f32_32x32x16_bf16(b0, qr[d0], p0, 0, 0, 0);
    p1 = __builtin_amdgcn_mfma_f32_32x32x16_bf16(b1, qr[d0], p1, 0, 0, 0); }
}
__device__ __forceinline__ int v_st(int k, int c) { const int kk = (k & ~0xC) | ((k & 4) << 1) | ((k & 8) >> 1); return ((kk >> 3) * 4 + (c >> 5)) * 512 + ((kk & 7) * 32 + (c & 31)) * 2; }
__device__ __forceinline__ int v_rd_base(int lane) { return ((lane & 3) << 3) | (((lane >> 2) & 3) << 6) | (((lane >> 4) & 1) << 5) | (((lane >> 5) & 1) << 8); }
constexpr int v_rd_off(int d0, int ks, int half) { return d0 * 512 + ks * 4096 + half * 2048; }
template <int OFF> __device__ __forceinline__ s16x4 tr_read(int vb) {
  s16x4 r; asm volatile("ds_read_b64_tr_b16 %0, %1 offset:%2" : "=&v"(r) : "v"(vb), "i"(OFF) : "memory"); return r;
}
template <int D0, int LV> __device__ __forceinline__ void pv_one(f32x16& od, int vb, bf16x8 pa0, bf16x8 pa1, bf16x8 pa2, bf16x8 pa3) {
  s16x4 l0 = {}, h0 = {}, l3 = {}, h3 = {};
  if (LV != 2) { l0 = tr_read<v_rd_off(D0, 0, 0)>(vb); h0 = tr_read<v_rd_off(D0, 0, 1)>(vb); }
  const s16x4 l1 = tr_read<v_rd_off(D0, 1, 0)>(vb), h1 = tr_read<v_rd_off(D0, 1, 1)>(vb), l2 = tr_read<v_rd_off(D0, 2, 0)>(vb), h2 = tr_read<v_rd_off(D0, 2, 1)>(vb);
  if (LV != 1) { l3 = tr_read<v_rd_off(D0, 3, 0)>(vb); h3 = tr_read<v_rd_off(D0, 3, 1)>(vb); }
  asm volatile("s_waitcnt lgkmcnt(0)" ::: "memory"); SBAR();
#define PK(L, H) (bf16x8){L[0], L[1], L[2], L[3], H[0], H[1], H[2], H[3]}
  if (LV != 2) od = __builtin_amdgcn_mfma_f32_32x32x16_bf16(pa0, PK(l0, h0), od, 0, 0, 0);
  od = __builtin_amdgcn_mfma_f32_32x32x16_bf16(pa1, PK(l1, h1), od, 0, 0, 0);
  od = __builtin_amdgcn_mfma_f32_32x32x16_bf16(pa2, PK(l2, h2), od, 0, 0, 0);
  if (LV != 1) od = __builtin_amdgcn_mfma_f32_32x32x16_bf16(pa3, PK(l3, h3), od, 0, 0, 0);
#undef PK
}
template <int LV> __device__ __forceinline__ void pv_d0(f32x16* o, int vb, bf16x8 pa0, bf16x8 pa1, bf16x8 pa2, bf16x8 pa3) {
  pv_one<0, LV>(o[0], vb, pa0, pa1, pa2, pa3); pv_one<1, LV>(o[1], vb, pa0, pa1, pa2, pa3); pv_one<2, LV>(o[2], vb, pa0, pa1, pa2, pa3); pv_one<3, LV>(o[3], vb, pa0, pa1, pa2, pa3);
}
template <int LV> __device__ __forceinline__ void attn_tile(const LAS unsigned char* Kt, int vb, const bf16x8* qr, f32x16* o, float& m_reg, float& l_reg, LAS float* al_l, int r32, int hi, const LAS unsigned char* rowb, const int (&off0)[16], const int (&off1)[16]) {
  f32x16 p0, p1; float mn, alpha; bf16x8 pa0, pa1, pa2, pa3;
  qkt(p0, p1, Kt, qr, r32, hi);
  if (LV != 0) {
#pragma unroll
    for (int r = 0; r < 16; ++r) { if (L0(LV, r)) p0[r] += *(const LAS float*)(rowb + off0[r]); if (L1(LV, r)) p1[r] += *(const LAS float*)(rowb + off1[r]); } }
  partialSM<LV>(p0, p1, m_reg, mn, alpha);
  if (__any(alpha < 1.f)) { if (hi == 0) al_l[r32] = alpha; asm volatile("s_waitcnt lgkmcnt(0)" ::: "memory");
#pragma unroll
    for (int d = 0; d < 4; ++d)
#pragma unroll
      for (int r = 0; r < 16; ++r) o[d][r] *= al_l[crow(r, hi)]; }
  finishSM<LV>(p0, p1, alpha, l_reg, pa0, pa1, pa2, pa3); SBAR();
  pv_d0<LV>(o, vb, pa0, pa1, pa2, pa3);
}
__device__ __forceinline__ void attn_unit(LAS unsigned char* lds, const bf16* Qb, bf16* Ob, const bf16* Kl, const bf16* Vl, int ntl, int rho0, int r0, const bf16* Kc, const bf16* Vc, const float* rpb) {
  int tid_ = threadIdx.x; asm volatile("" : "+v"(tid_));
  const int tid = tid_, wid = __builtin_amdgcn_readfirstlane(tid >> 6), lane = tid & 63, r32 = lane & 31, hi = lane >> 5;
  LAS unsigned char* V_lds = lds + OFF_V; LAS unsigned char* K_lds = lds + OFF_K;
  LAS float* wsf = (LAS float*)(lds + OFF_WS) + wid * 64; LAS float* li_l = wsf; LAS float* al_l = wsf + 32;
  LAS float* tab = (LAS float*)(lds + OFF_TAB);
  if (ntl > 0) { for (int i = tid; i < 15 * 31; i += NWAVES * 64) tab[i] = rpb[i] * (1.0f / SCALE); }
  float m_reg = -1e30f, l_reg = 0.f; f32x16 o[4] = {}; bf16x8 qr[8];
  { const bf16* Qw = Qb + (size_t)(wid * 32 + r32) * 2048 + hi * 8;
#pragma unroll
    for (int d0 = 0; d0 < 8; ++d0) qr[d0] = *(const GAS bf16x8*)(Qw + d0 * 16); }
  const int rq = r0 + (wid >> 1), cq = 32 * (wid & 1) + r32;
  const int rs = min(max(rq - 4, 0), 56), cs = min(max(cq - 8, 0), 48);
  LAS unsigned char* rowb = lds + OFF_ROW + wid * 128;
  int off0[16], off1[16];
#pragma unroll
  for (int r = 0; r < 16; ++r) { const int kap = (r & 3) + 8 * (r >> 2) + 4 * hi; off0[r] = ((unsigned)(kap - cs) < 16u) ? (kap - cq + 15) * 4 : 124; off1[r] = ((unsigned)(kap + 32 - cs) < 16u) ? (kap + 32 - cq + 15) * 4 : 124; }
  const int sr = tid >> 4, sc = (tid & 15) * 8, vst0 = v_st(sr, sc), vst1 = v_st(32 + sr, sc), kst0 = KSWZ(sr, sc * 2), kst1 = KSWZ(32 + sr, sc * 2);
  const int vb0 = (int)(unsigned)(uintptr_t)V_lds + v_rd_base(lane);
  const int NT = ntl + 4;
  bf16x8 sv0, sv1, sk0, sk1;
#define SLOAD(t) do { const bf16* kp = ((t) < ntl) ? Kl + (size_t)(t) * 64 * 2048 : Kc + (size_t)((t) - ntl) * 64 * 2048; const bf16* vp = ((t) < ntl) ? Vl + (size_t)(t) * 64 * 2048 : Vc + (size_t)((t) - ntl) * 64 * 2048; \
    sv0 = *(const GAS bf16x8*)(vp + (size_t)sr * 2048 + sc); sv1 = *(const GAS bf16x8*)(vp + (size_t)(32 + sr) * 2048 + sc); sk0 = *(const GAS bf16x8*)(kp + (size_t)sr * 2048 + sc); sk1 = *(const GAS bf16x8*)(kp + (size_t)(32 + sr) * 2048 + sc); } while (0)
#define SWRITE(b) do { *(LAS bf16x8*)(V_lds + (b) * SHM_T + vst0) = sv0; *(LAS bf16x8*)(V_lds + (b) * SHM_T + vst1) = sv1; *(LAS bf16x8*)(K_lds + (b) * SHM_T + kst0) = sk0; *(LAS bf16x8*)(K_lds + (b) * SHM_T + kst1) = sk1; } while (0)
  SLOAD(0); SWRITE(0); __syncthreads();
#define TILE_STEP(LV_, t) do { const int b = (t) & 1; if ((t) + 1 < NT) SLOAD((t) + 1); \
    const int rho = rho0 + (t); const bool need = (LV_ == 0) || (rho >= rs && rho < rs + 8); \
    if (need) { if (LV_ != 0) { if (lane < 32) ((LAS float*)rowb)[lane] = lane < 31 ? tab[(rho - rq + 7) * 31 + lane] : -1e30f; } attn_tile<LV_>(K_lds + b * SHM_T, vb0 + b * SHM_T, qr, o, m_reg, l_reg, al_l, r32, hi, rowb, off0, off1); } \
    if ((t) + 1 < NT) SWRITE(b ^ 1); __syncthreads(); } while (0)
  if (wid & 1) { for (int t = 0; t < ntl; ++t) TILE_STEP(2, t); }
  else { for (int t = 0; t < ntl; ++t) TILE_STEP(1, t); }
  for (int t = ntl; t < NT; ++t) TILE_STEP(0, t);
#undef TILE_STEP
#undef SLOAD
#undef SWRITE
  if (hi == 0) li_l[r32] = l_reg; asm volatile("s_waitcnt lgkmcnt(0)" ::: "memory");
  float rli[16];
#pragma unroll
  for (int r = 0; r < 16; ++r) rli[r] = __builtin_amdgcn_rcpf(li_l[crow(r, hi)]);
  bf16* Ow = Ob + (size_t)(wid * 32) * 2048;
#pragma unroll
  for (int r = 0; r < 16; ++r) { const int orow = crow(r, hi);
#pragma unroll
    for (int d0 = 0; d0 < 4; ++d0) { const unsigned w = pkbf(o[d0][r] * rli[r], 0.f); Ow[(size_t)orow * 2048 + d0 * 32 + r32] = (bf16)(w & 0xffffu); } }
}
#undef KSWZ
#undef SBAR
}
__device__ __forceinline__ float sum8(float v) { v += __shfl_xor(v, 1); v += __shfl_xor(v, 2); v += __shfl_xor(v, 4); return v; }
__device__ __forceinline__ void rwkv_prep(Frame& F, const Args& A, const h16s* PR, int prow0, int Ms, int L, h16s* RS, h16s* KS, h16s* VS, h16s* KK, bf16* LA) {
    const int gw = F.vcu * NWAVES + F.wave, NGW = F.G * NWAVES; const float* mu = A.in[I_MU]; const float* k_k = A.in[I_KK];
    for (int s0 = 2 * gw; s0 < Ms; s0 += 2 * NGW) {
        const int t = s0 % L; const bool hp = t > 0, hn = t + 2 < L;
        const h16s* pc = PR + (size_t)(prow0 + s0) * C_RWKV_P + F.lane * 8;
#pragma unroll 4
        for (int c = 0; c < 13; ++c) {
            const int col = c * 512 + F.lane * 8; const v4u z4 = {0u, 0u, 0u, 0u};
            const v4u w0 = hp ? *(const GAS v4u*)(pc + c * 512 - C_RWKV_P) : z4, w1 = *(const GAS v4u*)(pc + c * 512), w2 = *(const GAS v4u*)(pc + c * 512 + C_RWKV_P), w3 = hn ? *(const GAS v4u*)(pc + c * 512 + 2 * C_RWKV_P) : z4;
            float x0[8], x1[8], x2[8], x3[8], m[8]; unpack_h8(w0, x0); unpack_h8(w1, x1); unpack_h8(w2, x2); unpack_h8(w3, x3);
            if (col < C_RWKV) { const f32x4 m0 = *(const GAS f32x4*)(mu + col), m1 = *(const GAS f32x4*)(mu + col + 4); m[0] = m0.x; m[1] = m0.y; m[2] = m0.z; m[3] = m0.w; m[4] = m1.x; m[5] = m1.y; m[6] = m1.z; m[7] = m1.w; }
            else {
#pragma unroll
                for (int e = 0; e < 8; ++e) m[e] = 0.f; }
#pragma unroll
            for (int q = 0; q < 2; ++q) { const int s = s0 + q;
                float x[8];
#pragma unroll
                for (int e = 0; e < 8; ++e) { const float xc = q ? x2[e] : x1[e], xp = q ? x1[e] : x0[e], xn = q ? x3[e] : x2[e]; x[e] = xc + m[e] * (0.5f * (xp + xn) - xc); }
                if (c < 12) {
                    v4u o; o.x = pkh(x[0], x[1]); o.y = pkh(x[2], x[3]); o.z = pkh(x[4], x[5]); o.w = pkh(x[6], x[7]);
                    h16s* dst = (c < 4 ? RS : c < 8 ? KS : VS) + (size_t)s * D_RW + (c & 3) * 512 + F.lane * 8;
                    *(GAS v4u*)dst = o;
                    if (c >= 4 && c < 8) { const int kc = (c - 4) * 512 + F.lane * 8; const f32x4 q0 = *(const GAS f32x4*)(k_k + kc), q1 = *(const GAS f32x4*)(k_k + kc + 4);
                        float y[8] = {x[0] * q0.x, x[1] * q0.y, x[2] * q0.z, x[3] * q0.w, x[4] * q1.x, x[5] * q1.y, x[6] * q1.z, x[7] * q1.w}; float ss = 0.f;
    #pragma unroll
                        for (int e = 0; e < 8; ++e) ss += y[e] * y[e];
                        ss = sum8(ss); const float inv = 1.0f / fmaxf(sqrtf(ss), 1e-12f);
                        v4u ko; ko.x = pkh(y[0] * inv, y[1] * inv); ko.y = pkh(y[2] * inv, y[3] * inv); ko.z = pkh(y[4] * inv, y[5] * inv); ko.w = pkh(y[6] * inv, y[7] * inv);
                        *(GAS v4u*)(KK + (size_t)s * D_RW + kc) = ko; }
                } else {
                    float y[8];
    #pragma unroll
                    for (int e = 0; e < 8; ++e) { const int j = F.lane * 8 + e; const float v = x[e];
                        const float th = 1.0f - 2.0f * __builtin_amdgcn_rcpf(1.0f + __builtin_amdgcn_exp2f(2.8853900817779268f * v));
                        y[e] = j < 96 ? th : j < 192 ? v : j < 448 ? sigm(v) : 0.f; }
                    v4u o; o.x = pkbf(y[0], y[1]); o.y = pkbf(y[2], y[3]); o.z = pkbf(y[4], y[5]); o.w = pkbf(y[6], y[7]);
                    if (F.lane < 24) *(GAS v4u*)(LA + (size_t)s * 256 + F.lane * 8) = o;
                    else if (F.lane < 56) *(GAS v4u*)(LA + (size_t)Ms * 256 + (size_t)s * 256 + (F.lane - 24) * 8) = o;
                    else *(GAS v4u*)(LA + (size_t)s * 256 + 192 + (F.lane - 56) * 8) = (v4u){0u, 0u, 0u, 0u};
                }
            }
        }
    }
}
typedef float f32x2 __attribute__((ext_vector_type(2)));
__device__ __forceinline__ float dpp_xor1(float x) { return __builtin_bit_cast(float, __builtin_amdgcn_update_dpp(0, __builtin_bit_cast(int, x), 0xB1, 0xf, 0xf, true)); }
__device__ __forceinline__ float dpp_xor2(float x) { return __builtin_bit_cast(float, __builtin_amdgcn_update_dpp(0, __builtin_bit_cast(int, x), 0x4E, 0xf, 0xf, true)); }
__device__ __forceinline__ float dpp_hmir(float x) { return __builtin_bit_cast(float, __builtin_amdgcn_update_dpp(0, __builtin_bit_cast(int, x), 0x141, 0xf, 0xf, true)); }
__device__ __forceinline__ float red8(float x) { x += dpp_xor1(x); x += dpp_xor2(x); x += dpp_hmir(x); return x; }
__device__ __forceinline__ float dpp_shr1(float x) { return __builtin_bit_cast(float, __builtin_amdgcn_update_dpp(0, __builtin_bit_cast(int, x), 0x111, 0xf, 0xf, true)); }
__device__ __forceinline__ float dpp_shr2(float x) { return __builtin_bit_cast(float, __builtin_amdgcn_update_dpp(0, __builtin_bit_cast(int, x), 0x112, 0xf, 0xf, true)); }
__device__ __forceinline__ float dpp_shr4(float x) { return __builtin_bit_cast(float, __builtin_amdgcn_update_dpp(0, __builtin_bit_cast(int, x), 0x114, 0xf, 0xf, true)); }
constexpr int SC_U = 8, SC_STEP = 5 * 64, SC_OPS_F = SC_U * SC_STEP, SC_GAM_F = 64, SC_Y_F = SC_U * 512, SC_SLOT_F = 2 * SC_OPS_F + 2 * SC_GAM_F + 2 * SC_Y_F;
static_assert(2 * SC_SLOT_F * 4 <= RING_BYTES, "scan LDS");
struct ScanOps { f32x4 kk[2], bb[2], kd[2], r[2]; f32x2 v; };
__device__ __forceinline__ void scan_ld(ScanOps& o, const LAS float* ob, int kq, int v0) {
#pragma unroll
    for (int j = 0; j < 2; ++j) { o.kk[j] = *(const LAS f32x4*)(ob + 0 * 64 + kq * 8 + 4 * j); o.bb[j] = *(const LAS f32x4*)(ob + 1 * 64 + kq * 8 + 4 * j);
        o.kd[j] = *(const LAS f32x4*)(ob + 2 * 64 + kq * 8 + 4 * j); o.r[j] = *(const LAS f32x4*)(ob + 3 * 64 + kq * 8 + 4 * j); }
    o.v = *(const LAS f32x2*)(ob + 4 * 64 + v0);
}
__device__ __forceinline__ f32x2 lo2(f32x4 a) { return (f32x2){a.x, a.y}; }
__device__ __forceinline__ f32x2 hi2(f32x4 a) { return (f32x2){a.z, a.w}; }
__device__ __forceinline__ f32x2 h2x2(unsigned u) { typedef _Float16 hh2 __attribute__((ext_vector_type(2))); const hh2 h = __builtin_bit_cast(hh2, u); return (f32x2){(float)h.x, (float)h.y}; }
__device__ __forceinline__ f32x2 fma2(f32x2 a, f32x2 b, f32x2 c) { return __builtin_elementwise_fma(a, b, c); }
__device__ __forceinline__ f32x2 dot8(const f32x2 (&S)[4], const f32x4 (&x)[2]) { f32x2 p = S[0] * lo2(x[0]); p = fma2(S[1], hi2(x[0]), p); p = fma2(S[2], lo2(x[1]), p); p = fma2(S[3], hi2(x[1]), p); return p; }
__device__ __forceinline__ void rwkv_scan(Frame& F, const Args& A, int nseq, int L, int seq0_global, bool has_state, const h16s* RS, const h16s* KS, const h16s* VS, const h16s* KK,
                                          const h16s* DF, const h16s* DB, const h16s* AF, const h16s* AB, h16s* YF, h16s* YB, float* out_sf, float* out_sb) {
    const int nchains = nseq * NH_R * 2, nslots = nchains >= 2 * F.G ? 2 : 1; const int lane = F.lane, cs = F.wave >> 2, wq = F.wave & 3, kq = lane & 7, v0 = 16 * wq + 2 * (lane >> 3);
    const int ft = F.tid & 255, su = ft & 7, kp = ft >> 3;
    LAS float* const sl = (LAS float*)(F.lds + RING_OFF) + cs * SC_SLOT_F;
    const float* k_a = A.in[I_KA]; const int NC = L / SC_U;
    for (int it = 0; (it * F.G + F.vcu) * nslots < nchains; ++it) {
        const int chain = (it * F.G + F.vcu) * nslots + cs; const bool active = cs < nslots && chain < nchains;
        const int dir = chain & 1, head = (chain >> 1) & 31, seq = chain >> 6;
        const h16s* Dd = dir ? DB : DF; const h16s* Ad = dir ? AB : AF; h16s* Yd = dir ? YB : YF;
        const int colp = head * 64 + 2 * kp;
        f32x2 ka2 = (f32x2){0.f, 0.f}; if (active) ka2 = *(const GAS f32x2*)(k_a + colp); const f32x2 oka2 = (f32x2){1.0f - ka2.x, 1.0f - ka2.y};
        f32x2 Sa[4], Sb[4];
#pragma unroll
        for (int j = 0; j < 4; ++j) { Sa[j] = (f32x2){0.f, 0.f}; Sb[j] = (f32x2){0.f, 0.f}; }
        const size_t soff = (((size_t)(seq0_global + seq) * NH_R + head) * 64 + v0) * 64 + 8 * kq;
        if (active && has_state) { const float* sp = (dir ? A.in[I_SB] : A.in[I_SF]) + soff; const f32x4 a = *(const GAS f32x4*)sp, b = *(const GAS f32x4*)(sp + 4), c = *(const GAS f32x4*)(sp + 64), d = *(const GAS f32x4*)(sp + 68);
            Sa[0] = lo2(a); Sa[1] = hi2(a); Sa[2] = lo2(b); Sa[3] = hi2(b); Sb[0] = lo2(c); Sb[1] = hi2(c); Sb[2] = lo2(d); Sb[3] = hi2(d); }
        const int row0 = seq * L; const int tstart = dir ? L - 1 : 0, tstep = dir ? -1 : 1;
        struct Raw { unsigned r, k, kk, w, a, v; };
        Raw gA = {0, 0, 0, 0, 0, 0}, gB = {0, 0, 0, 0, 0, 0};
#define SC_AT(P, bo) (*(const GAS unsigned*)((const GAS char*)(P) + (bo)))
#define SC_GLOAD(g, c) do { const unsigned ro = (unsigned)((row0 + tstart + ((c) * SC_U + su) * tstep) * D_RW + colp) * 2u; g.r = SC_AT(RS, ro); g.k = SC_AT(KS, ro); g.kk = SC_AT(KK, ro); \
            g.w = SC_AT(Dd, ro); g.a = SC_AT(Ad, ro); g.v = SC_AT(VS, ro); } while (0)
        f32x2 f_r, f_kk, f_v, f_kd, f_bb, f_gi, f_t, f_inv;
#define SC_F0(g) do { const f32x2 k2 = h2x2(g.k), a2 = h2x2(g.a); f_r = h2x2(g.r); f_kk = h2x2(g.kk); f_v = h2x2(g.v); f_gi = h2x2(g.w); f_kd = k2 * (a2 * ka2 + oka2); f_bb = f_kk * a2; \
            f_t.x = dpp_shr1(f_gi.x); f_t.y = dpp_shr1(f_gi.y); } while (0)
#define SC_F1() do { if (su >= 1) f_gi *= f_t; f_t.x = dpp_shr2(f_gi.x); f_t.y = dpp_shr2(f_gi.y); } while (0)
#define SC_F2() do { if (su >= 2) f_gi *= f_t; f_t.x = dpp_shr4(f_gi.x); f_t.y = dpp_shr4(f_gi.y); } while (0)
#define SC_F3() do { if (su >= 4) f_gi *= f_t; f_t.x = dpp_shr1(f_gi.x); f_t.y = dpp_shr1(f_gi.y); f_inv = (f32x2){__builtin_amdgcn_rcpf(f_gi.x), __builtin_amdgcn_rcpf(f_gi.y)}; } while (0)
#define SC_F4(b) do { const f32x2 ge = su >= 1 ? f_t : (f32x2){1.0f, 1.0f}; \
            LAS float* ob = sl + (b) * SC_OPS_F + su * SC_STEP + 2 * kp; *(LAS f32x2*)(ob) = ge * f_kk; *(LAS f32x2*)(ob + 64) = f_bb * f_inv; *(LAS f32x2*)(ob + 128) = f_kd * f_inv; *(LAS f32x2*)(ob + 192) = f_gi * f_r; *(LAS f32x2*)(ob + 256) = f_v; \
            if (su == SC_U - 1) *(LAS f32x2*)(sl + 2 * SC_OPS_F + (b) * SC_GAM_F + 2 * kp) = f_gi; } while (0)
#define SC_YSTORE(bb_, c_) do { const LAS f32x4* yp = (const LAS f32x4*)(sl + 2 * SC_OPS_F + 2 * SC_GAM_F + (bb_) * SC_Y_F + (su * 64 + 2 * kp) * 8); const f32x4 a0 = yp[0], a1 = yp[1], b0 = yp[2], b1 = yp[3]; \
            const float y0 = ((a0.x + a0.z) + (a1.x + a1.z)) + ((b0.x + b0.z) + (b1.x + b1.z)), y1 = ((a0.y + a0.w) + (a1.y + a1.w)) + ((b0.y + b0.w) + (b1.y + b1.w)); \
            *(GAS unsigned*)((GAS char*)Yd + (unsigned)((row0 + tstart + ((c_) * SC_U + su) * tstep) * D_RW + colp) * 2u) = pkh(y0, y1); } while (0)
        __syncthreads();
        if (active) { SC_GLOAD(gA, 0); SC_F0(gA); SC_F1(); SC_F2(); SC_F3(); SC_F4(0); if (NC > 1) SC_GLOAD(gA, 1); }
        __syncthreads();
        for (int c = 0; c < NC; ++c) {
            const int b = c & 1;
            LAS float* yst = sl + 2 * SC_OPS_F + 2 * SC_GAM_F + b * SC_Y_F;
            if (active) {
                const bool fill = c + 1 < NC;
                if (c + 2 < NC) SC_GLOAD(gB, c + 2);
                const LAS float* ops = sl + b * SC_OPS_F;
                ScanOps cur, nxt; scan_ld(cur, ops, kq, v0);
                f32x2 pa = dot8(Sa, cur.kk), pb = dot8(Sb, cur.kk);
#define SC_STEP_(s) do { \
                    if ((s) + 1 < SC_U) scan_ld(nxt, ops + ((s) + 1) * SC_STEP, kq, v0); \
                    const f32x2 vA = (f32x2){cur.v.x, cur.v.x}, vB = (f32x2){cur.v.y, cur.v.y}; \
                    float ra = pa.x + pa.y, rb = pb.x + pb.y; \
                    ra += dpp_xor1(ra); rb += dpp_xor1(rb); \
                    Sa[0] = fma2(vA, lo2(cur.kd[0]), Sa[0]); Sb[0] = fma2(vB, lo2(cur.kd[0]), Sb[0]); Sa[1] = fma2(vA, hi2(cur.kd[0]), Sa[1]); Sb[1] = fma2(vB, hi2(cur.kd[0]), Sb[1]); \
                    ra += dpp_xor2(ra); rb += dpp_xor2(rb); \
                    Sa[2] = fma2(vA, lo2(cur.kd[1]), Sa[2]); Sb[2] = fma2(vB, lo2(cur.kd[1]), Sb[2]); Sa[3] = fma2(vA, hi2(cur.kd[1]), Sa[3]); Sb[3] = fma2(vB, hi2(cur.kd[1]), Sb[3]); \
                    ra += dpp_hmir(ra); rb += dpp_hmir(rb); \
                    const f32x2 sA = (f32x2){-ra, -ra}, sB = (f32x2){-rb, -rb}; \
                    Sa[0] = fma2(sA, lo2(cur.bb[0]), Sa[0]); Sb[0] = fma2(sB, lo2(cur.bb[0]), Sb[0]); Sa[1] = fma2(sA, hi2(cur.bb[0]), Sa[1]); Sb[1] = fma2(sB, hi2(cur.bb[0]), Sb[1]); \
                    Sa[2] = fma2(sA, lo2(cur.bb[1]), Sa[2]); Sb[2] = fma2(sB, lo2(cur.bb[1]), Sb[2]); Sa[3] = fma2(sA, hi2(cur.bb[1]), Sa[3]); Sb[3] = fma2(sB, hi2(cur.bb[1]), Sb[3]); \
                    f32x2 ya = Sa[0] * lo2(cur.r[0]), yb = Sb[0] * lo2(cur.r[0]); \
                    if ((s) + 1 < SC_U) { pa = Sa[0] * lo2(nxt.kk[0]); pb = Sb[0] * lo2(nxt.kk[0]); } \
                    ya = fma2(Sa[1], hi2(cur.r[0]), ya); yb = fma2(Sb[1], hi2(cur.r[0]), yb); \
                    if ((s) + 1 < SC_U) { pa = fma2(Sa[1], hi2(nxt.kk[0]), pa); pb = fma2(Sb[1], hi2(nxt.kk[0]), pb); } \
                    ya = fma2(Sa[2], lo2(cur.r[1]), ya); yb = fma2(Sb[2], lo2(cur.r[1]), yb); \
                    if ((s) + 1 < SC_U) { pa = fma2(Sa[2], lo2(nxt.kk[1]), pa); pb = fma2(Sb[2], lo2(nxt.kk[1]), pb); } \
                    ya = fma2(Sa[3], hi2(cur.r[1]), ya); yb = fma2(Sb[3], hi2(cur.r[1]), yb); \
                    if ((s) + 1 < SC_U) { pa = fma2(Sa[3], hi2(nxt.kk[1]), pa); pb = fma2(Sb[3], hi2(nxt.kk[1]), pb); } \
                    { float y0_, y1_; asm("v_add_f32 %0, %1, %2" : "=v"(y0_) : "v"(ya.x), "v"(ya.y)); asm("v_add_f32 %0, %1, %2" : "=v"(y1_) : "v"(yb.x), "v"(yb.y));     \
                      *(LAS f32x2*)(yst + ((s) * 64 + v0) * 8 + 2 * kq) = (f32x2){y0_, y1_}; } \
                    if ((s) + 1 < SC_U) cur = nxt; } while (0)
                SC_STEP_(0); SC_STEP_(1);
                if (c > 0) SC_YSTORE(b ^ 1, c - 1);
                if (fill) SC_F0(gA);
                SC_STEP_(2);
                if (fill) SC_F1();
                SC_STEP_(3);
                if (fill) SC_F2();
                SC_STEP_(4);
                if (fill) SC_F3();
                SC_STEP_(5);
                if (fill) SC_F4(b ^ 1);
                SC_STEP_(6); SC_STEP_(7);
#undef SC_STEP_
                { const LAS float* gp = sl + 2 * SC_OPS_F + b * SC_GAM_F + kq * 8; const f32x4 g0 = *(const LAS f32x4*)gp, g1 = *(const LAS f32x4*)(gp + 4);
                  Sa[0] *= lo2(g0); Sa[1] *= hi2(g0); Sa[2] *= lo2(g1); Sa[3] *= hi2(g1); Sb[0] *= lo2(g0); Sb[1] *= hi2(g0); Sb[2] *= lo2(g1); Sb[3] *= hi2(g1); }
                gA = gB;
            }
            __syncthreads();
        }
        if (active) SC_YSTORE((NC - 1) & 1, NC - 1);
#undef SC_GLOAD
#undef SC_F0
#undef SC_F1
#undef SC_F2
#undef SC_F3
#undef SC_F4
#undef SC_YSTORE
        if (active && out_sf) { float* dp = (dir ? out_sb : out_sf) + soff; *(GAS f32x4*)dp = (f32x4){Sa[0].x, Sa[0].y, Sa[1].x, Sa[1].y}; *(GAS f32x4*)(dp + 4) = (f32x4){Sa[2].x, Sa[2].y, Sa[3].x, Sa[3].y};
            *(GAS f32x4*)(dp + 64) = (f32x4){Sb[0].x, Sb[0].y, Sb[1].x, Sb[1].y}; *(GAS f32x4*)(dp + 68) = (f32x4){Sb[2].x, Sb[2].y, Sb[3].x, Sb[3].y}; }
    }
}
__device__ __forceinline__ void rwkv_post(Frame& F, const Args& A, int Ms, const h16s* RS, const h16s* KS, const h16s* VS, const h16s* AF, const h16s* AB, const h16s* LG, const h16s* YF, const h16s* YB, bf16* ORW  ) {
    const int gw = F.vcu * NWAVES + F.wave, NGW = F.G * NWAVES; const float *lnw = A.in[I_LNW], *lnb = A.in[I_LNB], *k_a = A.in[I_KA], *r_k = A.in[I_RK];
    for (int s = gw; s < Ms; s += NGW) {
#pragma unroll
        for (int c = 0; c < 4; ++c) { const int col = c * 512 + F.lane * 8; const size_t off = (size_t)s * D_RW + col;
            float yf[8], yb[8], r[8], k[8], v[8], af[8], ab[8], g[8], w[8], b[8], ka[8], rk[8];
            unpack_h8(*(const GAS v4u*)(YF + off), yf); unpack_h8(*(const GAS v4u*)(YB + off), yb); unpack_h8(*(const GAS v4u*)(RS + off), r); unpack_h8(*(const GAS v4u*)(KS + off), k);
            unpack_h8(*(const GAS v4u*)(VS + off), v); unpack_h8(*(const GAS v4u*)(AF + off), af); unpack_h8(*(const GAS v4u*)(AB + off), ab); unpack_h8(*(const GAS v4u*)(LG + off), g);
#pragma unroll
            for (int h = 0; h < 2; ++h) { const f32x4 a = *(const GAS f32x4*)(lnw + col + 4 * h), bb = *(const GAS f32x4*)(lnb + col + 4 * h), cc = *(const GAS f32x4*)(k_a + col + 4 * h), dd = *(const GAS f32x4*)(r_k + col + 4 * h);
                w[4 * h] = a.x; w[4 * h + 1] = a.y; w[4 * h + 2] = a.z; w[4 * h + 3] = a.w; b[4 * h] = bb.x; b[4 * h + 1] = bb.y; b[4 * h + 2] = bb.z; b[4 * h + 3] = bb.w;
                ka[4 * h] = cc.x; ka[4 * h + 1] = cc.y; ka[4 * h + 2] = cc.z; ka[4 * h + 3] = cc.w; rk[4 * h] = dd.x; rk[4 * h + 1] = dd.y; rk[4 * h + 2] = dd.z; rk[4 * h + 3] = dd.w; }
            float sf = 0.f, sb = 0.f, bf_ = 0.f, bb_ = 0.f;
#pragma unroll
            for (int e = 0; e < 8; ++e) { sf += yf[e]; sb += yb[e]; const float t = r[e] * k[e] * rk[e]; bf_ += t * (1.0f + (af[e] - 1.0f) * ka[e]); bb_ += t * (1.0f + (ab[e] - 1.0f) * ka[e]); }
            sf = sum8(sf) * (1.0f / 64.0f); sb = sum8(sb) * (1.0f / 64.0f); bf_ = sum8(bf_); bb_ = sum8(bb_);
            float qf = 0.f, qb = 0.f;
#pragma unroll
            for (int e = 0; e < 8; ++e) { yf[e] -= sf; yb[e] -= sb; qf += yf[e] * yf[e]; qb += yb[e] * yb[e]; }
            const float rf = 1.0f / sqrtf(sum8(qf) * (1.0f / 64.0f) + LNX_EPS), rb = 1.0f / sqrtf(sum8(qb) * (1.0f / 64.0f) + LNX_EPS);
            float o[8];
#pragma unroll
            for (int e = 0; e < 8; ++e) o[e] = ((yf[e] * rf + yb[e] * rb) * w[e] + 2.0f * b[e] + (bf_ + bb_) * v[e]) * g[e];
            v4u ow; ow.x = pkbf(o[0], o[1]); ow.y = pkbf(o[2], o[3]); ow.z = pkbf(o[4], o[5]); ow.w = pkbf(o[6], o[7]);
            *(GAS v4u*)(ORW + off) = ow; }
    }
}
__global__ void __launch_bounds__(NWAVES * 64, 2) fwd_kernel(Args args) {
    const Args& A = args;
    extern __shared__ __attribute__((aligned(16))) unsigned char lds[];
    Frame F;
    F.lds = (LAS unsigned char*)lds;
    F.MISC = (volatile LAS unsigned*)(F.lds + MISC_OFF);
    F.tid = threadIdx.x; F.lane = F.tid & 63; F.wave = __builtin_amdgcn_readfirstlane(F.tid >> 6);
    F.G = gridDim.x; { const int bx = blockIdx.x; F.vcu = (F.G % 8 == 0) ? (bx % 8) * (F.G / 8) + bx / 8 : bx; }
    F.ws = args.ws; F.out = args.out; F.ctl = (gu32*)(args.ws + WS_CTL);
    for (int u = F.tid; u < (LDS_BYTES - LDSCTL_OFF) / 4; u += NWAVES * 64) ((LAS unsigned*)(F.lds + LDSCTL_OFF))[u] = 0u;
    __syncthreads();
    XcdBarrier bar = xcd_barrier_post((unsigned*)(F.ctl + CW_BAR), F.MISC + 8);
#define GRID_BAR() xcd_barrier(bar)
    unsigned char* ws = args.ws;
    bf16* const H = (bf16*)(ws + WS_H); bf16* const Qb = (bf16*)(ws + WS_Q); bf16* const Kb = (bf16*)(ws + WS_K); bf16* const Vb = (bf16*)(ws + WS_V);
    h16s* const PR = (h16s*)(ws + WS_PR); bf16* const ORW = (bf16*)(ws + WS_ORW); bf16* const MID = (bf16*)(ws + WS_MID);
    const float* const MOD = (const float*)(ws + WS_MOD);

#ifndef PHMASK
#define PHMASK 0xffffffffu
#endif
#define PH(n) RELANE(); if constexpr ((PHMASK >> (n)) & 1u)
#define RELANE() do { int t_ = threadIdx.x; asm volatile("" : "+v"(t_)); F.tid = t_; F.lane = t_ & 63; } while (0)
    PH(0) p0_prologue(F, A); GRID_BAR();
    PH(1) p0b_mod_finalize(F, A); GRID_BAR();

    const bool flip = ((int)blockIdx.x & 1) != 0;
    int two = 2; asm volatile("" : "+s"(two));
    bf16* const HLAT = (bf16*)(ws + WS_HLAT);
    PH(2) modnorm_rows<false>(F, A.in[I_XP], T_CTX, A.in[I_N1], 0, DM, 0, L_CTX, 0, H); GRID_BAR();
    for (int g = 0; g < 2; ++g) {
        const int M = g ? T_LAT : T_CTX, L = g ? L_LAT : L_CTX, jbase = g, jmul = g, ppb = L / 256;
        const float* X = g ? A.in[I_XS] : A.in[I_XP]; float* Y = F.out + O_Y + (g ? (size_t)T_CTX * DM : 0); bf16* PG = (bf16*)Y;
        PH(3) { pg8::Gemm gm{g ? HLAT : H, (const bf16*)(ws + WS_WIN), M, N_IN_P, DM}; pg8::StaticOrder S; S.init(M, N_IN_P, F.G, (int)blockIdx.x);
          pg8::EpiProj E{Qb, Kb, Vb, PR, PG, g ? nullptr : F.out + O_NK, g ? nullptr : F.out + O_NV};
          pg8::gemm_phase<pg8::EpiProj, pg8::StaticOrder, true, true>(F.lds + RING_OFF, gm, S, E); }
        if (g == 0) { __syncthreads(); PH(16) { const int nextra = ((T_CTX / 256) * (N_IN_P / 256)) % F.G, bx = (int)blockIdx.x;
              if (nextra == 0) late_weight_copies(F, A, bx, F.G); else if (bx >= nextra) late_weight_copies(F, A, bx - nextra, F.G - nextra); } }
        GRID_BAR();
        bf16* const Ob = Qb;
        const int nseq = g ? B_LAT : B_CTX;
        h16s *RS = (h16s*)(ws + WS_RS), *KS = (h16s*)(ws + WS_KS), *VS = (h16s*)(ws + WS_VS), *KKb = (h16s*)(ws + WS_KK), *DF = (h16s*)(ws + WS_DF), *DB = (h16s*)(ws + WS_DB), *AF = (h16s*)(ws + WS_AF), *AB = (h16s*)(ws + WS_AB);
        h16s *LG = (h16s*)(ws + WS_LG), *YF = (h16s*)(ws + WS_YF), *YB = (h16s*)(ws + (g ? WS_YB_LAT : WS_YB_CTX)); bf16* LA = (bf16*)(ws + WS_LA);
        for (int ph = 0; ph < two; ++ph) {
          if ((ph == 0) != flip) {
            PH(4) { if (g == 0) { for (int u = F.vcu; u < B_CTX * NH_A; u += F.G) { const int b = u >> 4, h = u & 15; const size_t base = (size_t)b * L_CTX * 2048 + h * 128;
                    att::attn_unit(F.lds + RING_OFF, Qb + base, Ob + base, Kb, Vb, 0, 0, 0, Kb + base, Vb + base, nullptr); } }
            else { const bf16* CK = (const bf16*)(ws + WS_CK); const bf16* CV = (const bf16*)(ws + WS_CV);
                for (int u = F.vcu; u < B_LAT * NH_A * 16; u += F.G) { const int rg = u & 15, h = (u >> 4) & 15, b = u >> 8; const int r0 = 4 * rg, rho0 = min(max(r0 - 4, 0), 56), rho1 = min(max(r0 - 1, 0), 56) + 8;
                    const size_t qbase = ((size_t)b * L_LAT + (size_t)rg * 256) * 2048 + h * 128, lbase = ((size_t)b * L_LAT + (size_t)rho0 * 64) * 2048 + h * 128, cbase = (size_t)b * 256 * 2048 + h * 128;
                    att::attn_unit(F.lds + RING_OFF, Qb + qbase, Ob + qbase, Kb + lbase, Vb + lbase, rho1 - rho0, rho0, r0, CK + cbase, CV + cbase, A.in[I_RPB] + h * 15 * 31); } } }
          } else { PH(5) rwkv_prep(F, A, PR, 0, M, L, RS, KS, VS, KKb, LA); }
        }
        GRID_BAR();
        {   int klora = 256; asm volatile("" : "+s"(klora));
            PH(6) { pg8::Gemm gm{LA, (const bf16*)(ws + WS_WLORA), M, 8192, klora}; pg8::StaticOrder S; S.init(M, 8192, F.G, (int)blockIdx.x);
              pg8::EpiLora E{{DF, DB, AF, AB, LG}, A.in[I_W0], A.in[I_A0], 0};
              pg8::gemm_phase<pg8::EpiLora, pg8::StaticOrder, true, true>(F.lds + RING_OFF, gm, S, E); }
            PH(6) { pg8::Gemm gm{LA + (size_t)M * 256, (const bf16*)(ws + WS_WLORA) + (size_t)8192 * 256, M, 2048, klora}; pg8::StaticOrder S; S.init(M, 2048, F.G, (int)blockIdx.x);
              pg8::EpiLora E{{DF, DB, AF, AB, LG}, A.in[I_W0], A.in[I_A0], 4};
              pg8::gemm_phase<pg8::EpiLora, pg8::StaticOrder, true, true>(F.lds + RING_OFF, gm, S, E); }
            GRID_BAR();
            PH(7) rwkv_scan(F, A, nseq, L, 0, g != 0, RS, KS, VS, KKb, DF, DB, AF, AB, YF, YB, g ? nullptr : F.out + O_SF, g ? nullptr : F.out + O_SB);
            GRID_BAR();
        }
        for (int ph = 0; ph < two; ++ph) {
          if ((ph == 0) != flip) {
            PH(9) { pg8::Gemm gm{Qb, (const bf16*)(ws + WS_WOA), M, DM, D_ATT}; pg8::StaticOrder S; S.init(M, DM, F.G, (int)blockIdx.x);
              pg8::EpiGate<false> E{MID, PG, 0};
              pg8::gemm_phase<pg8::EpiGate<false>, pg8::StaticOrder, true, true>(F.lds + RING_OFF, gm, S, E); }
          } else { PH(8) rwkv_post(F, A, M, RS, KS, VS, AF, AB, LG, YF, YB, ORW); }
        }
        GRID_BAR();
        PH(10) { pg8::Gemm gm{ORW, (const bf16*)(ws + WS_WOR), M, DM, D_RW}; pg8::StaticOrder S; S.init(M, DM, F.G, (int)blockIdx.x);
          pg8::EpiGate<true> E{MID, PG, DM};
          pg8::gemm_phase<pg8::EpiGate<true>, pg8::StaticOrder, true, true>(F.lds + RING_OFF, gm, S, E); }
        GRID_BAR();
        for (int ph = 0; ph < two; ++ph) {
          if ((ph == 0) != flip) {
            PH(11) { pg8::Gemm gm{MID, (const bf16*)(ws + WS_WOUT), M, DM, DM}; pg8::StaticOrder S; S.init(M, DM, F.G, (int)blockIdx.x);
              pg8::EpiResid<true> E{X, (bf16*)Y, MOD + 2 * DM, jbase, ppb, jmul};
              pg8::gemm_phase<pg8::EpiResid<true>, pg8::StaticOrder, true, true>(F.lds + RING_OFF, gm, S, E); }
          } else if (g == 0) { PH(2) modnorm_rows<false>(F, A.in[I_XS], T_LAT, A.in[I_N1], 0, DM, 1, L_LAT, 1, HLAT); }
        }
        GRID_BAR();
    }
    { int six = 6; asm volatile("" : "+s"(six));
      for (int st = 0; st < six; ++st) {
        for (int ph = 0; ph < two; ++ph) {
          if ((ph == 0) != flip) {
            const int gg = (st == 2 || st == 3) ? 1 : 0, Mg = gg ? T_LAT : T_CTX;
            if (st == 1 || st == 2) {
              PH(13) { pg8::Gemm gm{(const bf16*)(F.ws + (gg ? WS_H2L : WS_H2C)), (const bf16*)(F.ws + WS_WM1), Mg, D_FF, DM}; pg8::StaticOrder S; S.init(Mg, D_FF, F.G, (int)blockIdx.x);
                pg8::EpiRelu2 E{(bf16*)(F.ws + (gg ? WS_UL : WS_UC))};
                pg8::gemm_phase<pg8::EpiRelu2, pg8::StaticOrder, true, true>(F.lds + RING_OFF, gm, S, E); }
            } else if (st == 3 || st == 4) {
              PH(14) { pg8::Gemm gm{(const bf16*)(F.ws + (gg ? WS_UL : WS_UC)), (const bf16*)(F.ws + WS_WM2), Mg, DM, D_FF}; pg8::StaticOrder S; S.init(Mg, DM, F.G, (int)blockIdx.x);
                pg8::EpiResid<false> E{nullptr, (bf16*)(F.out + O_Y + (gg ? (size_t)T_CTX * DM : 0)), (const float*)(F.ws + WS_MOD) + 5 * DM, gg, (gg ? L_LAT : L_CTX) / 256, gg};
                pg8::gemm_phase<pg8::EpiResid<false>, pg8::StaticOrder, true, true>(F.lds + RING_OFF, gm, S, E); }
            }
          } else {
            const int gm_ = (st == 1 || st == 4) ? 1 : 0, Mm = gm_ ? T_LAT : T_CTX; float* const Ym = F.out + O_Y + (gm_ ? (size_t)T_CTX * DM : 0);
            if (st < 2) { PH(12) modnorm16_rows(F, (const h16s*)Ym, Mm, A.in[I_N2], 3 * DM, 4 * DM, gm_, gm_ ? L_LAT : L_CTX, gm_, (bf16*)(F.ws + (gm_ ? WS_H2L : WS_H2C))); }
            else if (st >= 4) { PH(15) final16_rows(F, Ym, Mm, A.in[I_NF]); }
          }
        }
        if (st < 5) GRID_BAR();
      }
    }
#undef GRID_BAR
}

extern "C" void kernel_launch(void* const* d_in, const int* in_sizes, int n_in, void* d_out, int out_size, void* d_ws, size_t ws_size, hipStream_t stream) {
    static int grid = 0;
    if (grid == 0) {
        if (n_in != 31 || ws_size < WS_END) { fprintf(stderr, "kernel_launch: need 31 inputs and >= %zu bytes of workspace; got %d, %zu\n", (size_t)WS_END, n_in, ws_size); grid = -1; return; }
        int dev = 0, cus = 0, per_cu = 0;
        if (hipGetDevice(&dev) != hipSuccess || hipDeviceGetAttribute(&cus, hipDeviceAttributeMultiprocessorCount, dev) != hipSuccess) { grid = -1; return; }
        if (hipFuncSetAttribute((const void*)fwd_kernel, hipFuncAttributeMaxDynamicSharedMemorySize, LDS_BYTES) != hipSuccess) { fprintf(stderr, "kernel_launch: hipFuncSetAttribute failed\n"); grid = -1; return; }
        if (hipOccupancyMaxActiveBlocksPerMultiprocessor(&per_cu, (const void*)fwd_kernel, NWAVES * 64, LDS_BYTES) != hipSuccess || per_cu < 1) fprintf(stderr, "kernel_launch: occupancy query reports %d\n", per_cu);
        (void)hipGetLastError();
        grid = cus;
    }
    if (grid < 0) return;
    if (hipMemsetAsync((char*)d_ws + WS_CTL, 0, CTL_ZERO_BYTES, stream) != hipSuccess) return;
    Args a{};
    for (int i = 0; i < 31; ++i) a.in[i] = (const float*)d_in[i];
    a.out = (float*)d_out; a.ws = (unsigned char*)d_ws;
    hipLaunchKernelGGL(fwd_kernel, dim3(grid), dim3(NWAVES * 64), LDS_BYTES, stream, a);
    const hipError_t le = hipPeekAtLastError();
    if (le != hipSuccess) fprintf(stderr, "kernel_launch: launch failed: %s\n", hipGetErrorName(le));
}
```

```cpp
#include <hip/hip_runtime.h>
#include <cstdio>
#include <cstdint>
namespace pg8 {
#define PG8_LAS __attribute__((address_space(3)))
typedef unsigned short bf16_t;
typedef short bf16x8 __attribute__((ext_vector_type(8)));
typedef float f32x4 __attribute__((ext_vector_type(4)));
typedef unsigned u32x4 __attribute__((ext_vector_type(4)));
constexpr int BM = 256, BK = 64, HALF = 128, HTB = HALF * BK * 2  , STAGE_BYTES = 8 * HTB, NXCD = 8, WGM = 8;

__host__ __device__ __forceinline__ int lds_byte(int r, int c) { const int st = (r >> 4) * 2 + (c >> 5), rr = r & 15, cc = c & 31, ob = rr * 64 + cc * 2; return st * 1024 + (ob ^ (((ob >> 9) & 1) << 5)); }
__host__ __device__ __forceinline__ void stage_rc(int b, int& R, int& C) { const int st = b / 1024, sb = b % 1024, swz = sb ^ (((sb >> 9) & 1) << 5); R = (st >> 1) * 16 + swz / 64; C = (st & 1) * 32 + (swz % 64) / 2; }
__host__ __device__ __forceinline__ int perm32(int rho) { const int n = rho >> 4, i = rho & 15; return 8 * (i >> 2) + 4 * n + (i & 3); }

struct Unit { int pm, pn; };
struct Gemm { const bf16_t* A; const bf16_t* Bt; int M, N, K; };

struct StaticOrder {
    int nM, nN, nwg, G, c;
    __host__ __device__ void init(int M, int N, int G_, int c_) { nM = M / BM; nN = N / BM; nwg = nM * nN; G = G_; c = c_; }
    __host__ __device__ bool next(int i, Unit& u) const {
        const long L = (long)i * G + c; if (L >= nwg) return false;
        int wgid = (int)L; { const int q = nwg / NXCD, r = nwg % NXCD, xcd = wgid % NXCD, off = wgid / NXCD; wgid = (xcd < r ? xcd * (q + 1) : r * (q + 1) + (xcd - r) * q) + off; }
        const int nig = WGM * nN, gid = wgid / nig, fm = gid * WGM, gsz = (nM - fm) < WGM ? (nM - fm) : WGM;
        u.pm = fm + ((wgid % nig) % gsz); u.pn = (wgid % nig) / gsz; return true;
    }
    __device__ __forceinline__ void a_ready(const Unit&) const {}
    __device__ __forceinline__ void done(const Unit&) const {}
};

__device__ __forceinline__ unsigned cvt_pk_bf16(float lo, float hi) { unsigned r; asm volatile("v_cvt_pk_bf16_f32 %0, %1, %2" : "=v"(r) : "v"(lo), "v"(hi)); return r; }
typedef _Float16 h16x2 __attribute__((ext_vector_type(2)));
__device__ __forceinline__ unsigned cvt_pk_f16(float lo, float hi) { h16x2 v = {(_Float16)lo, (_Float16)hi}; return __builtin_bit_cast(unsigned, v); }
__device__ __forceinline__ float sigmoidf_(float x) { return __builtin_amdgcn_rcpf(1.0f + __builtin_amdgcn_exp2f(-1.4426950408889634f * x)); }
__device__ __forceinline__ float bf_lo(unsigned u) { return __builtin_bit_cast(float, u << 16); }
__device__ __forceinline__ float bf_hi(unsigned u) { return __builtin_bit_cast(float, u & 0xffff0000u); }

struct EpiProj {
    static constexpr bool PERM = true, AFTER_DRAIN = false;
    bf16_t *Q, *K, *V, *PR, *PG; float *NK, *NV;
    __device__ __forceinline__ void operator()(const f32x4 (&acc)[2][2][4][2], const Unit& u, int wr, int wc, int fr, int fq) const {
        const int row0 = u.pm * BM + wr * 64 + fr, pn = u.pn;
        bf16_t* base; int ld, colt, mode = 0; float* fb = nullptr;
        if (pn < 8) { base = Q; ld = 2048; colt = pn * 256; }
        else if (pn < 16) { base = K; ld = 2048; colt = (pn - 8) * 256; fb = NK; }
        else if (pn < 24) { base = V; ld = 2048; colt = (pn - 16) * 256; fb = NV; }
        else if (pn < 50) { base = PR; ld = 6656; colt = (pn - 24) * 256; mode = 1; }
        else { base = PG; ld = 8192; colt = (pn - 50) * 256; mode = 2; }
        const int col0 = colt + wc * 32 + 8 * fq;
#pragma unroll
        for (int ai = 0; ai < 2; ++ai)
#pragma unroll
            for (int m = 0; m < 4; ++m) { const size_t r = (size_t)(row0 + ai * HALF + m * 16); bf16_t* rowp = base + r * ld + col0;
#pragma unroll
                for (int bj = 0; bj < 2; ++bj) { f32x4 v0 = acc[ai][bj][m][0], v1 = acc[ai][bj][m][1]; u32x4 w;
                    if (mode == 2) { v0 = (f32x4){sigmoidf_(v0[0]), sigmoidf_(v0[1]), sigmoidf_(v0[2]), sigmoidf_(v0[3])}; v1 = (f32x4){sigmoidf_(v1[0]), sigmoidf_(v1[1]), sigmoidf_(v1[2]), sigmoidf_(v1[3])}; }
                    if (mode == 1) { w.x = cvt_pk_f16(v0[0], v0[1]); w.y = cvt_pk_f16(v0[2], v0[3]); w.z = cvt_pk_f16(v1[0], v1[1]); w.w = cvt_pk_f16(v1[2], v1[3]); }
                    else { w.x = cvt_pk_bf16(v0[0], v0[1]); w.y = cvt_pk_bf16(v0[2], v0[3]); w.z = cvt_pk_bf16(v1[0], v1[1]); w.w = cvt_pk_bf16(v1[2], v1[3]); }
                    *(u32x4*)(rowp + bj * HALF) = w;
                    if (fb) { float* fp = fb + r * 2048 + col0 + bj * HALF; *(f32x4*)fp = v0; *(f32x4*)(fp + 4) = v1; } } }
    }
};
struct EpiLora {
    static constexpr bool PERM = true, AFTER_DRAIN = false;
    bf16_t* OUT[5]; const float *w0, *a0; int selb;
    __device__ __forceinline__ void operator()(const f32x4 (&acc)[2][2][4][2], const Unit& u, int wr, int wc, int fr, int fq) const {
        const int row0 = u.pm * BM + wr * 64 + fr, sel = selb + (u.pn >> 3), colt = (u.pn & 7) * 256, col0 = colt + wc * 32 + 8 * fq;
        bf16_t* base = sel == 0 ? OUT[0] : sel == 1 ? OUT[1] : sel == 2 ? OUT[2] : sel == 3 ? OUT[3] : OUT[4];
        const float* bias = sel < 2 ? w0 + sel * 2048 : a0 + (sel - 2) * 2048;
        f32x4 bv[2][2];
#pragma unroll
        for (int bj = 0; bj < 2; ++bj)
#pragma unroll
            for (int n = 0; n < 2; ++n) bv[bj][n] = sel < 4 ? *(const f32x4*)(bias + col0 + bj * HALF + 4 * n) : (f32x4){0.f, 0.f, 0.f, 0.f};
#pragma unroll
        for (int ai = 0; ai < 2; ++ai)
#pragma unroll
            for (int m = 0; m < 4; ++m) { bf16_t* rowp = base + (size_t)(row0 + ai * HALF + m * 16) * 2048 + col0;
#pragma unroll
                for (int bj = 0; bj < 2; ++bj) { f32x4 v0 = acc[ai][bj][m][0] + bv[bj][0], v1 = acc[ai][bj][m][1] + bv[bj][1];
                    if (sel < 4) {
#pragma unroll
                        for (int e = 0; e < 4; ++e) { v0[e] = sigmoidf_(v0[e]); v1[e] = sigmoidf_(v1[e]); }
                        if (sel < 2) {
#pragma unroll
                            for (int e = 0; e < 4; ++e) { v0[e] = __builtin_amdgcn_exp2f(-0.87503716f * v0[e]); v1[e] = __builtin_amdgcn_exp2f(-0.87503716f * v1[e]); } } }
                    u32x4 w; w.x = cvt_pk_f16(v0[0], v0[1]); w.y = cvt_pk_f16(v0[2], v0[3]); w.z = cvt_pk_f16(v1[0], v1[1]); w.w = cvt_pk_f16(v1[2], v1[3]);
                    *(u32x4*)(rowp + bj * HALF) = w; } }
    }
};
template <bool ADD> struct EpiGate {
    static constexpr bool PERM = true, AFTER_DRAIN = false;
    bf16_t* O; const bf16_t* G; int goff;
    __device__ __forceinline__ void operator()(const f32x4 (&acc)[2][2][4][2], const Unit& u, int wr, int wc, int fr, int fq) const {
        const int row0 = u.pm * BM + wr * 64 + fr, col0 = u.pn * BM + wc * 32 + 8 * fq;
#pragma unroll
        for (int ai = 0; ai < 2; ++ai)
#pragma unroll
            for (int m = 0; m < 4; ++m) { const size_t r = (size_t)(row0 + ai * HALF + m * 16); bf16_t* rowp = O + r * 4096 + col0; const bf16_t* gp = G + r * 8192 + goff + col0;
#pragma unroll
                for (int bj = 0; bj < 2; ++bj) { const u32x4 g = *(const u32x4*)(gp + bj * HALF); const f32x4 a0 = acc[ai][bj][m][0], a1 = acc[ai][bj][m][1];
                    float o[8] = {a0[0] * bf_lo(g.x), a0[1] * bf_hi(g.x), a0[2] * bf_lo(g.y), a0[3] * bf_hi(g.y), a1[0] * bf_lo(g.z), a1[1] * bf_hi(g.z), a1[2] * bf_lo(g.w), a1[3] * bf_hi(g.w)};
                    if (ADD) { const u32x4 p = *(const u32x4*)(rowp + bj * HALF); o[0] += bf_lo(p.x); o[1] += bf_hi(p.x); o[2] += bf_lo(p.y); o[3] += bf_hi(p.y); o[4] += bf_lo(p.z); o[5] += bf_hi(p.z); o[6] += bf_lo(p.w); o[7] += bf_hi(p.w); }
                    u32x4 w; w.x = cvt_pk_bf16(o[0], o[1]); w.y = cvt_pk_bf16(o[2], o[3]); w.z = cvt_pk_bf16(o[4], o[5]); w.w = cvt_pk_bf16(o[6], o[7]);
                    *(u32x4*)(rowp + bj * HALF) = w; } }
    }
};
__device__ __forceinline__ f32x4 h4lo(unsigned a, unsigned b) { typedef _Float16 hh2 __attribute__((ext_vector_type(2))); const hh2 x = __builtin_bit_cast(hh2, a), y = __builtin_bit_cast(hh2, b); return (f32x4){(float)x.x, (float)x.y, (float)y.x, (float)y.y}; }
template <bool RF32> struct EpiResid {
    static constexpr bool PERM = true, AFTER_DRAIN = false;
    const float* R32; bf16_t* XH; const float* gt; int jbase, ppb, jmul;
    __device__ __forceinline__ void operator()(const f32x4 (&acc)[2][2][4][2], const Unit& u, int wr, int wc, int fr, int fq) const {
        const int row0 = u.pm * BM + wr * 64 + fr, col0 = u.pn * BM + wc * 32 + 8 * fq;
        const float* g = gt + (size_t)(jbase + (u.pm / ppb) * jmul) * 24576 + col0;
        f32x4 gv[2][2];
#pragma unroll
        for (int bj = 0; bj < 2; ++bj)
#pragma unroll
            for (int n = 0; n < 2; ++n) gv[bj][n] = *(const f32x4*)(g + bj * HALF + 4 * n);
#pragma unroll
        for (int ai = 0; ai < 2; ++ai)
#pragma unroll
            for (int m = 0; m < 4; ++m) { const size_t row = (size_t)(row0 + ai * HALF + m * 16); bf16_t* xp = XH + row * 8192 + col0;
#pragma unroll
                for (int bj = 0; bj < 2; ++bj) { f32x4 r0, r1;
                    if (RF32) { const float* rp = R32 + row * 4096 + col0 + bj * HALF; r0 = *(const f32x4*)rp; r1 = *(const f32x4*)(rp + 4); }
                    else { const u32x4 h = *(const u32x4*)(xp + bj * HALF); r0 = h4lo(h.x, h.y); r1 = h4lo(h.z, h.w); }
                    const f32x4 y0 = r0 + gv[bj][0] * acc[ai][bj][m][0], y1 = r1 + gv[bj][1] * acc[ai][bj][m][1];
                    u32x4 w; w.x = cvt_pk_f16(y0[0], y0[1]); w.y = cvt_pk_f16(y0[2], y0[3]); w.z = cvt_pk_f16(y1[0], y1[1]); w.w = cvt_pk_f16(y1[2], y1[3]);
                    *(u32x4*)(xp + bj * HALF) = w; } }
    }
};
struct EpiRelu2 {
    static constexpr bool PERM = true, AFTER_DRAIN = false;
    bf16_t* U;
    __device__ __forceinline__ void operator()(const f32x4 (&acc)[2][2][4][2], const Unit& u, int wr, int wc, int fr, int fq) const {
        const int row0 = u.pm * BM + wr * 64 + fr, col0 = u.pn * BM + wc * 32 + 8 * fq;
#pragma unroll
        for (int ai = 0; ai < 2; ++ai)
#pragma unroll
            for (int m = 0; m < 4; ++m) { bf16_t* rowp = U + (size_t)(row0 + ai * HALF + m * 16) * 16384 + col0;
#pragma unroll
                for (int bj = 0; bj < 2; ++bj) { f32x4 v0 = acc[ai][bj][m][0], v1 = acc[ai][bj][m][1];
#pragma unroll
                    for (int e = 0; e < 4; ++e) { const float a = fmaxf(v0[e], 0.f), b = fmaxf(v1[e], 0.f); v0[e] = a * a; v1[e] = b * b; }
                    u32x4 w; w.x = cvt_pk_bf16(v0[0], v0[1]); w.y = cvt_pk_bf16(v0[2], v0[3]); w.z = cvt_pk_bf16(v1[0], v1[1]); w.w = cvt_pk_bf16(v1[2], v1[3]);
                    *(u32x4*)(rowp + bj * HALF) = w; } }
    }
};

template <class Epi, class Sched, bool ALIGN_EPI = false, bool SP2 = false>
__device__ __forceinline__ void gemm_phase(PG8_LAS unsigned char* lds, const Gemm g, const Sched& S, const Epi& E) {
    int tid_ = threadIdx.x; asm volatile("" : "+v"(tid_));
    const int tid = tid_, wid = __builtin_amdgcn_readfirstlane(tid >> 6), lane = tid & 63, wr = wid >> 2, wc = wid & 3, fr = lane & 15, fq = lane >> 4;
    const int K = g.K, nt = K / BK;
    unsigned voffA[2], voffB[2];
#pragma unroll
    for (int i = 0; i < 2; ++i) { int R, C; stage_rc(tid * 16 + i * 8192, R, C); const int Rb = Epi::PERM ? ((R & ~31) + perm32(R & 31)) : R;
        voffA[i] = (unsigned)(R * K + C) * 2u; voffB[i] = (unsigned)(Rb * K + C) * 2u; }
    const size_t kstep = (size_t)(BK * 2);
    const size_t hstep = (size_t)HALF * K * 2;
    const size_t tstep = 2 * hstep;
    const unsigned ldsw = (unsigned)wid * 1024u;
    const int aoff = lds_byte(wr * 64 + fr, fq * 8), boff = lds_byte(wc * 32 + fr, fq * 8);
#define PG8_SA(b, h) (((b) * 2 + (h)) * HTB)
#define PG8_SB(b, h) ((4 + (b) * 2 + (h)) * HTB)
#define PG8_STAGE(bufoff, gbase, voff) do { _Pragma("unroll") for (int _i = 0; _i < 2; ++_i) \
        __builtin_amdgcn_global_load_lds((const unsigned*)((const char*)(gbase) + (voff)[_i]), (PG8_LAS unsigned*)(lds + (bufoff) + ldsw + _i * 8192), 16, 0, 0); } while (0)
#define PG8_LDA(dst, b, h) do { _Pragma("unroll") for (int m = 0; m < 4; ++m) _Pragma("unroll") for (int k = 0; k < 2; ++k) dst[m][k] = *(const PG8_LAS bf16x8*)(lds + PG8_SA(b, h) + aoff + m * 2048 + k * 1024); } while (0)
#define PG8_LDB(dst, b, h) do { _Pragma("unroll") for (int n = 0; n < 2; ++n) _Pragma("unroll") for (int k = 0; k < 2; ++k) dst[n][k] = *(const PG8_LAS bf16x8*)(lds + PG8_SB(b, h) + boff + n * 2048 + k * 1024); } while (0)
#define PG8_MMA(ai, bj, At, Bt) do { __builtin_amdgcn_s_setprio(1); _Pragma("unroll") for (int m = 0; m < 4; ++m) _Pragma("unroll") for (int n = 0; n < 2; ++n) _Pragma("unroll") for (int k = 0; k < 2; ++k) \
        acc[ai][bj][m][n] = __builtin_amdgcn_mfma_f32_16x16x32_bf16(Bt[n][k], At[m][k], acc[ai][bj][m][n], 0, 0, 0); __builtin_amdgcn_s_setprio(0); } while (0)
#define PG8_WAIT_V(n) asm volatile("s_waitcnt vmcnt(" #n ")" ::: "memory")
#define PG8_WAIT_L(n) asm volatile("s_waitcnt lgkmcnt(" #n ")" ::: "memory")
#define PG8_BAR __builtin_amdgcn_s_barrier()
#define PG8_SCHED __builtin_amdgcn_sched_barrier(0)
    Unit cur, nxt; int ui = 0;
    if (!S.next(0, cur)) return;
    f32x4 acc[2][2][4][2];
#pragma unroll
    for (int a = 0; a < 2; ++a)
#pragma unroll
        for (int b = 0; b < 2; ++b)
#pragma unroll
            for (int m = 0; m < 4; ++m)
#pragma unroll
                for (int n = 0; n < 2; ++n) acc[a][b][m][n] = (f32x4){0.f, 0.f, 0.f, 0.f};
    bf16x8 At[4][2], B0[2][2], B1[2][2];
    const char* cA = (const char*)g.A + (size_t)cur.pm * tstep; const char* cB = (const char*)g.Bt + (size_t)cur.pn * tstep;
    S.a_ready(cur);
    if constexpr (SP2) {
        PG8_STAGE(PG8_SB(0, 0), cB, voffB); PG8_STAGE(PG8_SB(0, 1), cB + hstep, voffB); PG8_STAGE(PG8_SA(0, 0), cA, voffA); PG8_STAGE(PG8_SA(0, 1), cA + hstep, voffA);
        if (wr == 1) PG8_BAR;
        PG8_WAIT_V(2); PG8_BAR;
        PG8_STAGE(PG8_SB(1, 0), cB + kstep, voffB); PG8_STAGE(PG8_SA(1, 0), cA + kstep, voffA); PG8_STAGE(PG8_SB(1, 1), cB + hstep + kstep, voffB);
        PG8_WAIT_V(6); PG8_BAR;
    } else {
        PG8_STAGE(PG8_SB(0, 0), cB, voffB); PG8_STAGE(PG8_SA(0, 0), cA, voffA); PG8_STAGE(PG8_SB(0, 1), cB + hstep, voffB); PG8_STAGE(PG8_SA(0, 1), cA + hstep, voffA);
        if (wr == 1) PG8_BAR;
        PG8_WAIT_V(4); PG8_BAR;
        PG8_STAGE(PG8_SB(1, 0), cB + kstep, voffB); PG8_STAGE(PG8_SA(1, 0), cA + kstep, voffA); PG8_STAGE(PG8_SB(1, 1), cB + hstep + kstep, voffB);
        PG8_WAIT_V(6); PG8_BAR;
    }
    for (;;) {
        const bool has_next = S.next(ui + 1, nxt);
        const char* nA = has_next ? (const char*)g.A + (size_t)nxt.pm * tstep : cA; const char* nB = has_next ? (const char*)g.Bt + (size_t)nxt.pn * tstep : cB;
        for (int t = 0; t < nt; t += 2) {
            const bool last = (t == nt - 2);
            const char* a1 = cA + (size_t)(t + 1) * kstep;
            const char* a2 = last ? nA : cA + (size_t)(t + 2) * kstep; const char* b2 = last ? nB : cB + (size_t)(t + 2) * kstep;
            const char* a3 = a2 + kstep; const char* b3 = b2 + kstep;
            if (last && has_next) S.a_ready(nxt);
            if constexpr (SP2) {
            PG8_LDB(B0, 0, 0); PG8_LDB(B1, 0, 1); PG8_SCHED; PG8_LDA(At, 0, 0); PG8_STAGE(PG8_SA(1, 1), a1 + hstep, voffA);
            PG8_WAIT_V(8); PG8_WAIT_L(0); PG8_BAR; PG8_MMA(0, 0, At, B0); PG8_MMA(0, 1, At, B1); PG8_BAR; PG8_SCHED;
            PG8_LDA(At, 0, 1); PG8_STAGE(PG8_SB(0, 0), b2, voffB); PG8_STAGE(PG8_SB(0, 1), b2 + hstep, voffB); PG8_STAGE(PG8_SA(0, 0), a2, voffA);
            PG8_WAIT_V(8); PG8_WAIT_L(0); PG8_BAR; PG8_MMA(1, 0, At, B0); PG8_MMA(1, 1, At, B1); PG8_BAR; PG8_SCHED;
            PG8_LDB(B0, 1, 0); PG8_LDB(B1, 1, 1); PG8_SCHED; PG8_LDA(At, 1, 0); PG8_STAGE(PG8_SA(0, 1), a2 + hstep, voffA);
            PG8_WAIT_V(8); PG8_WAIT_L(0); PG8_BAR; PG8_MMA(0, 0, At, B0); PG8_MMA(0, 1, At, B1); PG8_BAR; PG8_SCHED;
            PG8_LDA(At, 1, 1); PG8_STAGE(PG8_SB(1, 0), b3, voffB); PG8_STAGE(PG8_SB(1, 1), b3 + hstep, voffB); PG8_STAGE(PG8_SA(1, 0), a3, voffA);
            PG8_WAIT_V(8); PG8_WAIT_L(0); PG8_BAR; PG8_MMA(1, 0, At, B0); PG8_MMA(1, 1, At, B1); PG8_BAR; PG8_SCHED;
            } else {
            PG8_LDB(B0, 0, 0); PG8_SCHED; PG8_LDA(At, 0, 0); PG8_STAGE(PG8_SA(1, 1), a1 + hstep, voffA);
            PG8_WAIT_L(8); PG8_BAR; PG8_WAIT_L(0); PG8_MMA(0, 0, At, B0); PG8_BAR; PG8_SCHED;
            PG8_LDB(B1, 0, 1); PG8_STAGE(PG8_SB(0, 0), b2, voffB);
            PG8_BAR; PG8_WAIT_L(0); PG8_MMA(0, 1, At, B1); PG8_BAR;
            PG8_LDA(At, 0, 1); PG8_STAGE(PG8_SA(0, 0), a2, voffA);
            PG8_BAR; PG8_WAIT_L(0); PG8_MMA(1, 0, At, B0); PG8_BAR; PG8_SCHED;
            PG8_STAGE(PG8_SB(0, 1), b2 + hstep, voffB);
            PG8_WAIT_V(6); PG8_BAR; PG8_MMA(1, 1, At, B1); PG8_BAR;
            PG8_LDB(B0, 1, 0); PG8_SCHED; PG8_LDA(At, 1, 0); PG8_STAGE(PG8_SA(0, 1), a2 + hstep, voffA);
            PG8_WAIT_L(8); PG8_BAR; PG8_WAIT_L(0); PG8_MMA(0, 0, At, B0); PG8_BAR; PG8_SCHED;
            PG8_LDB(B1, 1, 1); PG8_STAGE(PG8_SB(1, 0), b3, voffB);
            PG8_BAR; PG8_WAIT_L(0); PG8_MMA(0, 1, At, B1); PG8_BAR;
            PG8_LDA(At, 1, 1); PG8_STAGE(PG8_SA(1, 0), a3, voffA);
            PG8_BAR; PG8_WAIT_L(0); PG8_MMA(1, 0, At, B0); PG8_BAR; PG8_SCHED;
            PG8_STAGE(PG8_SB(1, 1), b3 + hstep, voffB);
            PG8_WAIT_V(6); PG8_BAR; PG8_MMA(1, 1, At, B1); PG8_BAR;
            }
        }
        if constexpr (ALIGN_EPI) { if (wr == 0) PG8_BAR; }
        if constexpr (!Epi::AFTER_DRAIN) { E(acc, cur, wr, wc, fr, fq); S.done(cur); }
        if (!has_next) break;
#pragma unroll
        for (int a = 0; a < 2; ++a)
#pragma unroll
            for (int b = 0; b < 2; ++b)
#pragma unroll
                for (int m = 0; m < 4; ++m)
#pragma unroll
                    for (int n = 0; n < 2; ++n) acc[a][b][m][n] = (f32x4){0.f, 0.f, 0.f, 0.f};
        cur = nxt; cA = nA; cB = nB; ++ui;
        if constexpr (ALIGN_EPI) { if (wr == 1) PG8_BAR; }
    }
    PG8_WAIT_V(0);
    if constexpr (!ALIGN_EPI) { if (wr == 0) PG8_BAR; }
    PG8_BAR;
    if constexpr (Epi::AFTER_DRAIN) { E.fused(acc, cur, wr, wc, fr, fq, lds, wid, lane); S.done(cur); }
#undef PG8_SA
#undef PG8_SB
#undef PG8_STAGE
#undef PG8_LDA
#undef PG8_LDB
#undef PG8_MMA
#undef PG8_WAIT_V
#undef PG8_WAIT_L
#undef PG8_BAR
#undef PG8_SCHED
}
}


constexpr int NWAVES = 8;
constexpr int DM = 4096, T_CTX = 8192, T_LAT = 32768, L_CTX = 256, L_LAT = 4096, B_CTX = 32, B_LAT = 8;
constexpr int NH_A = 16, DH_A = 128, D_ATT = 2048, NH_R = 32, DH_R = 64, D_RW = 2048;
constexpr int C_RWKV = 6592, C_RWKV_P = 6656, D_IN = 20928, N_IN_P = 20992, D_FF = 16384, N_LORA = 10240, K_LORA = 512, NMOD = 24576;
constexpr float RMS_EPS = 1e-6f, LNX_EPS = 64e-5f;
constexpr size_t MiB = 1u << 20;
constexpr size_t WS_CTL = 0, CTL_ZERO_BYTES = 1 * MiB;
constexpr size_t WS_MODP = 1 * MiB;
constexpr size_t WS_MOD = 8 * MiB;
constexpr size_t WS_WIN = 9 * MiB;
constexpr size_t WS_WOA = 173 * MiB, WS_WOR = 189 * MiB, WS_WOUT = 205 * MiB;
constexpr size_t WS_WM1 = 237 * MiB, WS_WM2 = 365 * MiB;
constexpr size_t WS_WLORA = 493 * MiB;
constexpr size_t WS_CK = 503 * MiB, WS_CV = 511 * MiB;
constexpr size_t WS_H = 520 * MiB;
constexpr size_t WS_Q = 776 * MiB, WS_K = 904 * MiB, WS_V = 1032 * MiB;
constexpr size_t WS_PR = 1160 * MiB;
constexpr size_t WS_ORW = 1832 * MiB;
constexpr size_t WS_HLAT = 1576 * MiB;
constexpr size_t WS_MID = 1160 * MiB;
constexpr size_t WS_H2L = 512 * MiB, WS_UL = 768 * MiB;
constexpr size_t WS_H2C = 1416 * MiB, WS_UC = 1792 * MiB;
constexpr size_t WS_END = 2048 * MiB;
constexpr size_t WS_RS = 520 * MiB, WS_KS = 648 * MiB, WS_VS = 1576 * MiB, WS_KK = 1704 * MiB;
constexpr size_t WS_DF = 1160 * MiB, WS_DB = 1288 * MiB, WS_AF = 1416 * MiB, WS_YF = WS_ORW, WS_AB = WS_K, WS_LG = WS_V;
constexpr size_t WS_YB_CTX = 1960 * MiB, WS_YB_LAT = WS_WIN, WS_LA = 2016 * MiB;
static_assert(WS_UL + (size_t)T_LAT * D_FF * 2 <= WS_UC && WS_UC + (size_t)T_CTX * D_FF * 2 <= WS_END && WS_H2L + (size_t)T_LAT * DM * 2 <= WS_UL && WS_LA + (size_t)T_LAT * K_LORA * 2 <= WS_END && WS_YB_CTX + (size_t)T_CTX * D_RW * 2 <= WS_LA && WS_YF + (size_t)T_LAT * D_RW * 2 <= WS_YB_CTX && WS_MID + (size_t)T_LAT * DM * 2 <= WS_AF, "d_ws map");
constexpr int CW_BAR = 4096;
constexpr int RING_OFF = 0, RING_BYTES = 131072;
constexpr int LDSCTL_OFF = RING_BYTES, MISC_OFF = LDSCTL_OFF + 320;
constexpr int LDS_BYTES = 147456;

#define GAS __attribute__((address_space(1)))
#define LAS __attribute__((address_space(3)))
typedef unsigned short bf16;
typedef unsigned v4u __attribute__((ext_vector_type(4)));
typedef float f32x4 __attribute__((ext_vector_type(4)));
typedef short bf16x8 __attribute__((ext_vector_type(8)));
typedef GAS unsigned gu32;
typedef GAS unsigned long long gu64;
#define RLX_AGENT __ATOMIC_RELAXED, __HIP_MEMORY_SCOPE_AGENT
#define LDS_WAIT() asm volatile("s_waitcnt lgkmcnt(0)" ::: "memory")
#define VM_WAIT() asm volatile("s_waitcnt vmcnt(0)" ::: "memory")
__device__ __forceinline__ unsigned long long rt() { return __builtin_amdgcn_s_memrealtime(); }
__device__ __forceinline__ unsigned f2bf(float f) { unsigned u = __builtin_bit_cast(unsigned, f); return (u + 0x7fffu + ((u >> 16) & 1u)) >> 16; }
__device__ __forceinline__ unsigned pk2(float lo, float hi) { return f2bf(lo) | (f2bf(hi) << 16); }

#define XB_TMO      128
#define XB_XCNT(j)  (256  + 64 * (j))
#define XB_XSUB(j)  (1280 + 64 * (j))
#define XB_XGEN(j)  (2304 + 64 * (j))
#define XB_TOP      3328
#define XB_TOPGEN   3392
#define XCD_BAR_WORDS 3456
#define XB_SPIN_CAP (1u << 18)

__device__ __forceinline__ unsigned xb_ld(unsigned* p)              { return __hip_atomic_load(p, __ATOMIC_RELAXED, __HIP_MEMORY_SCOPE_AGENT); }
__device__ __forceinline__ unsigned xb_add(unsigned* p, unsigned v) { return __hip_atomic_fetch_add(p, v, __ATOMIC_RELAXED, __HIP_MEMORY_SCOPE_AGENT); }
__device__ __forceinline__ unsigned xb_xcc_id() { return (unsigned)__builtin_amdgcn_s_getreg((3 << 11) | 20) & 0xFu; }
#define XB_SPIN(cond, bar) do { unsigned _sp = 0; while (cond) { __builtin_amdgcn_s_sleep(1); \
    if ((++_sp & 255u) == 0u) { if (xb_ld(&(bar)[XB_TMO])) break; if (_sp > XB_SPIN_CAP) { atomicAdd(&(bar)[XB_TMO], 1u); break; } } } } while (0)

struct XcdBarrier {
    unsigned* bar; unsigned x;
    volatile LAS unsigned* st;
};

__device__ __forceinline__ XcdBarrier xcd_barrier_post(unsigned* bar, volatile LAS unsigned* st) {
    XcdBarrier b; b.bar = bar; b.x = xb_xcc_id(); b.st = st;
    if (threadIdx.x == 0) (void)xb_add(&bar[XB_XCNT(b.x)], 1u);
    return b;
}
__device__ __forceinline__ void xcd_barrier_complete(unsigned* bar, unsigned x, unsigned& nloc, unsigned& nx) {
    const unsigned G = gridDim.x * gridDim.y * gridDim.z;
    unsigned sum, cnt, mine, sp = 0u;
    for (;;) {
        sum = 0u; cnt = 0u; mine = 0u;
#pragma unroll
        for (unsigned j = 0; j < 16; ++j) { const unsigned c = xb_ld(&bar[XB_XCNT(j)]); sum += c; cnt += (c > 0u) ? 1u : 0u; mine = (j == x) ? c : mine; }
        if (sum == G) break;
        __builtin_amdgcn_s_sleep(1);
        if ((++sp & 255u) == 0u) { if (xb_ld(&bar[XB_TMO])) break; if (sp > XB_SPIN_CAP) { atomicAdd(&bar[XB_TMO], 1u); break; } }
    }
    nloc = mine > 0u ? mine : 1u; nx = cnt > 0u ? cnt : 1u;
}

__device__ __forceinline__ void xcd_barrier(const XcdBarrier& b) {
    asm volatile("s_waitcnt vmcnt(0)" ::: "memory");
    __syncthreads();
    if (threadIdx.x == 0) {
        unsigned* bar = b.bar;
        __builtin_amdgcn_s_waitcnt(0);
        unsigned nloc = b.st[0], nx = b.st[1];
        if (nloc == 0u) { xcd_barrier_complete(bar, b.x, nloc, nx); b.st[0] = nloc; b.st[1] = nx; }
        const unsigned old = xb_add(&bar[XB_XSUB(b.x)], 1u);
        const unsigned gen = old / nloc;
        if (old + 1u == (gen + 1u) * nloc) {
            __builtin_amdgcn_fence(__ATOMIC_RELEASE, "agent");
            asm volatile("s_waitcnt vmcnt(0)" ::: "memory");
            const unsigned og = xb_add(&bar[XB_TOP], 1u);
            const unsigned tg = og / nx;
            if (og + 1u == (tg + 1u) * nx) xb_add(&bar[XB_TOPGEN], 1u);
            else XB_SPIN(xb_ld(&bar[XB_TOPGEN]) == tg, bar);
            __builtin_amdgcn_fence(__ATOMIC_ACQUIRE, "agent");
            xb_add(&bar[XB_XGEN(b.x)], 1u);
            asm volatile("s_waitcnt vmcnt(0)" ::: "memory");
        } else {
            XB_SPIN(xb_ld(&bar[XB_XGEN(b.x)]) == gen, bar);
            __builtin_amdgcn_fence(__ATOMIC_ACQUIRE, "agent");
            asm volatile("s_waitcnt vmcnt(0)" ::: "memory");
        }
    }
    __syncthreads();
}

typedef unsigned short h16s;
typedef _Float16 h16x8 __attribute__((ext_vector_type(8)));
typedef float f32x16 __attribute__((ext_vector_type(16)));
typedef short s16x4 __attribute__((ext_vector_type(4)));
struct Frame {
    LAS unsigned char* lds;
    volatile LAS unsigned* MISC;
    gu32* ctl;
    int tid, lane, wave;
    int vcu, G;
    unsigned char* ws;
    float* out;
};
struct Args { const float* in[31]; float* out; unsigned char* ws; };
enum { I_XP = 0, I_XS, I_CK, I_CV, I_SF, I_SB, I_C, I_CCTX, I_WMOD, I_BMOD, I_N1, I_N2, I_NF, I_WIN, I_MU, I_RPB, I_W0, I_W2, I_A0, I_A2, I_G2, I_KK, I_KA, I_RK, I_LNW, I_LNB, I_WOA, I_WOR, I_WOUT, I_WM1, I_WM2 };
constexpr size_t O_Y = 0, O_NK = (size_t)(T_CTX + T_LAT) * DM, O_NV = O_NK + (size_t)T_CTX * D_ATT, O_SF = O_NV + (size_t)T_CTX * D_ATT, O_SB = O_SF + (size_t)B_CTX * NH_R * 64 * 64;

__device__ __forceinline__ float wave_sum(float v) {
#pragma unroll
    for (int o = 1; o < 64; o <<= 1) v += __shfl_xor(v, o);
    return v;
}
__device__ __forceinline__ unsigned pkbf(float lo, float hi) { return pg8::cvt_pk_bf16(lo, hi); }
__device__ __forceinline__ unsigned pkh(float lo, float hi) { return pg8::cvt_pk_f16(lo, hi); }
__device__ __forceinline__ float sigm(float x) { return pg8::sigmoidf_(x); }
__device__ __forceinline__ void unpack_h8(const v4u w, float (&f)[8]) { const h16x8 h = __builtin_bit_cast(h16x8, w);
#pragma unroll
    for (int e = 0; e < 8; ++e) f[e] = (float)h[e]; }

__device__ __forceinline__ void p0_transpose_item(const float* W, int ldw, int col_off, int nblk, bf16* WT, int ldt, int row_off, LAS float* scr, int item, int lane) {
    const int kb = item / nblk, nb = item % nblk, k0 = 64 * kb, n0 = 32 * nb;
    { f32x4 t[8]; const int kr = lane >> 3, nq = (lane & 7) * 4;
#pragma unroll
      for (int i = 0; i < 8; ++i) t[i] = *(const GAS f32x4*)(W + (size_t)(k0 + 8 * i + kr) * ldw + col_off + n0 + nq);
#pragma unroll
      for (int i = 0; i < 8; ++i) { LAS float* d = scr + (8 * i + kr) * 33 + nq; d[0] = t[i].x; d[1] = t[i].y; d[2] = t[i].z; d[3] = t[i].w; } }
    LDS_WAIT(); asm volatile("" ::: "memory");
    const int c = lane & 7;
#pragma unroll
    for (int j = 0; j < 4; ++j) { const int n = (lane >> 3) + 8 * j; const LAS float* s = scr + (8 * c) * 33 + n;
        v4u o; o.x = pkbf(s[0 * 33], s[1 * 33]); o.y = pkbf(s[2 * 33], s[3 * 33]); o.z = pkbf(s[4 * 33], s[5 * 33]); o.w = pkbf(s[6 * 33], s[7 * 33]);
        *(GAS v4u*)(WT + (size_t)(row_off + n0 + n) * ldt + k0 + 8 * c) = o; }
    LDS_WAIT(); asm volatile("" ::: "memory");
}
struct TDesc { const float* W; bf16* WT; int ldw, lgn, ldt, item; };
__device__ __forceinline__ TDesc late_desc(const Args& A, unsigned char* ws, int r) {
    constexpr int E0 = 32 * 128, E1 = E0 + 32 * 128, E2 = E1 + 64 * 128, E3 = E2 + 64 * 512;
    const int sel = (r >= E0) + (r >= E1) + (r >= E2) + (r >= E3);
    const int base = sel == 0 ? 0 : sel == 1 ? E0 : sel == 2 ? E1 : sel == 3 ? E2 : E3;
    const int widx = sel == 0 ? I_WOA : sel == 1 ? I_WOR : sel == 2 ? I_WOUT : sel == 3 ? I_WM1 : I_WM2;
    const size_t woff = sel == 0 ? WS_WOA : sel == 1 ? WS_WOR : sel == 2 ? WS_WOUT : sel == 3 ? WS_WM1 : WS_WM2;
    const int ldw = sel == 3 ? D_FF : DM, lgn = sel == 3 ? 9 : 7, ldt = sel == 0 ? D_ATT : sel == 1 ? D_RW : sel == 4 ? D_FF : DM;
    typedef const float* fptr; const __attribute__((address_space(4))) fptr* kin = (const __attribute__((address_space(4))) fptr*)__builtin_amdgcn_kernarg_segment_ptr();
    return TDesc{kin[widx], (bf16*)(ws + woff), ldw, lgn, ldt, r - base};
}
constexpr int LATE_ITEMS = 32 * 128 + 32 * 128 + 64 * 128 + 64 * 512 + 256 * 128;
__device__ __forceinline__ void late_load(f32x4 (&t)[8], const TDesc& d, int lane) {
    const int kb = d.item >> d.lgn, nb = d.item & ((1 << d.lgn) - 1), k0 = 64 * kb, n0 = 32 * nb, kr = lane >> 3, nq = (lane & 7) * 4;
#pragma unroll
    for (int i = 0; i < 8; ++i) t[i] = *(const GAS f32x4*)(d.W + (size_t)(k0 + 8 * i + kr) * d.ldw + n0 + nq);
}
__device__ __forceinline__ void late_finish(const f32x4 (&t)[8], const TDesc& d, LAS float* scr, int lane) {
    const int kb = d.item >> d.lgn, nb = d.item & ((1 << d.lgn) - 1), k0 = 64 * kb, n0 = 32 * nb, kr = lane >> 3, nq = (lane & 7) * 4;
#pragma unroll
    for (int i = 0; i < 8; ++i) { LAS float* q = scr + (8 * i + kr) * 33 + nq; q[0] = t[i].x; q[1] = t[i].y; q[2] = t[i].z; q[3] = t[i].w; }
    LDS_WAIT(); asm volatile("" ::: "memory");
    const int c = lane & 7;
#pragma unroll
    for (int j = 0; j < 4; ++j) { const int n = (lane >> 3) + 8 * j; const LAS float* sp = scr + (8 * c) * 33 + n;
        v4u o; o.x = pkbf(sp[0 * 33], sp[1 * 33]); o.y = pkbf(sp[2 * 33], sp[3 * 33]); o.z = pkbf(sp[4 * 33], sp[5 * 33]); o.w = pkbf(sp[6 * 33], sp[7 * 33]);
        *(GAS v4u*)(d.WT + (size_t)(n0 + n) * d.ldt + k0 + 8 * c) = o; }
    LDS_WAIT(); asm volatile("" ::: "memory");
}
__device__ __forceinline__ void late_weight_copies(Frame& F, const Args& A, int part, int nparts, const int NIT) {
    LAS float* scr = (LAS float*)(F.lds + RING_OFF + F.wave * 16384);
    int w0 = part * NWAVES + F.wave; const int st = nparts * NWAVES;
    asm volatile("" : "+v"(w0));
    if (w0 >= NIT) return;
    f32x4 ta[8], tb[8], tc[8];
#define LATE_LD(T, IT) late_load(T, late_desc(A, F.ws, min((IT), NIT - 1)), F.lane)
#define LATE_FN(T, IT) late_finish(T, late_desc(A, F.ws, (IT)), scr, F.lane)
    LATE_LD(ta, w0); LATE_LD(tb, w0 + st);
    for (int it = w0;;) {
        LATE_LD(tc, it + 2 * st); LATE_FN(ta, it); if (it + st >= NIT) break;
        LATE_LD(ta, it + 3 * st); LATE_FN(tb, it + st); if (it + 2 * st >= NIT) break;
        LATE_LD(tb, it + 4 * st); LATE_FN(tc, it + 2 * st); if (it + 3 * st >= NIT) break;
        it += 3 * st;
    }
#undef LATE_LD
#undef LATE_FN
}
constexpr int LATE_BG0 = 32 * 128 + 32 * 128 + 64 * 128;
__device__ __forceinline__ void bgc_load(f32x4 (&t)[8], const TDesc& d, int lane) {
    const int kb = d.item >> d.lgn, nb = d.item & ((1 << d.lgn) - 1), a = lane >> 3, q = lane & 7;
    const float* src = d.W + (size_t)(64 * kb + 8 * a) * d.ldw + 32 * nb + 4 * q;
#pragma unroll
    for (int i = 0; i < 8; ++i) t[i] = *(const GAS f32x4*)(src + (size_t)i * d.ldw);
}
__device__ __forceinline__ void bgc_store(const f32x4 (&t)[8], const TDesc& d, int lane) {
    const int kb = d.item >> d.lgn, nb = d.item & ((1 << d.lgn) - 1), a = lane >> 3, q = lane & 7;
    bf16* dst = d.WT + (size_t)(32 * nb + 4 * q) * d.ldt + 64 * kb + 8 * a;
#pragma unroll
    for (int e = 0; e < 4; ++e) { v4u o; o.x = pkbf(t[0][e], t[1][e]); o.y = pkbf(t[2][e], t[3][e]); o.z = pkbf(t[4][e], t[5][e]); o.w = pkbf(t[6][e], t[7][e]); *(GAS v4u*)(dst + (size_t)e * d.ldt) = o; }
}
__device__ __forceinline__ void p0_prologue(Frame& F, const Args& A) {
    const int gw = F.vcu * NWAVES + F.wave, NGW = F.G * NWAVES, gt = gw * 64 + F.lane, NGT = NGW * 64;
    unsigned char* ws = F.ws;
    { LAS float* scr = (LAS float*)(F.lds + RING_OFF + F.wave * 16384);
      constexpr int I_A = 64 * 398, I_B = 64 * 256, NITEMS = I_A + I_B;
      for (int it = gw; it < NITEMS; it += NGW) { int r = it;
          if (r < I_A) { p0_transpose_item(A.in[I_WIN], D_IN, 0, 398, (bf16*)(ws + WS_WIN), DM, 0, scr, r, F.lane); continue; } r -= I_A;
          p0_transpose_item(A.in[I_WIN], D_IN, 12736, 256, (bf16*)(ws + WS_WIN), DM, 12800, scr, r, F.lane);
      } }
    { GAS v4u* p = (GAS v4u*)((bf16*)(ws + WS_WIN) + (size_t)12736 * DM); const int n = 64 * DM / 8; for (int i = gt; i < n; i += NGT) p[i] = (v4u){0u, 0u, 0u, 0u}; }
    { bf16* WL = (bf16*)(ws + WS_WLORA); const float *w2 = A.in[I_W2], *a2 = A.in[I_A2], *g2 = A.in[I_G2];
      for (int i = gt; i < N_LORA * 256 / 2; i += NGT) { const int n = i >> 7, k = (i & 127) * 2; const int sel = n >> 11, col = n & 2047; float v[2];
#pragma unroll
          for (int e = 0; e < 2; ++e) { const int kk = k + e; float x = 0.f;
              if (sel < 2) { if (kk < 96) x = w2[((size_t)sel * 96 + kk) * 2048 + col]; }
              else if (sel < 4) { if (kk >= 96 && kk < 192) x = a2[((size_t)(sel - 2) * 96 + (kk - 96)) * 2048 + col]; }
              else x = g2[(size_t)kk * 2048 + col];
              v[e] = x; }
          ((GAS unsigned*)WL)[i] = pkbf(v[0], v[1]); } }
    { const int n8 = B_LAT * 256 * 2048 / 8;
      for (int i = gt; i < 2 * n8; i += NGT) { const bool isk = i < n8; const int j = isk ? i : i - n8; const float* src = (isk ? A.in[I_CK] : A.in[I_CV]) + (size_t)j * 8;
          const f32x4 a = *(const GAS f32x4*)src, b = *(const GAS f32x4*)(src + 4); v4u o; o.x = pkbf(a.x, a.y); o.y = pkbf(a.z, a.w); o.z = pkbf(b.x, b.y); o.w = pkbf(b.z, b.w);
          *((GAS v4u*)(ws + (isk ? WS_CK : WS_CV)) + j) = o; } }
    { LAS float* sc = (LAS float*)(F.lds + RING_OFF); LAS float* red = sc + 9 * 512; const float* wm = A.in[I_WMOD]; float* MODP = (float*)(ws + WS_MODP);
      for (int it = F.vcu; it < 96 * 8; it += F.G) { const int cb = it % 96, ks = it / 96;
          for (int idx = F.tid; idx < 9 * 512; idx += NWAVES * 64) { const int j = idx >> 9, kk = idx & 511, k = ks * 512 + kk; const float c = j == 0 ? A.in[I_CCTX][k] : A.in[I_C][(size_t)(j - 1) * DM + k]; sc[idx] = c * sigm(c); }
          __syncthreads();
          f32x4 acc[9];
#pragma unroll
          for (int j = 0; j < 9; ++j) acc[j] = (f32x4){0.f, 0.f, 0.f, 0.f};
          const float* wp = wm + (size_t)(ks * 512 + F.wave * 64) * NMOD + cb * 256 + F.lane * 4;
#pragma unroll 8
          for (int r = 0; r < 64; ++r) { const f32x4 w4 = *(const GAS f32x4*)(wp + (size_t)r * NMOD); const int kk = F.wave * 64 + r;
#pragma unroll
              for (int j = 0; j < 9; ++j) acc[j] += w4 * sc[j * 512 + kk]; }
#pragma unroll
          for (int j = 0; j < 9; ++j) *(LAS f32x4*)(red + (F.wave * 9 + j) * 256 + F.lane * 4) = acc[j];
          __syncthreads();
          for (int idx = F.tid; idx < 9 * 256; idx += NWAVES * 64) { const int j = idx >> 8, c = idx & 255; float s = 0.f;
#pragma unroll
              for (int w = 0; w < 8; ++w) s += red[(w * 9 + j) * 256 + c];
              MODP[((size_t)ks * 9 + j) * NMOD + cb * 256 + c] = s; }
          __syncthreads(); } }
}
__device__ __forceinline__ void p0b_mod_finalize(Frame& F, const Args& A) {
    const int gt = (F.vcu * NWAVES + F.wave) * 64 + F.lane, NGT = F.G * NWAVES * 64; const float* MODP = (const float*)(F.ws + WS_MODP); float* MOD = (float*)(F.ws + WS_MOD);
    for (int i = gt; i < 9 * NMOD; i += NGT) { const int n = i % NMOD; float s = A.in[I_BMOD][n];
#pragma unroll
        for (int ks = 0; ks < 8; ++ks) s += MODP[(size_t)ks * 9 * NMOD + i];
        MOD[i] = s; }
}
template <bool XF16> __device__ __forceinline__ void modnorm_rows(Frame& F, const void* Xv, int M, const float* nw, int sh_off, int sc_off, int jbase, int rps, int jmul, bf16* H) {
    static_assert(!XF16, "fp16 rows: modnorm16_rows");
    const int gw = F.vcu * NWAVES + F.wave, NGW = F.G * NWAVES; const float* MOD = (const float*)(F.ws + WS_MOD);
    for (int row0 = 2 * gw; row0 < M; row0 += 2 * NGW) {
        f32x4 v[2][8][2]; float ss[2] = {0.f, 0.f};
#pragma unroll
        for (int q = 0; q < 2; ++q) { const float* xr = (const float*)Xv + (size_t)(row0 + q) * DM + F.lane * 8;
#pragma unroll
            for (int c = 0; c < 8; ++c) { v[q][c][0] = *(const GAS f32x4*)(xr + c * 512); v[q][c][1] = *(const GAS f32x4*)(xr + c * 512 + 4); } }
#pragma unroll
        for (int q = 0; q < 2; ++q)
#pragma unroll
            for (int c = 0; c < 8; ++c)
                ss[q] += (v[q][c][0].x * v[q][c][0].x + v[q][c][0].y * v[q][c][0].y) + (v[q][c][0].z * v[q][c][0].z + v[q][c][0].w * v[q][c][0].w) + (v[q][c][1].x * v[q][c][1].x + v[q][c][1].y * v[q][c][1].y) + (v[q][c][1].z * v[q][c][1].z + v[q][c][1].w * v[q][c][1].w);
        const float rstd[2] = {1.0f / sqrtf(wave_sum(ss[0]) * (1.0f / DM) + RMS_EPS), 1.0f / sqrtf(wave_sum(ss[1]) * (1.0f / DM) + RMS_EPS)};
        const float* mj = MOD + (size_t)(jbase + (row0 / rps) * jmul) * NMOD + F.lane * 8; bf16* hr = H + (size_t)row0 * DM + F.lane * 8;
#pragma unroll
        for (int c = 0; c < 8; ++c) { unsigned ow[2][4];
#pragma unroll
            for (int h = 0; h < 2; ++h) { const f32x4 w4 = *(const GAS f32x4*)(nw + F.lane * 8 + c * 512 + 4 * h), s4 = *(const GAS f32x4*)(mj + sc_off + c * 512 + 4 * h), b4 = *(const GAS f32x4*)(mj + sh_off + c * 512 + 4 * h);
                const f32x4 cf = w4 * (s4 + 1.0f);
#pragma unroll
                for (int q = 0; q < 2; ++q) { const f32x4 y = v[q][c][h] * rstd[q] * cf + b4; ow[q][2 * h] = pkbf(y.x, y.y); ow[q][2 * h + 1] = pkbf(y.z, y.w); } }
#pragma unroll
            for (int q = 0; q < 2; ++q) { v4u o; o.x = ow[q][0]; o.y = ow[q][1]; o.z = ow[q][2]; o.w = ow[q][3]; *(GAS v4u*)(hr + (size_t)q * DM + c * 512) = o; }
            if (c & 1) asm volatile("" ::: "memory"); }
    }
}
__device__ __forceinline__ void final_norm_rows(Frame& F, float* Y, int M, const float* nw) {
    const int gw = F.vcu * NWAVES + F.wave, NGW = F.G * NWAVES;
    for (int row0 = gw; row0 < M; row0 += 2 * NGW) {
        f32x4 v[2][8][2]; float ss[2] = {0.f, 0.f}; const bool two = row0 + NGW < M;
#pragma unroll
        for (int q = 0; q < 2; ++q) { const int row = q ? (two ? row0 + NGW : row0) : row0;
#pragma unroll
            for (int c = 0; c < 8; ++c) { const v4u h = *(const GAS v4u*)((const h16s*)(Y + (size_t)row * DM) + F.lane * 8 + c * 512); v[q][c][0] = pg8::h4lo(h.x, h.y); v[q][c][1] = pg8::h4lo(h.z, h.w); } }
#pragma unroll
        for (int q = 0; q < 2; ++q)
#pragma unroll
            for (int c = 0; c < 8; ++c)
                ss[q] += (v[q][c][0].x * v[q][c][0].x + v[q][c][0].y * v[q][c][0].y) + (v[q][c][0].z * v[q][c][0].z + v[q][c][0].w * v[q][c][0].w) + (v[q][c][1].x * v[q][c][1].x + v[q][c][1].y * v[q][c][1].y) + (v[q][c][1].z * v[q][c][1].z + v[q][c][1].w * v[q][c][1].w);
        const float rstd0 = 1.0f / sqrtf(wave_sum(ss[0]) * (1.0f / DM) + RMS_EPS), rstd1 = 1.0f / sqrtf(wave_sum(ss[1]) * (1.0f / DM) + RMS_EPS);
        asm volatile("s_waitcnt vmcnt(0)" ::: "memory");
#pragma unroll
        for (int q = 0; q < 2; ++q) { if (q == 1 && !two) break; float* xr = Y + (size_t)(row0 + q * NGW) * DM + F.lane * 8; const float rstd = q ? rstd1 : rstd0;
#pragma unroll
            for (int c = 0; c < 8; ++c)
#pragma unroll
                for (int h = 0; h < 2; ++h) { const f32x4 w4 = *(const GAS f32x4*)(nw + F.lane * 8 + c * 512 + 4 * h); *(GAS f32x4*)(xr + c * 512 + 4 * h) = v[q][c][h] * rstd * w4; } }
    }
}
#define SSQ4(V) (((V).x * (V).x + (V).y * (V).y) + ((V).z * (V).z + (V).w * (V).w))
__device__ __forceinline__ void rows2_load(v4u (&B)[2][8], const h16s* X, int r0, int NGW, int M, int lane) {
#pragma unroll
    for (int q = 0; q < 2; ++q) { const int row = min(r0 + q * NGW, M - 1);
#pragma unroll
        for (int c = 0; c < 8; ++c) B[q][c] = *(const GAS v4u*)(X + (size_t)row * 8192 + lane * 8 + c * 512); }
}
__device__ __forceinline__ void rows2_rstd(const v4u (&B)[2][8], float (&rstd)[2]) {
    float ss[2] = {0.f, 0.f};
#pragma unroll
    for (int q = 0; q < 2; ++q)
#pragma unroll
        for (int c = 0; c < 8; ++c) { const f32x4 a = pg8::h4lo(B[q][c].x, B[q][c].y), b = pg8::h4lo(B[q][c].z, B[q][c].w); ss[q] += SSQ4(a) + SSQ4(b); }
#pragma unroll
    for (int q = 0; q < 2; ++q) rstd[q] = 1.0f / sqrtf(wave_sum(ss[q]) * (1.0f / DM) + RMS_EPS);
}
__device__ __forceinline__ void modnorm16_store(Frame& F, const v4u (&B)[2][8], int r0, int M, const float* nw, int sh_off, int sc_off, int jbase, int rps, int jmul, bf16* H) {
    const float* MOD = (const float*)(F.ws + WS_MOD); float rstd[2]; rows2_rstd(B, rstd);
    if (r0 >= M) return;
    const float* mj = MOD + (size_t)(jbase + (r0 / rps) * jmul) * NMOD + F.lane * 8; bf16* hr = H + (size_t)r0 * DM + F.lane * 8;
#pragma unroll
    for (int c = 0; c < 8; ++c) { unsigned ow[2][4];
#pragma unroll
        for (int h = 0; h < 2; ++h) { const f32x4 w4 = *(const GAS f32x4*)(nw + F.lane * 8 + c * 512 + 4 * h), s4 = *(const GAS f32x4*)(mj + sc_off + c * 512 + 4 * h), b4 = *(const GAS f32x4*)(mj + sh_off + c * 512 + 4 * h);
            const f32x4 cf = w4 * (s4 + 1.0f);
#pragma unroll
            for (int q = 0; q < 2; ++q) { unsigned u0 = h ? B[q][c].z : B[q][c].x, u1 = h ? B[q][c].w : B[q][c].y; asm volatile("" : "+v"(u0), "+v"(u1));
                const f32x4 x = pg8::h4lo(u0, u1);
                const f32x4 y = x * rstd[q] * cf + b4; ow[q][2 * h] = pkbf(y.x, y.y); ow[q][2 * h + 1] = pkbf(y.z, y.w); } }
#pragma unroll
        for (int q = 0; q < 2; ++q) { v4u o; o.x = ow[q][0]; o.y = ow[q][1]; o.z = ow[q][2]; o.w = ow[q][3]; *(GAS v4u*)(hr + (size_t)q * DM + c * 512) = o; }
        if (c & 1) asm volatile("" ::: "memory"); }
}
__device__ __forceinline__ void modnorm16_rows(Frame& F, const h16s* X, int M, const float* nw, int sh_off, int sc_off, int jbase, int rps, int jmul, bf16* H) {
    const int gw = F.vcu * NWAVES + F.wave, NGW = F.G * NWAVES;
    if (2 * gw >= M) return;
    v4u A_[2][8], B_[2][8]; rows2_load(A_, X, 2 * gw, 1, M, F.lane);
    for (int r0 = 2 * gw; r0 < M; r0 += 4 * NGW) {
        rows2_load(B_, X, r0 + 2 * NGW, 1, M, F.lane);
        modnorm16_store(F, A_, r0, M, nw, sh_off, sc_off, jbase, rps, jmul, H);
        if (r0 + 2 * NGW >= M) break;
        rows2_load(A_, X, r0 + 4 * NGW, 1, M, F.lane);
        modnorm16_store(F, B_, r0 + 2 * NGW, M, nw, sh_off, sc_off, jbase, rps, jmul, H);
    }
}
__device__ __forceinline__ void final16_store(Frame& F, const v4u (&B)[2][8], int r0, int M, float* Y, const float* nw) {
    float rstd[2]; rows2_rstd(B, rstd);
    if (r0 >= M) return;
    float* xr = Y + (size_t)r0 * DM + F.lane * 8;
#pragma unroll
    for (int c = 0; c < 8; ++c)
#pragma unroll
        for (int h = 0; h < 2; ++h) { const f32x4 w4 = *(const GAS f32x4*)(nw + F.lane * 8 + c * 512 + 4 * h);
#pragma unroll
            for (int q = 0; q < 2; ++q) { unsigned u0 = h ? B[q][c].z : B[q][c].x, u1 = h ? B[q][c].w : B[q][c].y; asm volatile("" : "+v"(u0), "+v"(u1));
                *(GAS f32x4*)(xr + (size_t)q * DM + c * 512 + 4 * h) = pg8::h4lo(u0, u1) * rstd[q] * w4; } }
}
__device__ __forceinline__ void final16_rows(Frame& F, float* Y, int M, const float* nw) {
    const int gw = F.vcu * NWAVES + F.wave, NGW = F.G * NWAVES; const h16s* X = (const h16s*)Y;
    if (2 * gw >= M) return;
    v4u A_[2][8], B_[2][8]; rows2_load(A_, X, 2 * gw, 1, M, F.lane);
    for (int r0 = 2 * gw; r0 < M; r0 += 4 * NGW) {
        rows2_load(B_, X, r0 + 2 * NGW, 1, M, F.lane);
        final16_store(F, A_, r0, M, Y, nw);
        if (r0 + 2 * NGW >= M) break;
        rows2_load(A_, X, r0 + 4 * NGW, 1, M, F.lane);
        final16_store(F, B_, r0 + 2 * NGW, M, Y, nw);
    }
}
namespace att {
constexpr float SCALE = 0.088388347648318440f, C = SCALE * 1.4426950408889634f;
constexpr int SHM_T = 16384;
constexpr int OFF_V = 0, OFF_K = 2 * SHM_T, OFF_WS = 4 * SHM_T, OFF_TAB = OFF_WS + 4096, OFF_ROW = OFF_TAB + 4096;
#define KSWZ(row, colB) ((row) * 256 + ((colB) ^ (((row) & 7) << 4)))
#define SBAR() __builtin_amdgcn_sched_barrier(0)
__device__ __forceinline__ int crow(int r, int hi) { return (r & 3) + 8 * (r >> 2) + 4 * hi; }
constexpr bool L0(int LV, int r) { return LV != 2 || r >= 12; }
constexpr bool L1(int LV, int r) { return LV != 1 || r < 4; }
template <int LV> __device__ __forceinline__ void partialSM(f32x16& p0, f32x16& p1, float& m_reg, float& mn, float& alpha) {
  float pmax = -3.0e38f;
#pragma unroll
  for (int r = 0; r < 16; ++r) if (L0(LV, r)) pmax = fmaxf(pmax, p0[r]);
#pragma unroll
  for (int r = 0; r < 16; ++r) if (L1(LV, r)) pmax = fmaxf(pmax, p1[r]);
  { auto rr = __builtin_amdgcn_permlane32_swap(__float_as_uint(pmax), __float_as_uint(pmax), false, false);
    pmax = fmaxf(__uint_as_float(rr[0]), __uint_as_float(rr[1])); }
  if (__all(pmax <= m_reg)) { mn = m_reg; alpha = 1.f; }
  else { mn = fmaxf(m_reg, pmax); alpha = __builtin_amdgcn_exp2f((m_reg - mn) * C); m_reg = mn; }
  const float mnC = -mn * C; typedef float f2_ __attribute__((ext_vector_type(2))); const f2_ C2 = {C, C}, M2 = {mnC, mnC};
#pragma unroll
  for (int r = 0; r < 16; r += 2) { if (L0(LV, r)) { const f2_ t = __builtin_elementwise_fma((f2_){p0[r], p0[r + 1]}, C2, M2); p0[r] = __builtin_amdgcn_exp2f(t.x); p0[r + 1] = __builtin_amdgcn_exp2f(t.y); } else { p0[r] = 0.f; p0[r + 1] = 0.f; } }
#pragma unroll
  for (int r = 0; r < 16; r += 2) { if (L1(LV, r)) { const f2_ t = __builtin_elementwise_fma((f2_){p1[r], p1[r + 1]}, C2, M2); p1[r] = __builtin_amdgcn_exp2f(t.x); p1[r + 1] = __builtin_amdgcn_exp2f(t.y); } else { p1[r] = 0.f; p1[r + 1] = 0.f; } }
}
template <int LV> __device__ __forceinline__ void finishSM(f32x16& p0, f32x16& p1, float alpha, float& l_reg, bf16x8& pa0, bf16x8& pa1, bf16x8& pa2, bf16x8& pa3) {
  typedef float f2_ __attribute__((ext_vector_type(2))); f2_ s2 = {0.f, 0.f};
#pragma unroll
  for (int r = 0; r < 16; r += 2) if (L0(LV, r)) s2 += (f2_){p0[r], p0[r + 1]};
#pragma unroll
  for (int r = 0; r < 16; r += 2) if (L1(LV, r)) s2 += (f2_){p1[r], p1[r + 1]};
  float ps = s2.x + s2.y;
  { auto rr = __builtin_amdgcn_permlane32_swap(__float_as_uint(ps), __float_as_uint(ps), false, false);
    ps = __uint_as_float(rr[0]) + __uint_as_float(rr[1]); }
  l_reg = l_reg * alpha + ps;
#define PK4(P, BASE, OUT) do { unsigned a0 = pkbf(P[BASE + 0], P[BASE + 1]), a1 = pkbf(P[BASE + 2], P[BASE + 3]);   \
    unsigned b0 = pkbf(P[BASE + 4], P[BASE + 5]), b1 = pkbf(P[BASE + 6], P[BASE + 7]);                              \
    auto r0 = __builtin_amdgcn_permlane32_swap(a0, b0, false, false); auto r1 = __builtin_amdgcn_permlane32_swap(a1, b1, false, false); \
    v4u w = {r0[0], r1[0], r0[1], r1[1]}; OUT = __builtin_bit_cast(bf16x8, w); } while (0)
  if (LV != 2) PK4(p0, 0, pa0); else pa0 = bf16x8{};
  PK4(p0, 8, pa1); PK4(p1, 0, pa2);
  if (LV != 1) PK4(p1, 8, pa3); else pa3 = bf16x8{};
#undef PK4
}
__device__ __forceinline__ void qkt(f32x16& p0, f32x16& p1, const LAS unsigned char* Ks, const bf16x8* qr, int r32, int hi) {
  p0 = f32x16{}; p1 = f32x16{};
#pragma unroll
  for (int d0 = 0; d0 < 8; ++d0) { const int cb = (d0 * 16 + hi * 8) * 2;
    const bf16x8 b0 = *(const LAS bf16x8*)(Ks + KSWZ(r32, cb));
    const bf16x8 b1 = *(const LAS bf16x8*)(Ks + KSWZ(32 + r32, cb));
    p0 = __builtin_amdgcn_mfma_f32_32x32x16_bf16(b0, qr[d0], p0, 0, 0, 0);
    p1 = __builtin_amdgcn_mfma_f32_32x32x16_bf16(b1, qr[d0], p1, 0, 0, 0); }
}
__device__ __forceinline__ int v_st(int k, int c) { const int kk = (k & ~0xC) | ((k & 4) << 1) | ((k & 8) >> 1); return ((kk >> 3) * 4 + (c >> 5)) * 512 + ((kk & 7) * 32 + (c & 31)) * 2; }
__device__ __forceinline__ int v_rd_base(int lane) { return ((lane & 3) << 3) | (((lane >> 2) & 3) << 6) | (((lane >> 4) & 1) << 5) | (((lane >> 5) & 1) << 8); }
constexpr int v_rd_off(int d0, int ks, int half) { return d0 * 512 + ks * 4096 + half * 2048; }
template <int OFF> __device__ __forceinline__ s16x4 tr_read(int vb) {
  s16x4 r; asm volatile("ds_read_b64_tr_b16 %0, %1 offset:%2" : "=&v"(r) : "v"(vb), "i"(OFF) : "memory"); return r;
}
template <int D0, int LV> __device__ __forceinline__ void pv_one(f32x16& od, int vb, bf16x8 pa0, bf16x8 pa1, bf16x8 pa2, bf16x8 pa3) {
  s16x4 l0 = {}, h0 = {}, l3 = {}, h3 = {};
  if (LV != 2) { l0 = tr_read<v_rd_off(D0, 0, 0)>(vb); h0 = tr_read<v_rd_off(D0, 0, 1)>(vb); }
  const s16x4 l1 = tr_read<v_rd_off(D0, 1, 0)>(vb), h1 = tr_read<v_rd_off(D0, 1, 1)>(vb), l2 = tr_read<v_rd_off(D0, 2, 0)>(vb), h2 = tr_read<v_rd_off(D0, 2, 1)>(vb);
  if (LV != 1) { l3 = tr_read<v_rd_off(D0, 3, 0)>(vb); h3 = tr_read<v_rd_off(D0, 3, 1)>(vb); }
  asm volatile("s_waitcnt lgkmcnt(0)" ::: "memory"); SBAR();
#define PK(L, H) (bf16x8){L[0], L[1], L[2], L[3], H[0], H[1], H[2], H[3]}
  if (LV != 2) od = __builtin_amdgcn_mfma_f32_32x32x16_bf16(pa0, PK(l0, h0), od, 0, 0, 0);
  od = __builtin_amdgcn_mfma_f32_32x32x16_bf16(pa1, PK(l1, h1), od, 0, 0, 0);
  od = __builtin_amdgcn_mfma_f32_32x32x16_bf16(pa2, PK(l2, h2), od, 0, 0, 0);
  if (LV != 1) od = __builtin_amdgcn_mfma_f32_32x32x16_bf16(pa3, PK(l3, h3), od, 0, 0, 0);
#undef PK
}
template <int LV> __device__ __forceinline__ void pv_d0(f32x16* o, int vb, bf16x8 pa0, bf16x8 pa1, bf16x8 pa2, bf16x8 pa3) {
  pv_one<0, LV>(o[0], vb, pa0, pa1, pa2, pa3); pv_one<1, LV>(o[1], vb, pa0, pa1, pa2, pa3); pv_one<2, LV>(o[2], vb, pa0, pa1, pa2, pa3); pv_one<3, LV>(o[3], vb, pa0, pa1, pa2, pa3);
}
template <int LV> __device__ __forceinline__ void attn_tile(const LAS unsigned char* Kt, int vb, const bf16x8* qr, f32x16* o, float& m_reg, float& l_reg, LAS float* al_l, int r32, int hi, const LAS unsigned char* rowb, const int (&off0)[16], const int (&off1)[16]) {
  f32x16 p0, p1; float mn, alpha; bf16x8 pa0, pa1, pa2, pa3;
  qkt(p0, p1, Kt, qr, r32, hi);
  if (LV != 0) {
#pragma unroll
    for (int r = 0; r < 16; ++r) { if (L0(LV, r)) p0[r] += *(const LAS float*)(rowb + off0[r]); if (L1(LV, r)) p1[r] += *(const LAS float*)(rowb + off1[r]); } }
  partialSM<LV>(p0, p1, m_reg, mn, alpha);
  if (__any(alpha < 1.f)) { if (hi == 0) al_l[r32] = alpha; asm volatile("s_waitcnt lgkmcnt(0)" ::: "memory");
#pragma unroll
    for (int d = 0; d < 4; ++d)
#pragma unroll
      for (int r = 0; r < 16; ++r) o[d][r] *= al_l[crow(r, hi)]; }
  finishSM<LV>(p0, p1, alpha, l_reg, pa0, pa1, pa2, pa3); SBAR();
  pv_d0<LV>(o, vb, pa0, pa1, pa2, pa3);
}
__device__ __forceinline__ void attn_unit(LAS unsigned char* lds, const bf16* Qb, bf16* Ob, const bf16* Kl, const bf16* Vl, int ntl, int rho0, int r0, const bf16* Kc, const bf16* Vc, const float* rpb) {
  int tid_ = threadIdx.x; asm volatile("" : "+v"(tid_));
  const int tid = tid_, wid = __builtin_amdgcn_readfirstlane(tid >> 6), lane = tid & 63, r32 = lane & 31, hi = lane >> 5;
  LAS unsigned char* V_lds = lds + OFF_V; LAS unsigned char* K_lds = lds + OFF_K;
  LAS float* wsf = (LAS float*)(lds + OFF_WS) + wid * 64; LAS float* li_l = wsf; LAS float* al_l = wsf + 32;
  LAS float* tab = (LAS float*)(lds + OFF_TAB);
  if (ntl > 0) { for (int i = tid; i < 15 * 31; i += NWAVES * 64) tab[i] = rpb[i] * (1.0f / SCALE); }
  float m_reg = -1e30f, l_reg = 0.f; f32x16 o[4] = {}; bf16x8 qr[8];
  { const bf16* Qw = Qb + (size_t)(wid * 32 + r32) * 2048 + hi * 8;
#pragma unroll
    for (int d0 = 0; d0 < 8; ++d0) qr[d0] = *(const GAS bf16x8*)(Qw + d0 * 16); }
  const int rq = r0 + (wid >> 1), cq = 32 * (wid & 1) + r32;
  const int rs = min(max(rq - 4, 0), 56), cs = min(max(cq - 8, 0), 48);
  LAS unsigned char* rowb = lds + OFF_ROW + wid * 128;
  int off0[16], off1[16];
#pragma unroll
  for (int r = 0; r < 16; ++r) { const int kap = (r & 3) + 8 * (r >> 2) + 4 * hi; off0[r] = ((unsigned)(kap - cs) < 16u) ? (kap - cq + 15) * 4 : 124; off1[r] = ((unsigned)(kap + 32 - cs) < 16u) ? (kap + 32 - cq + 15) * 4 : 124; }
  const int sr = tid >> 4, sc = (tid & 15) * 8, vst0 = v_st(sr, sc), vst1 = v_st(32 + sr, sc), kst0 = KSWZ(sr, sc * 2), kst1 = KSWZ(32 + sr, sc * 2);
  const int vb0 = (int)(unsigned)(uintptr_t)V_lds + v_rd_base(lane);
  const int NT = ntl + 4;
  bf16x8 sv0, sv1, sk0, sk1;
#define SLOAD(t) do { const bf16* kp = ((t) < ntl) ? Kl + (size_t)(t) * 64 * 2048 : Kc + (size_t)((t) - ntl) * 64 * 2048; const bf16* vp = ((t) < ntl) ? Vl + (size_t)(t) * 64 * 2048 : Vc + (size_t)((t) - ntl) * 64 * 2048; \
    sv0 = *(const GAS bf16x8*)(vp + (size_t)sr * 2048 + sc); sv1 = *(const GAS bf16x8*)(vp + (size_t)(32 + sr) * 2048 + sc); sk0 = *(const GAS bf16x8*)(kp + (size_t)sr * 2048 + sc); sk1 = *(const GAS bf16x8*)(kp + (size_t)(32 + sr) * 2048 + sc); } while (0)
#define SWRITE(b) do { *(LAS bf16x8*)(V_lds + (b) * SHM_T + vst0) = sv0; *(LAS bf16x8*)(V_lds + (b) * SHM_T + vst1) = sv1; *(LAS bf16x8*)(K_lds + (b) * SHM_T + kst0) = sk0; *(LAS bf16x8*)(K_lds + (b) * SHM_T + kst1) = sk1; } while (0)
  SLOAD(0); SWRITE(0); __syncthreads();
#define TILE_STEP(LV_, t) do { const int b = (t) & 1; if ((t) + 1 < NT) SLOAD((t) + 1); \
    const int rho = rho0 + (t); const bool need = (LV_ == 0) || (rho >= rs && rho < rs + 8); \
    if (need) { if (LV_ != 0) { if (lane < 32) ((LAS float*)rowb)[lane] = lane < 31 ? tab[(rho - rq + 7) * 31 + lane] : -1e30f; } attn_tile<LV_>(K_lds + b * SHM_T, vb0 + b * SHM_T, qr, o, m_reg, l_reg, al_l, r32, hi, rowb, off0, off1); } \
    if ((t) + 1 < NT) SWRITE(b ^ 1); __syncthreads(); } while (0)
  if (wid & 1) { for (int t = 0; t < ntl; ++t) TILE_STEP(2, t); }
  else { for (int t = 0; t < ntl; ++t) TILE_STEP(1, t); }
  for (int t = ntl; t < NT; ++t) TILE_STEP(0, t);
#undef TILE_STEP
#undef SLOAD
#undef SWRITE
  if (hi == 0) li_l[r32] = l_reg; asm volatile("s_waitcnt lgkmcnt(0)" ::: "memory");
  float rli[16];
#pragma unroll
  for (int r = 0; r < 16; ++r) rli[r] = __builtin_amdgcn_rcpf(li_l[crow(r, hi)]);
  bf16* Ow = Ob + (size_t)(wid * 32) * 2048;
#pragma unroll
  for (int r = 0; r < 16; ++r) { const int orow = crow(r, hi);
#pragma unroll
    for (int d0 = 0; d0 < 4; ++d0) { const unsigned w = pkbf(o[d0][r] * rli[r], 0.f); Ow[(size_t)orow * 2048 + d0 * 32 + r32] = (bf16)(w & 0xffffu); } }
}
#undef KSWZ
#undef SBAR
}
__device__ __forceinline__ float sum8(float v) { v += __shfl_xor(v, 1); v += __shfl_xor(v, 2); v += __shfl_xor(v, 4); return v; }
__device__ __forceinline__ void rwkv_prep(Frame& F, const Args& A, const h16s* PR, int prow0, int Ms, int L, h16s* RS, h16s* KS, h16s* VS, h16s* KK, bf16* LA) {
    const int gw = F.vcu * NWAVES + F.wave, NGW = F.G * NWAVES; const float* mu = A.in[I_MU]; const float* k_k = A.in[I_KK];
    for (int s0 = 2 * gw; s0 < Ms; s0 += 2 * NGW) {
        const int t = s0 % L; const bool hp = t > 0, hn = t + 2 < L;
        const h16s* pc = PR + (size_t)(prow0 + s0) * C_RWKV_P + F.lane * 8;
#pragma unroll 4
        for (int c = 0; c < 13; ++c) {
            const int col = c * 512 + F.lane * 8; const v4u z4 = {0u, 0u, 0u, 0u};
            const v4u w0 = hp ? *(const GAS v4u*)(pc + c * 512 - C_RWKV_P) : z4, w1 = *(const GAS v4u*)(pc + c * 512), w2 = *(const GAS v4u*)(pc + c * 512 + C_RWKV_P), w3 = hn ? *(const GAS v4u*)(pc + c * 512 + 2 * C_RWKV_P) : z4;
            float x0[8], x1[8], x2[8], x3[8], m[8]; unpack_h8(w0, x0); unpack_h8(w1, x1); unpack_h8(w2, x2); unpack_h8(w3, x3);
            if (col < C_RWKV) { const f32x4 m0 = *(const GAS f32x4*)(mu + col), m1 = *(const GAS f32x4*)(mu + col + 4); m[0] = m0.x; m[1] = m0.y; m[2] = m0.z; m[3] = m0.w; m[4] = m1.x; m[5] = m1.y; m[6] = m1.z; m[7] = m1.w; }
            else {
#pragma unroll
                for (int e = 0; e < 8; ++e) m[e] = 0.f; }
#pragma unroll
            for (int q = 0; q < 2; ++q) { const int s = s0 + q;
                float x[8];
#pragma unroll
                for (int e = 0; e < 8; ++e) { const float xc = q ? x2[e] : x1[e], xp = q ? x1[e] : x0[e], xn = q ? x3[e] : x2[e]; x[e] = xc + m[e] * (0.5f * (xp + xn) - xc); }
                if (c < 12) {
                    v4u o; o.x = pkh(x[0], x[1]); o.y = pkh(x[2], x[3]); o.z = pkh(x[4], x[5]); o.w = pkh(x[6], x[7]);
                    h16s* dst = (c < 4 ? RS : c < 8 ? KS : VS) + (size_t)s * D_RW + (c & 3) * 512 + F.lane * 8;
                    *(GAS v4u*)dst = o;
                    if (c >= 4 && c < 8) { const int kc = (c - 4) * 512 + F.lane * 8; const f32x4 q0 = *(const GAS f32x4*)(k_k + kc), q1 = *(const GAS f32x4*)(k_k + kc + 4);
                        float y[8] = {x[0] * q0.x, x[1] * q0.y, x[2] * q0.z, x[3] * q0.w, x[4] * q1.x, x[5] * q1.y, x[6] * q1.z, x[7] * q1.w}; float ss = 0.f;
    #pragma unroll
                        for (int e = 0; e < 8; ++e) ss += y[e] * y[e];
                        ss = sum8(ss); const float inv = 1.0f / fmaxf(sqrtf(ss), 1e-12f);
                        v4u ko; ko.x = pkh(y[0] * inv, y[1] * inv); ko.y = pkh(y[2] * inv, y[3] * inv); ko.z = pkh(y[4] * inv, y[5] * inv); ko.w = pkh(y[6] * inv, y[7] * inv);
                        *(GAS v4u*)(KK + (size_t)s * D_RW + kc) = ko; }
                } else {
                    float y[8];
    #pragma unroll
                    for (int e = 0; e < 8; ++e) { const int j = F.lane * 8 + e; const float v = x[e];
                        const float th = 1.0f - 2.0f * __builtin_amdgcn_rcpf(1.0f + __builtin_amdgcn_exp2f(2.8853900817779268f * v));
                        y[e] = j < 96 ? th : j < 192 ? v : j < 448 ? sigm(v) : 0.f; }
                    v4u o; o.x = pkbf(y[0], y[1]); o.y = pkbf(y[2], y[3]); o.z = pkbf(y[4], y[5]); o.w = pkbf(y[6], y[7]);
                    if (F.lane < 24) *(GAS v4u*)(LA + (size_t)s * 256 + F.lane * 8) = o;
                    else if (F.lane < 56) *(GAS v4u*)(LA + (size_t)Ms * 256 + (size_t)s * 256 + (F.lane - 24) * 8) = o;
                    else *(GAS v4u*)(LA + (size_t)s * 256 + 192 + (F.lane - 56) * 8) = (v4u){0u, 0u, 0u, 0u};
                }
            }
        }
    }
}
typedef float f32x2 __attribute__((ext_vector_type(2)));
__device__ __forceinline__ float dpp_xor1(float x) { return __builtin_bit_cast(float, __builtin_amdgcn_update_dpp(0, __builtin_bit_cast(int, x), 0xB1, 0xf, 0xf, true)); }
__device__ __forceinline__ float dpp_xor2(float x) { return __builtin_bit_cast(float, __builtin_amdgcn_update_dpp(0, __builtin_bit_cast(int, x), 0x4E, 0xf, 0xf, true)); }
__device__ __forceinline__ float dpp_hmir(float x) { return __builtin_bit_cast(float, __builtin_amdgcn_update_dpp(0, __builtin_bit_cast(int, x), 0x141, 0xf, 0xf, true)); }
__device__ __forceinline__ float red8(float x) { x += dpp_xor1(x); x += dpp_xor2(x); x += dpp_hmir(x); return x; }
__device__ __forceinline__ float dpp_shr1(float x) { return __builtin_bit_cast(float, __builtin_amdgcn_update_dpp(0, __builtin_bit_cast(int, x), 0x111, 0xf, 0xf, true)); }
__device__ __forceinline__ float dpp_shr2(float x) { return __builtin_bit_cast(float, __builtin_amdgcn_update_dpp(0, __builtin_bit_cast(int, x), 0x112, 0xf, 0xf, true)); }
__device__ __forceinline__ float dpp_shr4(float x) { return __builtin_bit_cast(float, __builtin_amdgcn_update_dpp(0, __builtin_bit_cast(int, x), 0x114, 0xf, 0xf, true)); }
constexpr int SC_U = 8, SC_STEP = 5 * 64, SC_OPS_F = SC_U * SC_STEP, SC_GAM_F = 64, SC_Y_F = SC_U * 512, SC_SLOT_F = 2 * SC_OPS_F + 2 * SC_GAM_F + 2 * SC_Y_F;
static_assert(2 * SC_SLOT_F * 4 <= RING_BYTES, "scan LDS");
struct ScanOps { f32x4 kk[2], bb[2], kd[2], r[2]; f32x2 v; };
__device__ __forceinline__ void scan_ld(ScanOps& o, const LAS float* ob, int kq, int v0) {
#pragma unroll
    for (int j = 0; j < 2; ++j) { o.kk[j] = *(const LAS f32x4*)(ob + 0 * 64 + kq * 8 + 4 * j); o.bb[j] = *(const LAS f32x4*)(ob + 1 * 64 + kq * 8 + 4 * j);
        o.kd[j] = *(const LAS f32x4*)(ob + 2 * 64 + kq * 8 + 4 * j); o.r[j] = *(const LAS f32x4*)(ob + 3 * 64 + kq * 8 + 4 * j); }
    o.v = *(const LAS f32x2*)(ob + 4 * 64 + v0);
}
__device__ __forceinline__ f32x2 lo2(f32x4 a) { return (f32x2){a.x, a.y}; }
__device__ __forceinline__ f32x2 hi2(f32x4 a) { return (f32x2){a.z, a.w}; }
__device__ __forceinline__ f32x2 h2x2(unsigned u) { typedef _Float16 hh2 __attribute__((ext_vector_type(2))); const hh2 h = __builtin_bit_cast(hh2, u); return (f32x2){(float)h.x, (float)h.y}; }
__device__ __forceinline__ f32x2 fma2(f32x2 a, f32x2 b, f32x2 c) { return __builtin_elementwise_fma(a, b, c); }
__device__ __forceinline__ f32x2 dot8(const f32x2 (&S)[4], const f32x4 (&x)[2]) { f32x2 p = S[0] * lo2(x[0]); p = fma2(S[1], hi2(x[0]), p); p = fma2(S[2], lo2(x[1]), p); p = fma2(S[3], hi2(x[1]), p); return p; }
__device__ __forceinline__ void rwkv_scan(Frame& F, const Args& A, int nseq, int L, int seq0_global, bool has_state, const h16s* RS, const h16s* KS, const h16s* VS, const h16s* KK,
                                          const h16s* DF, const h16s* DB, const h16s* AF, const h16s* AB, h16s* YF, h16s* YB, float* out_sf, float* out_sb) {
    int wv_ = F.wave; asm volatile("" : "+s"(wv_));
    const int nchains = nseq * NH_R * 2, nslots = nchains >= 2 * F.G ? 2 : 1; const int lane = F.lane, cs = wv_ >> 2, wq = wv_ & 3, kq = lane & 7, v0 = 16 * wq + 2 * (lane >> 3);
    const int ft = F.tid & 255, su = ft & 7, kp = ft >> 3;
    LAS float* const sl = (LAS float*)(F.lds + RING_OFF) + cs * SC_SLOT_F;
    const float* k_a = A.in[I_KA]; const int NC = L / SC_U;
    const bool bg_on = out_sf != nullptr; const int bg_stride = F.G * NWAVES; int bg_i = LATE_BG0 + F.vcu * NWAVES + wv_;
    f32x4 bgT[8]; bool bg_have = false; asm volatile("" : "+v"(bg_i));
    for (int it = 0; (it * F.G + F.vcu) * nslots < nchains; ++it) {
        const int chain = (it * F.G + F.vcu) * nslots + cs; const bool active = cs < nslots && chain < nchains;
        const int dir = chain & 1, head = (chain >> 1) & 31, seq = chain >> 6;
        const h16s* Dd = dir ? DB : DF; const h16s* Ad = dir ? AB : AF; h16s* Yd = dir ? YB : YF;
        const int colp = head * 64 + 2 * kp;
        f32x2 ka2 = (f32x2){0.f, 0.f}; if (active) ka2 = *(const GAS f32x2*)(k_a + colp); const f32x2 oka2 = (f32x2){1.0f - ka2.x, 1.0f - ka2.y};
        f32x2 Sa[4], Sb[4];
#pragma unroll
        for (int j = 0; j < 4; ++j) { Sa[j] = (f32x2){0.f, 0.f}; Sb[j] = (f32x2){0.f, 0.f}; }
        const size_t soff = (((size_t)(seq0_global + seq) * NH_R + head) * 64 + v0) * 64 + 8 * kq;
        if (active && has_state) { const float* sp = (dir ? A.in[I_SB] : A.in[I_SF]) + soff; const f32x4 a = *(const GAS f32x4*)sp, b = *(const GAS f32x4*)(sp + 4), c = *(const GAS f32x4*)(sp + 64), d = *(const GAS f32x4*)(sp + 68);
            Sa[0] = lo2(a); Sa[1] = hi2(a); Sa[2] = lo2(b); Sa[3] = hi2(b); Sb[0] = lo2(c); Sb[1] = hi2(c); Sb[2] = lo2(d); Sb[3] = hi2(d); }
        const int row0 = seq * L; const int tstart = dir ? L - 1 : 0, tstep = dir ? -1 : 1;
        struct Raw { unsigned r, k, kk, w, a, v; };
        Raw gA = {0, 0, 0, 0, 0, 0}, gB = {0, 0, 0, 0, 0, 0};
#define SC_AT(P, bo) (*(const GAS unsigned*)((const GAS char*)(P) + (bo)))
#define SC_GLOAD(g, c) do { const unsigned ro = (unsigned)((row0 + tstart + ((c) * SC_U + su) * tstep) * D_RW + colp) * 2u; g.r = SC_AT(RS, ro); g.k = SC_AT(KS, ro); g.kk = SC_AT(KK, ro); \
            g.w = SC_AT(Dd, ro); g.a = SC_AT(Ad, ro); g.v = SC_AT(VS, ro); } while (0)
        f32x2 f_r, f_kk, f_v, f_kd, f_bb, f_gi, f_t, f_inv;
#define SC_F0(g) do { const f32x2 k2 = h2x2(g.k), a2 = h2x2(g.a); f_r = h2x2(g.r); f_kk = h2x2(g.kk); f_v = h2x2(g.v); f_gi = h2x2(g.w); f_kd = k2 * (a2 * ka2 + oka2); f_bb = f_kk * a2; \
            f_t.x = dpp_shr1(f_gi.x); f_t.y = dpp_shr1(f_gi.y); } while (0)
#define SC_F1() do { if (su >= 1) f_gi *= f_t; f_t.x = dpp_shr2(f_gi.x); f_t.y = dpp_shr2(f_gi.y); } while (0)
#define SC_F2() do { if (su >= 2) f_gi *= f_t; f_t.x = dpp_shr4(f_gi.x); f_t.y = dpp_shr4(f_gi.y); } while (0)
#define SC_F3() do { if (su >= 4) f_gi *= f_t; f_t.x = dpp_shr1(f_gi.x); f_t.y = dpp_shr1(f_gi.y); f_inv = (f32x2){__builtin_amdgcn_rcpf(f_gi.x), __builtin_amdgcn_rcpf(f_gi.y)}; } while (0)
#define SC_F4(b) do { const f32x2 ge = su >= 1 ? f_t : (f32x2){1.0f, 1.0f}; \
            LAS float* ob = sl + (b) * SC_OPS_F + su * SC_STEP + 2 * kp; *(LAS f32x2*)(ob) = ge * f_kk; *(LAS f32x2*)(ob + 64) = f_bb * f_inv; *(LAS f32x2*)(ob + 128) = f_kd * f_inv; *(LAS f32x2*)(ob + 192) = f_gi * f_r; *(LAS f32x2*)(ob + 256) = f_v; \
            if (su == SC_U - 1) *(LAS f32x2*)(sl + 2 * SC_OPS_F + (b) * SC_GAM_F + 2 * kp) = f_gi; } while (0)
#define SC_YSTORE(bb_, c_) do { const LAS f32x4* yp = (const LAS f32x4*)(sl + 2 * SC_OPS_F + 2 * SC_GAM_F + (bb_) * SC_Y_F + (su * 64 + 2 * kp) * 8); const f32x4 a0 = yp[0], a1 = yp[1], b0 = yp[2], b1 = yp[3]; \
            const float y0 = ((a0.x + a0.z) + (a1.x + a1.z)) + ((b0.x + b0.z) + (b1.x + b1.z)), y1 = ((a0.y + a0.w) + (a1.y + a1.w)) + ((b0.y + b0.w) + (b1.y + b1.w)); \
            *(GAS unsigned*)((GAS char*)Yd + (unsigned)((row0 + tstart + ((c_) * SC_U + su) * tstep) * D_RW + colp) * 2u) = pkh(y0, y1); } while (0)
        __syncthreads();
        if (active) { SC_GLOAD(gA, 0); SC_F0(gA); SC_F1(); SC_F2(); SC_F3(); SC_F4(0); if (NC > 1) SC_GLOAD(gA, 1); }
        __syncthreads();
        for (int c = 0; c < NC; ++c) {
            const int b = c & 1;
            LAS float* yst = sl + 2 * SC_OPS_F + 2 * SC_GAM_F + b * SC_Y_F;
            if (active) {
                const bool fill = c + 1 < NC;
                if (c + 2 < NC) SC_GLOAD(gB, c + 2);
                const LAS float* ops = sl + b * SC_OPS_F;
                ScanOps cur, nxt; scan_ld(cur, ops, kq, v0);
                f32x2 pa = dot8(Sa, cur.kk), pb = dot8(Sb, cur.kk);
#define SC_STEP_(s) do { \
                    if ((s) + 1 < SC_U) scan_ld(nxt, ops + ((s) + 1) * SC_STEP, kq, v0); \
                    const f32x2 vA = (f32x2){cur.v.x, cur.v.x}, vB = (f32x2){cur.v.y, cur.v.y}; \
                    float ra = pa.x + pa.y, rb = pb.x + pb.y; \
                    ra += dpp_xor1(ra); rb += dpp_xor1(rb); \
                    Sa[0] = fma2(vA, lo2(cur.kd[0]), Sa[0]); Sb[0] = fma2(vB, lo2(cur.kd[0]), Sb[0]); Sa[1] = fma2(vA, hi2(cur.kd[0]), Sa[1]); Sb[1] = fma2(vB, hi2(cur.kd[0]), Sb[1]); \
                    ra += dpp_xor2(ra); rb += dpp_xor2(rb); \
                    Sa[2] = fma2(vA, lo2(cur.kd[1]), Sa[2]); Sb[2] = fma2(vB, lo2(cur.kd[1]), Sb[2]); Sa[3] = fma2(vA, hi2(cur.kd[1]), Sa[3]); Sb[3] = fma2(vB, hi2(cur.kd[1]), Sb[3]); \
                    ra += dpp_hmir(ra); rb += dpp_hmir(rb); \
                    const f32x2 sA = (f32x2){-ra, -ra}, sB = (f32x2){-rb, -rb}; \
                    Sa[0] = fma2(sA, lo2(cur.bb[0]), Sa[0]); Sb[0] = fma2(sB, lo2(cur.bb[0]), Sb[0]); Sa[1] = fma2(sA, hi2(cur.bb[0]), Sa[1]); Sb[1] = fma2(sB, hi2(cur.bb[0]), Sb[1]); \
                    Sa[2] = fma2(sA, lo2(cur.bb[1]), Sa[2]); Sb[2] = fma2(sB, lo2(cur.bb[1]), Sb[2]); Sa[3] = fma2(sA, hi2(cur.bb[1]), Sa[3]); Sb[3] = fma2(sB, hi2(cur.bb[1]), Sb[3]); \
                    f32x2 ya = Sa[0] * lo2(cur.r[0]), yb = Sb[0] * lo2(cur.r[0]); \
                    if ((s) + 1 < SC_U) { pa = Sa[0] * lo2(nxt.kk[0]); pb = Sb[0] * lo2(nxt.kk[0]); } \
                    ya = fma2(Sa[1], hi2(cur.r[0]), ya); yb = fma2(Sb[1], hi2(cur.r[0]), yb); \
                    if ((s) + 1 < SC_U) { pa = fma2(Sa[1], hi2(nxt.kk[0]), pa); pb = fma2(Sb[1], hi2(nxt.kk[0]), pb); } \
                    ya = fma2(Sa[2], lo2(cur.r[1]), ya); yb = fma2(Sb[2], lo2(cur.r[1]), yb); \
                    if ((s) + 1 < SC_U) { pa = fma2(Sa[2], lo2(nxt.kk[1]), pa); pb = fma2(Sb[2], lo2(nxt.kk[1]), pb); } \
                    ya = fma2(Sa[3], hi2(cur.r[1]), ya); yb = fma2(Sb[3], hi2(cur.r[1]), yb); \
                    if ((s) + 1 < SC_U) { pa = fma2(Sa[3], hi2(nxt.kk[1]), pa); pb = fma2(Sb[3], hi2(nxt.kk[1]), pb); } \
                    { float y0_, y1_; asm("v_add_f32 %0, %1, %2" : "=v"(y0_) : "v"(ya.x), "v"(ya.y)); asm("v_add_f32 %0, %1, %2" : "=v"(y1_) : "v"(yb.x), "v"(yb.y));     \
                      *(LAS f32x2*)(yst + ((s) * 64 + v0) * 8 + 2 * kq) = (f32x2){y0_, y1_}; } \
                    if ((s) + 1 < SC_U) cur = nxt; } while (0)
                SC_STEP_(0); SC_STEP_(1);
                if (c > 0) SC_YSTORE(b ^ 1, c - 1);
                if (fill) SC_F0(gA);
                if (bg_on) {
                    if (bg_have) bgc_store(bgT, late_desc(A, F.ws, bg_i - bg_stride), lane);
                    bg_have = bg_i < LATE_ITEMS;
                    if (bg_have) { bgc_load(bgT, late_desc(A, F.ws, bg_i), lane); bg_i += bg_stride; } }
                SC_STEP_(2);
                if (fill) SC_F1();
                SC_STEP_(3);
                if (fill) SC_F2();
                SC_STEP_(4);
                if (fill) SC_F3();
                SC_STEP_(5);
                if (fill) SC_F4(b ^ 1);
                SC_STEP_(6); SC_STEP_(7);
#undef SC_STEP_
                { const LAS float* gp = sl + 2 * SC_OPS_F + b * SC_GAM_F + kq * 8; const f32x4 g0 = *(const LAS f32x4*)gp, g1 = *(const LAS f32x4*)(gp + 4);
                  Sa[0] *= lo2(g0); Sa[1] *= hi2(g0); Sa[2] *= lo2(g1); Sa[3] *= hi2(g1); Sb[0] *= lo2(g0); Sb[1] *= hi2(g0); Sb[2] *= lo2(g1); Sb[3] *= hi2(g1); }
                gA = gB;
            }
            __syncthreads();
        }
        if (active) SC_YSTORE((NC - 1) & 1, NC - 1);
#undef SC_GLOAD
#undef SC_F0
#undef SC_F1
#undef SC_F2
#undef SC_F3
#undef SC_F4
#undef SC_YSTORE
        if (active && out_sf) { float* dp = (dir ? out_sb : out_sf) + soff; *(GAS f32x4*)dp = (f32x4){Sa[0].x, Sa[0].y, Sa[1].x, Sa[1].y}; *(GAS f32x4*)(dp + 4) = (f32x4){Sa[2].x, Sa[2].y, Sa[3].x, Sa[3].y};
            *(GAS f32x4*)(dp + 64) = (f32x4){Sb[0].x, Sb[0].y, Sb[1].x, Sb[1].y}; *(GAS f32x4*)(dp + 68) = (f32x4){Sb[2].x, Sb[2].y, Sb[3].x, Sb[3].y}; }
    }
    if (bg_on) {
        if (bg_have) bgc_store(bgT, late_desc(A, F.ws, bg_i - bg_stride), lane);
        for (; bg_i < LATE_ITEMS; bg_i += bg_stride) { const TDesc d = late_desc(A, F.ws, bg_i); bgc_load(bgT, d, lane); bgc_store(bgT, d, lane); } }
}
__device__ __forceinline__ void rwkv_post(Frame& F, const Args& A, int Ms, const h16s* RS, const h16s* KS, const h16s* VS, const h16s* AF, const h16s* AB, const h16s* LG, const h16s* YF, const h16s* YB, bf16* ORW  ) {
    const int gw = F.vcu * NWAVES + F.wave, NGW = F.G * NWAVES; const float *lnw = A.in[I_LNW], *lnb = A.in[I_LNB], *k_a = A.in[I_KA], *r_k = A.in[I_RK];
    for (int s = gw; s < Ms; s += NGW) {
#pragma unroll
        for (int c = 0; c < 4; ++c) { const int col = c * 512 + F.lane * 8; const size_t off = (size_t)s * D_RW + col;
            float yf[8], yb[8], r[8], k[8], v[8], af[8], ab[8], g[8], w[8], b[8], ka[8], rk[8];
            unpack_h8(*(const GAS v4u*)(YF + off), yf); unpack_h8(*(const GAS v4u*)(YB + off), yb); unpack_h8(*(const GAS v4u*)(RS + off), r); unpack_h8(*(const GAS v4u*)(KS + off), k);
            unpack_h8(*(const GAS v4u*)(VS + off), v); unpack_h8(*(const GAS v4u*)(AF + off), af); unpack_h8(*(const GAS v4u*)(AB + off), ab); unpack_h8(*(const GAS v4u*)(LG + off), g);
#pragma unroll
            for (int h = 0; h < 2; ++h) { const f32x4 a = *(const GAS f32x4*)(lnw + col + 4 * h), bb = *(const GAS f32x4*)(lnb + col + 4 * h), cc = *(const GAS f32x4*)(k_a + col + 4 * h), dd = *(const GAS f32x4*)(r_k + col + 4 * h);
                w[4 * h] = a.x; w[4 * h + 1] = a.y; w[4 * h + 2] = a.z; w[4 * h + 3] = a.w; b[4 * h] = bb.x; b[4 * h + 1] = bb.y; b[4 * h + 2] = bb.z; b[4 * h + 3] = bb.w;
                ka[4 * h] = cc.x; ka[4 * h + 1] = cc.y; ka[4 * h + 2] = cc.z; ka[4 * h + 3] = cc.w; rk[4 * h] = dd.x; rk[4 * h + 1] = dd.y; rk[4 * h + 2] = dd.z; rk[4 * h + 3] = dd.w; }
            float sf = 0.f, sb = 0.f, bf_ = 0.f, bb_ = 0.f;
#pragma unroll
            for (int e = 0; e < 8; ++e) { sf += yf[e]; sb += yb[e]; const float t = r[e] * k[e] * rk[e]; bf_ += t * (1.0f + (af[e] - 1.0f) * ka[e]); bb_ += t * (1.0f + (ab[e] - 1.0f) * ka[e]); }
            sf = sum8(sf) * (1.0f / 64.0f); sb = sum8(sb) * (1.0f / 64.0f); bf_ = sum8(bf_); bb_ = sum8(bb_);
            float qf = 0.f, qb = 0.f;
#pragma unroll
            for (int e = 0; e < 8; ++e) { yf[e] -= sf; yb[e] -= sb; qf += yf[e] * yf[e]; qb += yb[e] * yb[e]; }
            const float rf = 1.0f / sqrtf(sum8(qf) * (1.0f / 64.0f) + LNX_EPS), rb = 1.0f / sqrtf(sum8(qb) * (1.0f / 64.0f) + LNX_EPS);
            float o[8];
#pragma unroll
            for (int e = 0; e < 8; ++e) o[e] = ((yf[e] * rf + yb[e] * rb) * w[e] + 2.0f * b[e] + (bf_ + bb_) * v[e]) * g[e];
            v4u ow; ow.x = pkbf(o[0], o[1]); ow.y = pkbf(o[2], o[3]); ow.z = pkbf(o[4], o[5]); ow.w = pkbf(o[6], o[7]);
            *(GAS v4u*)(ORW + off) = ow; }
    }
}
__global__ void __launch_bounds__(NWAVES * 64, 2) fwd_kernel(Args args) {
    const Args& A = args;
    extern __shared__ __attribute__((aligned(16))) unsigned char lds[];
    Frame F;
    F.lds = (LAS unsigned char*)lds;
    F.MISC = (volatile LAS unsigned*)(F.lds + MISC_OFF);
    F.tid = threadIdx.x; F.lane = F.tid & 63; F.wave = __builtin_amdgcn_readfirstlane(F.tid >> 6);
    F.G = gridDim.x; { const int bx = blockIdx.x; F.vcu = (F.G % 8 == 0) ? (bx % 8) * (F.G / 8) + bx / 8 : bx; }
    F.ws = args.ws; F.out = args.out; F.ctl = (gu32*)(args.ws + WS_CTL);
    for (int u = F.tid; u < (LDS_BYTES - LDSCTL_OFF) / 4; u += NWAVES * 64) ((LAS unsigned*)(F.lds + LDSCTL_OFF))[u] = 0u;
    __syncthreads();
    XcdBarrier bar = xcd_barrier_post((unsigned*)(F.ctl + CW_BAR), F.MISC + 8);
    bar.x = __builtin_amdgcn_readfirstlane(bar.x);
#define GRID_BAR() do { XcdBarrier b_ = bar; unsigned x_ = b_.x; asm volatile("" : "+s"(x_)); b_.x = x_; xcd_barrier(b_); } while (0)
    unsigned char* ws = args.ws;
    bf16* const H = (bf16*)(ws + WS_H); bf16* const Qb = (bf16*)(ws + WS_Q); bf16* const Kb = (bf16*)(ws + WS_K); bf16* const Vb = (bf16*)(ws + WS_V);
    h16s* const PR = (h16s*)(ws + WS_PR); bf16* const ORW = (bf16*)(ws + WS_ORW); bf16* const MID = (bf16*)(ws + WS_MID);
    const float* const MOD = (const float*)(ws + WS_MOD);

#ifndef PHMASK
#define PHMASK 0xffffffffu
#endif
#define PH(n) RELANE(); if constexpr ((PHMASK >> (n)) & 1u)
#define RELANE() do { int t_ = threadIdx.x; asm volatile("" : "+v"(t_)); F.tid = t_; F.lane = t_ & 63; } while (0)
    PH(0) p0_prologue(F, A); GRID_BAR();
    PH(1) p0b_mod_finalize(F, A); GRID_BAR();

    const bool flip = ((int)blockIdx.x & 1) != 0;
    int two = 2; asm volatile("" : "+s"(two));
    bf16* const HLAT = (bf16*)(ws + WS_HLAT);
    PH(2) modnorm_rows<false>(F, A.in[I_XP], T_CTX, A.in[I_N1], 0, DM, 0, L_CTX, 0, H); GRID_BAR();
    for (int g = 0; g < 2; ++g) {
        const int M = g ? T_LAT : T_CTX, L = g ? L_LAT : L_CTX, jbase = g, jmul = g, ppb = L / 256;
        const float* X = g ? A.in[I_XS] : A.in[I_XP]; float* Y = F.out + O_Y + (g ? (size_t)T_CTX * DM : 0); bf16* PG = (bf16*)Y;
        PH(3) { pg8::Gemm gm{g ? HLAT : H, (const bf16*)(ws + WS_WIN), M, N_IN_P, DM}; pg8::StaticOrder S; S.init(M, N_IN_P, F.G, (int)blockIdx.x);
          pg8::EpiProj E{Qb, Kb, Vb, PR, PG, g ? nullptr : F.out + O_NK, g ? nullptr : F.out + O_NV};
          pg8::gemm_phase<pg8::EpiProj, pg8::StaticOrder, true, true>(F.lds + RING_OFF, gm, S, E); }
        if (g == 0) { __syncthreads(); PH(16) { const int nextra = ((T_CTX / 256) * (N_IN_P / 256)) % F.G, bx = (int)blockIdx.x;
              if (nextra == 0) late_weight_copies(F, A, bx, F.G, LATE_BG0); else if (bx >= nextra) late_weight_copies(F, A, bx - nextra, F.G - nextra, LATE_BG0); } }
        GRID_BAR();
        bf16* const Ob = Qb;
        const int nseq = g ? B_LAT : B_CTX;
        h16s *RS = (h16s*)(ws + WS_RS), *KS = (h16s*)(ws + WS_KS), *VS = (h16s*)(ws + WS_VS), *KKb = (h16s*)(ws + WS_KK), *DF = (h16s*)(ws + WS_DF), *DB = (h16s*)(ws + WS_DB), *AF = (h16s*)(ws + WS_AF), *AB = (h16s*)(ws + WS_AB);
        h16s *LG = (h16s*)(ws + WS_LG), *YF = (h16s*)(ws + WS_YF), *YB = (h16s*)(ws + (g ? WS_YB_LAT : WS_YB_CTX)); bf16* LA = (bf16*)(ws + WS_LA);
        for (int ph = 0; ph < two; ++ph) {
          if ((ph == 0) != flip) {
            PH(4) { if (g == 0) { for (int u = F.vcu; u < B_CTX * NH_A; u += F.G) { const int b = u >> 4, h = u & 15; const size_t base = (size_t)b * L_CTX * 2048 + h * 128;
                    att::attn_unit(F.lds + RING_OFF, Qb + base, Ob + base, Kb, Vb, 0, 0, 0, Kb + base, Vb + base, nullptr); } }
            else { const bf16* CK = (const bf16*)(ws + WS_CK); const bf16* CV = (const bf16*)(ws + WS_CV);
                for (int u = F.vcu; u < B_LAT * NH_A * 16; u += F.G) { const int rg = u & 15, h = (u >> 4) & 15, b = u >> 8; const int r0 = 4 * rg, rho0 = min(max(r0 - 4, 0), 56), rho1 = min(max(r0 - 1, 0), 56) + 8;
                    const size_t qbase = ((size_t)b * L_LAT + (size_t)rg * 256) * 2048 + h * 128, lbase = ((size_t)b * L_LAT + (size_t)rho0 * 64) * 2048 + h * 128, cbase = (size_t)b * 256 * 2048 + h * 128;
                    att::attn_unit(F.lds + RING_OFF, Qb + qbase, Ob + qbase, Kb + lbase, Vb + lbase, rho1 - rho0, rho0, r0, CK + cbase, CV + cbase, A.in[I_RPB] + h * 15 * 31); } } }
          } else { PH(5) rwkv_prep(F, A, PR, 0, M, L, RS, KS, VS, KKb, LA); }
        }
        GRID_BAR();
        {   int klora = 256; asm volatile("" : "+s"(klora));
            PH(6) { pg8::Gemm gm{LA, (const bf16*)(ws + WS_WLORA), M, 8192, klora}; pg8::StaticOrder S; S.init(M, 8192, F.G, (int)blockIdx.x);
              pg8::EpiLora E{{DF, DB, AF, AB, LG}, A.in[I_W0], A.in[I_A0], 0};
              pg8::gemm_phase<pg8::EpiLora, pg8::StaticOrder, true, true>(F.lds + RING_OFF, gm, S, E); }
            PH(6) { pg8::Gemm gm{LA + (size_t)M * 256, (const bf16*)(ws + WS_WLORA) + (size_t)8192 * 256, M, 2048, klora}; pg8::StaticOrder S; S.init(M, 2048, F.G, (int)blockIdx.x);
              pg8::EpiLora E{{DF, DB, AF, AB, LG}, A.in[I_W0], A.in[I_A0], 4};
              pg8::gemm_phase<pg8::EpiLora, pg8::StaticOrder, true, true>(F.lds + RING_OFF, gm, S, E); }
            GRID_BAR();
            PH(7) rwkv_scan(F, A, nseq, L, 0, g != 0, RS, KS, VS, KKb, DF, DB, AF, AB, YF, YB, g ? nullptr : F.out + O_SF, g ? nullptr : F.out + O_SB);
            GRID_BAR();
        }
        for (int ph = 0; ph < two; ++ph) {
          if ((ph == 0) != flip) {
            PH(9) { pg8::Gemm gm{Qb, (const bf16*)(ws + WS_WOA), M, DM, D_ATT}; pg8::StaticOrder S; S.init(M, DM, F.G, (int)blockIdx.x);
              pg8::EpiGate<false> E{MID, PG, 0};
              pg8::gemm_phase<pg8::EpiGate<false>, pg8::StaticOrder, true, true>(F.lds + RING_OFF, gm, S, E); }
          } else { PH(8) rwkv_post(F, A, M, RS, KS, VS, AF, AB, LG, YF, YB, ORW); }
        }
        GRID_BAR();
        PH(10) { pg8::Gemm gm{ORW, (const bf16*)(ws + WS_WOR), M, DM, D_RW}; pg8::StaticOrder S; S.init(M, DM, F.G, (int)blockIdx.x);
          pg8::EpiGate<true> E{MID, PG, DM};
          pg8::gemm_phase<pg8::EpiGate<true>, pg8::StaticOrder, true, true>(F.lds + RING_OFF, gm, S, E); }
        GRID_BAR();
        for (int ph = 0; ph < two; ++ph) {
          if ((ph == 0) != flip) {
            PH(11) { pg8::Gemm gm{MID, (const bf16*)(ws + WS_WOUT), M, DM, DM}; pg8::StaticOrder S; S.init(M, DM, F.G, (int)blockIdx.x);
              pg8::EpiResid<true> E{X, (bf16*)Y, MOD + 2 * DM, jbase, ppb, jmul};
              pg8::gemm_phase<pg8::EpiResid<true>, pg8::StaticOrder, true, true>(F.lds + RING_OFF, gm, S, E); }
          } else if (g == 0) { PH(2) modnorm_rows<false>(F, A.in[I_XS], T_LAT, A.in[I_N1], 0, DM, 1, L_LAT, 1, HLAT); }
        }
        GRID_BAR();
    }
    { int six = 6; asm volatile("" : "+s"(six));
      for (int st = 0; st < six; ++st) {
        for (int ph = 0; ph < two; ++ph) {
          if ((ph == 0) != flip) {
            const int gg = (st == 2 || st == 3) ? 1 : 0, Mg = gg ? T_LAT : T_CTX;
            if (st == 1 || st == 2) {
              PH(13) { pg8::Gemm gm{(const bf16*)(F.ws + (gg ? WS_H2L : WS_H2C)), (const bf16*)(F.ws + WS_WM1), Mg, D_FF, DM}; pg8::StaticOrder S; S.init(Mg, D_FF, F.G, (int)blockIdx.x);
                pg8::EpiRelu2 E{(bf16*)(F.ws + (gg ? WS_UL : WS_UC))};
                pg8::gemm_phase<pg8::EpiRelu2, pg8::StaticOrder, true, true>(F.lds + RING_OFF, gm, S, E); }
            } else if (st == 3 || st == 4) {
              PH(14) { pg8::Gemm gm{(const bf16*)(F.ws + (gg ? WS_UL : WS_UC)), (const bf16*)(F.ws + WS_WM2), Mg, DM, D_FF}; pg8::StaticOrder S; S.init(Mg, DM, F.G, (int)blockIdx.x);
                pg8::EpiResid<false> E{nullptr, (bf16*)(F.out + O_Y + (gg ? (size_t)T_CTX * DM : 0)), (const float*)(F.ws + WS_MOD) + 5 * DM, gg, (gg ? L_LAT : L_CTX) / 256, gg};
                pg8::gemm_phase<pg8::EpiResid<false>, pg8::StaticOrder, true, true>(F.lds + RING_OFF, gm, S, E); }
            }
          } else {
            const int gm_ = (st == 1 || st == 4) ? 1 : 0, Mm = gm_ ? T_LAT : T_CTX; float* const Ym = F.out + O_Y + (gm_ ? (size_t)T_CTX * DM : 0);
            if (st < 2) { PH(12) modnorm16_rows(F, (const h16s*)Ym, Mm, A.in[I_N2], 3 * DM, 4 * DM, gm_, gm_ ? L_LAT : L_CTX, gm_, (bf16*)(F.ws + (gm_ ? WS_H2L : WS_H2C))); }
            else if (st >= 4) { PH(15) final16_rows(F, Ym, Mm, A.in[I_NF]); }
          }
        }
        if (st < 5) GRID_BAR();
      }
    }
#undef GRID_BAR
}

extern "C" void kernel_launch(void* const* d_in, const int* in_sizes, int n_in, void* d_out, int out_size, void* d_ws, size_t ws_size, hipStream_t stream) {
    static int grid = 0;
    if (grid == 0) {
        if (n_in != 31 || ws_size < WS_END) { fprintf(stderr, "kernel_launch: need 31 inputs and >= %zu bytes of workspace; got %d, %zu\n", (size_t)WS_END, n_in, ws_size); grid = -1; return; }
        int dev = 0, cus = 0, per_cu = 0;
        if (hipGetDevice(&dev) != hipSuccess || hipDeviceGetAttribute(&cus, hipDeviceAttributeMultiprocessorCount, dev) != hipSuccess) { grid = -1; return; }
        if (hipFuncSetAttribute((const void*)fwd_kernel, hipFuncAttributeMaxDynamicSharedMemorySize, LDS_BYTES) != hipSuccess) { fprintf(stderr, "kernel_launch: hipFuncSetAttribute failed\n"); grid = -1; return; }
        if (hipOccupancyMaxActiveBlocksPerMultiprocessor(&per_cu, (const void*)fwd_kernel, NWAVES * 64, LDS_BYTES) != hipSuccess || per_cu < 1) fprintf(stderr, "kernel_launch: occupancy query reports %d\n", per_cu);
        (void)hipGetLastError();
        grid = cus;
    }
    if (grid < 0) return;
    if (hipMemsetAsync((char*)d_ws + WS_CTL, 0, CTL_ZERO_BYTES, stream) != hipSuccess) return;
    Args a{};
    for (int i = 0; i < 31; ++i) a.in[i] = (const float*)d_in[i];
    a.out = (float*)d_out; a.ws = (unsigned char*)d_ws;
    hipLaunchKernelGGL(fwd_kernel, dim3(grid), dim3(NWAVES * 64), LDS_BYTES, stream, a);
    const hipError_t le = hipPeekAtLastError();
    if (le != hipSuccess) fprintf(stderr, "kernel_launch: launch failed: %s\n", hipGetErrorName(le));
}
```
